# Optimizing an MI355X kernel written in HIP

```python
import math
import jax
import jax.numpy as jnp
from jax import lax
import numpy as np

D_MODEL = 1024
BATCH = 1
SEQ = 16384
DEPTH = 4

GRID_W = 64
CTX_LEN = 256
H_A = 4
HD_A = 128
A_WIDTH = H_A * HD_A
CONV_W = 5
H_B = 4
DK_B = 64
DV_B = 128
B_KWIDTH = H_B * DK_B
B_VWIDTH = H_B * DV_B
GLA_RANK = 16
GLA_NORMALIZER = 16.0
H_C = 8
KV_C = 2
REP_C = H_C // KV_C
HD_C = 64
C_WIDTH = H_C * HD_C
WINDOW = 128
ATT_BLOCK = 128
ROPE_THETA = 10000.0
N_BRANCH = 3
CHUNK = 64
N_EXPERTS = 32
TOP_K = 4
D_FF = 1024
SWIGLU_LIMIT = 7.0
SWIGLU_ALPHA = 1.702
MOE_BLOCK = 128
EPS = 1e-6

IN_SPLITS = (A_WIDTH, A_WIDTH, A_WIDTH, A_WIDTH, 2 * H_A, 2 * H_A,
             B_KWIDTH, B_KWIDTH, B_VWIDTH, B_VWIDTH, 2 * GLA_RANK,
             C_WIDTH, KV_C * HD_C, KV_C * HD_C, N_BRANCH * D_MODEL)
IN_COLS = sum(IN_SPLITS)

kernel_name = 'hybrid_deltanet_gla_swa_moe_flow_block'


def rms_norm(x, g):
    xf = x.astype(jnp.float32)
    y = xf * lax.rsqrt(jnp.mean(xf * xf, axis=-1, keepdims=True) + EPS)
    return (y * g.astype(jnp.float32)).astype(x.dtype)


def l2_norm(x):
    return x * lax.rsqrt(jnp.sum(x * x, axis=-1, keepdims=True) + EPS)


def short_conv(x, w):
    return lax.conv_general_dilated(
        x, w[:, None, :].astype(x.dtype), window_strides=(1,),
        padding=[(CONV_W // 2, CONV_W // 2)], dimension_numbers=('NWC', 'WIO', 'NWC'),
        feature_group_count=x.shape[-1])


def dir_order(x):
    return jnp.concatenate([jnp.flip(x[:, :CTX_LEN], 1), jnp.flip(x[:, CTX_LEN:], 1)], 1)


def to_chunks(x):
    b, l, h = x.shape[:3]
    x = x.reshape((b, l // CHUNK, CHUNK, h) + x.shape[3:])
    return x.transpose((1, 0, 3, 2) + tuple(range(4, x.ndim)))


def from_chunks(x):
    n, b, h, c, d = x.shape
    return x.transpose(1, 0, 3, 2, 4).reshape(b, n * c, h, d)


def gated_delta_rule(q, k, v, g, beta):
    b, _, h, dk = q.shape
    dv = v.shape[-1]
    qc, kc, vc = to_chunks(q), to_chunks(k), to_chunks(v)
    gc = jnp.cumsum(to_chunks(g), axis=-1)
    bc = to_chunks(beta)
    idx = jnp.arange(CHUNK)
    incl = idx[:, None] >= idx[None, :]
    strict = idx[:, None] > idx[None, :]
    decay = jnp.exp(jnp.where(incl, gc[..., :, None] - gc[..., None, :], -jnp.inf))
    kb = kc * bc[..., None]
    lower = jnp.einsum('nbhid,nbhjd->nbhij', kb, kc) * jnp.where(strict, decay, 0.0)
    eye = jnp.eye(CHUNK, dtype=q.dtype)
    rhs = jnp.concatenate([vc * bc[..., None], kb * jnp.exp(gc)[..., None]], -1)
    sol = lax.linalg.triangular_solve(lower + eye, rhs, left_side=True, lower=True,
                                      unit_diagonal=True)
    u, w = sol[..., :dv], sol[..., dv:]
    qk = jnp.einsum('nbhid,nbhjd->nbhij', qc, kc) * decay
    q_dec = qc * jnp.exp(gc)[..., None]
    k_dec = kc * jnp.exp(gc[..., -1:] - gc)[..., None]
    g_tot = jnp.exp(gc[..., -1])[..., None, None]

    def step(s, xs):
        u_n, w_n, qk_n, qd_n, kd_n, gt_n = xs
        v_new = u_n - jnp.einsum('bhck,bhkv->bhcv', w_n, s)
        o = jnp.einsum('bhck,bhkv->bhcv', qd_n, s) + jnp.einsum('bhij,bhjv->bhiv', qk_n, v_new)
        s = s * gt_n + jnp.einsum('bhck,bhcv->bhkv', kd_n, v_new)
        return s, o

    _, o = lax.scan(step, jnp.zeros((b, h, dk, dv), q.dtype), (u, w, qk, q_dec, k_dec, g_tot))
    return from_chunks(o)


def gla_chunked(q, k, v, gk):
    b, _, h, dk = q.shape
    dv = v.shape[-1]
    qc, kc, vc = to_chunks(q), to_chunks(k), to_chunks(v)
    bc = jnp.cumsum(to_chunks(gk), axis=-2)
    idx = jnp.arange(CHUNK)
    incl = (idx[:, None] >= idx[None, :])[:, :, None]

    def step(s, xs):
        q_n, k_n, v_n, b_n = xs
        o_inter = jnp.einsum('bhck,bhkv->bhcv', q_n * jnp.exp(b_n), s)
        wd = jnp.exp(jnp.where(incl, b_n[:, :, :, None, :] - b_n[:, :, None, :, :], -jnp.inf))
        a = jnp.einsum('bhik,bhjk,bhijk->bhij', q_n, k_n, wd)
        o = o_inter + jnp.einsum('bhij,bhjv->bhiv', a, v_n)
        b_last = b_n[:, :, -1:, :]
        s = s * jnp.exp(b_last)[:, :, 0, :, None] + jnp.einsum(
            'bhck,bhcv->bhkv', k_n * jnp.exp(b_last - b_n), v_n)
        return s, o

    _, o = lax.scan(step, jnp.zeros((b, h, dk, dv), q.dtype), (qc, kc, vc, bc))
    return from_chunks(o)


def axial_rope(x, rows, cols):
    half = x.shape[-1] // 2
    inv_freq = ROPE_THETA ** (-jnp.arange(0, half, 2, dtype=jnp.float32) / half)

    def rot(xp, pos):
        ang = pos.astype(jnp.float32)[:, None] * inv_freq[None, :]
        cos = jnp.cos(ang)[None, :, None, :].astype(x.dtype)
        sin = jnp.sin(ang)[None, :, None, :].astype(x.dtype)
        x1, x2 = xp[..., :half // 2], xp[..., half // 2:]
        return jnp.concatenate([x1 * cos - x2 * sin, x2 * cos + x1 * sin], -1)

    return jnp.concatenate([rot(x[..., :half], rows), rot(x[..., half:], cols)], -1)


def window_gqa(q, k, v, sink):
    b = q.shape[0]
    scale = HD_C ** -0.5
    sink_l = sink.astype(jnp.float32).reshape(KV_C, REP_C)
    qx, ql = q[:, :CTX_LEN], q[:, CTX_LEN:]
    kx, kl = k[:, :CTX_LEN], k[:, CTX_LEN:]
    vx, vl = v[:, :CTX_LEN], v[:, CTX_LEN:]
    qx = qx.reshape(b, CTX_LEN, KV_C, REP_C, HD_C)
    s = jnp.einsum('bqgrd,bkgd->bgrqk', qx, kx).astype(jnp.float32) * scale
    sink_col = jnp.broadcast_to(sink_l[None, :, :, None, None], s.shape[:-1] + (1,))
    p = jax.nn.softmax(jnp.concatenate([s, sink_col], -1), axis=-1)[..., :CTX_LEN]
    o_ctx = jnp.einsum('bgrqk,bkgd->bqgrd', p.astype(v.dtype), vx).reshape(b, CTX_LEN, C_WIDTH)
    s_len = ql.shape[1]
    nb = s_len // ATT_BLOCK
    qb = ql.reshape(b, nb, ATT_BLOCK, KV_C, REP_C, HD_C)

    def band(t):
        tp = jnp.pad(t, ((0, 0), (ATT_BLOCK, ATT_BLOCK), (0, 0), (0, 0)))
        tp = tp.reshape(b, nb + 2, ATT_BLOCK, KV_C, HD_C)
        return jnp.concatenate([tp[:, :-2], tp[:, 1:-1], tp[:, 2:]], axis=2)

    kb, vb = band(kl), band(vl)
    s_loc = jnp.einsum('bnqgrd,bnkgd->bngrqk', qb, kb).astype(jnp.float32) * scale
    blk = jnp.arange(nb)[:, None, None]
    qpos = blk * ATT_BLOCK + jnp.arange(ATT_BLOCK)[None, :, None]
    kpos = (blk - 1) * ATT_BLOCK + jnp.arange(3 * ATT_BLOCK)[None, None, :]
    valid = (jnp.abs(qpos - kpos) <= WINDOW) & (kpos >= 0) & (kpos < s_len)
    s_loc = jnp.where(valid[None, :, None, None], s_loc, -jnp.inf)
    s_ctx = jnp.einsum('bnqgrd,bcgd->bngrqc', qb, kx).astype(jnp.float32) * scale
    sink_col = jnp.broadcast_to(sink_l[None, None, :, :, None, None], s_ctx.shape[:-1] + (1,))
    p = jax.nn.softmax(jnp.concatenate([s_loc, s_ctx, sink_col], -1), axis=-1).astype(v.dtype)
    p_loc = p[..., :3 * ATT_BLOCK]
    p_ctx = p[..., 3 * ATT_BLOCK:3 * ATT_BLOCK + CTX_LEN]
    o_lat = (jnp.einsum('bngrqk,bnkgd->bnqgrd', p_loc, vb)
             + jnp.einsum('bngrqc,bcgd->bnqgrd', p_ctx, vx)).reshape(b, s_len, C_WIDTH)
    return jnp.concatenate([o_ctx, o_lat], 1)


def token_mixer(h, rows, cols, w_in, conv_w, a_log, dt_bias, dn_g, gla_w2, gla_b2, gla_g,
                q_g, k_g, sink, wpa, wpb, wpc, wo):
    b, lt, _ = h.shape
    f32 = jnp.float32
    points = np.cumsum(IN_SPLITS)[:-1].tolist()
    (aq, ak, av, az, aa, ab, bq, bk, bv, bz, bg, cq, ck, cv, gl) = jnp.split(h @ w_in, points, axis=-1)

    qkv = jnp.concatenate([aq, ak, av], -1)
    qkv = jnp.concatenate([short_conv(qkv[:, :CTX_LEN], conv_w), short_conv(qkv[:, CTX_LEN:], conv_w)], 1)
    qkv = jax.nn.silu(qkv).astype(f32)
    qa, ka, va = [t.reshape(b, lt, H_A, HD_A) for t in jnp.split(qkv, 3, axis=-1)]
    qa = l2_norm(qa) * HD_A ** -0.5
    ka = l2_norm(ka)
    g_dn = -jnp.exp(a_log.astype(f32)) * jax.nn.softplus(
        aa.astype(f32).reshape(b, lt, 2, H_A) + dt_bias.astype(f32))
    beta = jax.nn.sigmoid(ab.astype(f32).reshape(b, lt, 2, H_A))
    o_a = gated_delta_rule(qa, ka, va, g_dn[:, :, 0], beta[:, :, 0]) + dir_order(
        gated_delta_rule(dir_order(qa), dir_order(ka), dir_order(va),
                         dir_order(g_dn[:, :, 1]), dir_order(beta[:, :, 1])))
    y_a = (rms_norm(o_a, dn_g) * jax.nn.silu(az.astype(f32).reshape(b, lt, H_A, HD_A)))
    y_a = y_a.reshape(b, lt, A_WIDTH).astype(h.dtype)

    qb_ = bq.astype(f32).reshape(b, lt, H_B, DK_B) * DK_B ** -0.5
    kb_ = bk.astype(f32).reshape(b, lt, H_B, DK_B)
    vb_ = bv.astype(f32).reshape(b, lt, H_B, DV_B)
    gk = jax.nn.log_sigmoid(jnp.einsum('bldr,drk->bldk', bg.astype(f32).reshape(b, lt, 2, GLA_RANK),
                                       gla_w2.astype(f32)) + gla_b2.astype(f32)) / GLA_NORMALIZER
    gk = gk.reshape(b, lt, 2, H_B, DK_B)
    o_b = gla_chunked(qb_, kb_, vb_, gk[:, :, 0]) + dir_order(
        gla_chunked(dir_order(qb_), dir_order(kb_), dir_order(vb_), dir_order(gk[:, :, 1])))
    y_b = (rms_norm(o_b, gla_g) * jax.nn.silu(bz.astype(f32).reshape(b, lt, H_B, DV_B)))
    y_b = y_b.reshape(b, lt, B_VWIDTH).astype(h.dtype)

    qc = rms_norm(cq.reshape(b, lt, H_C, HD_C), q_g)
    kc = rms_norm(ck.reshape(b, lt, KV_C, HD_C), k_g)
    vc = cv.reshape(b, lt, KV_C, HD_C)
    qc = jnp.concatenate([qc[:, :CTX_LEN], axial_rope(qc[:, CTX_LEN:], rows, cols)], 1)
    kc = jnp.concatenate([kc[:, :CTX_LEN], axial_rope(kc[:, CTX_LEN:], rows, cols)], 1)
    y_c = window_gqa(qc, kc, vc, sink)

    ga, gb, gcc = jnp.split(jax.nn.sigmoid(gl), 3, axis=-1)
    merged = ga * (y_a @ wpa) + gb * (y_b @ wpb) + gcc * (y_c @ wpc)
    return merged @ wo


def moe_ffn(h, router_w, router_b, w_gu, b_gu, w_dn, b_dn):
    b, l, d = h.shape
    x = h.reshape(-1, d)
    t = x.shape[0]
    tk = t * TOP_K
    logits = (x @ router_w + router_b).astype(jnp.float32)
    top_v, top_e = lax.top_k(logits, TOP_K)
    gate = jax.nn.softmax(top_v, axis=-1)
    flat_e = top_e.reshape(-1)
    order = jnp.argsort(flat_e)
    sorted_e = flat_e[order]
    counts = jnp.zeros((N_EXPERTS,), jnp.int32).at[flat_e].add(1)
    padded = (counts + MOE_BLOCK - 1) // MOE_BLOCK * MOE_BLOCK
    start = jnp.cumsum(counts) - counts
    pend = jnp.cumsum(padded)
    pstart = pend - padded
    dest_sorted = pstart[sorted_e] + jnp.arange(tk, dtype=jnp.int32) - start[sorted_e]
    n_blocks = (tk + N_EXPERTS * (MOE_BLOCK - 1) + MOE_BLOCK - 1) // MOE_BLOCK
    p_rows = n_blocks * MOE_BLOCK
    src_tok = jnp.full((p_rows,), t, jnp.int32).at[dest_sorted].set((order // TOP_K).astype(jnp.int32))
    x_src = jnp.concatenate([x, jnp.zeros((1, d), x.dtype)], 0)
    xb = x_src[src_tok].reshape(n_blocks, MOE_BLOCK, d)
    blk_e = jnp.minimum(jnp.searchsorted(pend, jnp.arange(n_blocks, dtype=jnp.int32) * MOE_BLOCK,
                                         side='right'), N_EXPERTS - 1)

    def expert(args):
        xe, e = args
        gu = xe @ w_gu[e] + b_gu[e]
        g_, u_ = gu[:, :D_FF], gu[:, D_FF:]
        g_ = jnp.minimum(g_, SWIGLU_LIMIT)
        u_ = jnp.clip(u_, -SWIGLU_LIMIT, SWIGLU_LIMIT)
        glu = g_ * jax.nn.sigmoid(g_ * SWIGLU_ALPHA)
        return ((u_ + 1.0) * glu) @ w_dn[e] + b_dn[e]

    y = lax.map(expert, (xb, blk_e)).reshape(p_rows, d)
    dest = jnp.zeros((tk,), jnp.int32).at[order].set(dest_sorted)
    y_assign = y[dest].reshape(t, TOP_K, d)
    out = jnp.einsum('tk,tkd->td', gate.astype(y.dtype), y_assign)
    return out.reshape(b, l, d)


def modulate(xn, shift_c, scale_c, shift_l, scale_l):
    return jnp.concatenate([xn[:, :CTX_LEN] * (1.0 + scale_c) + shift_c,
                            xn[:, CTX_LEN:] * (1.0 + scale_l) + shift_l], 1)


def gate_streams(y, g_c, g_l):
    return jnp.concatenate([y[:, :CTX_LEN] * g_c, y[:, CTX_LEN:] * g_l], 1)


def setup_inputs(seed: int = 0) -> dict:
    key = jax.random.key(seed)
    ks = jax.random.split(key, 32)
    d = D_MODEL

    def nrm(k, shape, s):
        return jax.random.normal(k, shape, jnp.float32) * s

    dt = jnp.exp(jax.random.uniform(ks[11], (DEPTH, 2, H_A), jnp.float32,
                                    math.log(1e-3), math.log(1e-1)))
    return {
        'x': nrm(ks[0], (BATCH, SEQ, d), 1.0),
        'c': nrm(ks[1], (BATCH, d), 1.0),
        'ctx': nrm(ks[2], (BATCH, CTX_LEN, d), 1.0),
        'c_ctx': nrm(ks[3], (d,), 1.0),
        'ada_w': nrm(ks[4], (DEPTH, d, 6 * d), 0.5 * d ** -0.5),
        'ada_b': nrm(ks[5], (DEPTH, 6 * d), 0.02),
        'norm_mix_g': 1.0 + nrm(ks[6], (DEPTH, d), 0.01),
        'norm_ffn_g': 1.0 + nrm(ks[7], (DEPTH, d), 0.01),
        'w_in': nrm(ks[8], (DEPTH, d, IN_COLS), d ** -0.5),
        'dn_conv_w': nrm(ks[9], (DEPTH, CONV_W, 3 * A_WIDTH), CONV_W ** -0.5),
        'dn_a_log': jnp.log(jax.random.uniform(ks[10], (DEPTH, 2, H_A), jnp.float32, 1.0, 16.0)),
        'dn_dt_bias': dt + jnp.log(-jnp.expm1(-dt)),
        'dn_norm_g': 1.0 + nrm(ks[12], (DEPTH, HD_A), 0.01),
        'gla_w2': nrm(ks[13], (DEPTH, 2, GLA_RANK, B_KWIDTH), GLA_RANK ** -0.5),
        'gla_b2': nrm(ks[14], (DEPTH, 2, B_KWIDTH), 0.1),
        'gla_norm_g': 1.0 + nrm(ks[15], (DEPTH, DV_B), 0.01),
        'attn_q_norm_g': 1.0 + nrm(ks[16], (DEPTH, HD_C), 0.01),
        'attn_k_norm_g': 1.0 + nrm(ks[17], (DEPTH, HD_C), 0.01),
        'attn_sink': nrm(ks[18], (DEPTH, H_C), 0.5),
        'w_branch_a': nrm(ks[19], (DEPTH, A_WIDTH, d), A_WIDTH ** -0.5),
        'w_branch_b': nrm(ks[20], (DEPTH, B_VWIDTH, d), B_VWIDTH ** -0.5),
        'w_branch_c': nrm(ks[21], (DEPTH, C_WIDTH, d), C_WIDTH ** -0.5),
        'w_out': nrm(ks[22], (DEPTH, d, d), d ** -0.5),
        'router_w': nrm(ks[23], (DEPTH, d, N_EXPERTS), d ** -0.5),
        'router_b': nrm(ks[24], (DEPTH, N_EXPERTS), 0.01),
        'w_gate_up': nrm(ks[25], (DEPTH, N_EXPERTS, d, 2 * D_FF), d ** -0.5),
        'b_gate_up': nrm(ks[26], (DEPTH, N_EXPERTS, 2 * D_FF), 0.01),
        'w_down': nrm(ks[27], (DEPTH, N_EXPERTS, D_FF, d), D_FF ** -0.5),
        'b_down': nrm(ks[28], (DEPTH, N_EXPERTS, d), 0.01),
    }


def reference(x, c, ctx, c_ctx, ada_w, ada_b, norm_mix_g, norm_ffn_g, w_in, dn_conv_w,
              dn_a_log, dn_dt_bias, dn_norm_g, gla_w2, gla_b2, gla_norm_g, attn_q_norm_g,
              attn_k_norm_g, attn_sink, w_branch_a, w_branch_b, w_branch_c, w_out, router_w,
              router_b, w_gate_up, b_gate_up, w_down, b_down):
    s_len = x.shape[1]
    ROWS = s_len // GRID_W
    rows = jnp.repeat(jnp.arange(ROWS), GRID_W)
    cols = jnp.tile(jnp.arange(GRID_W), ROWS)
    xs = jnp.concatenate([ctx, x], 1)
    for l in range(DEPTH):
        mod_l = jax.nn.silu(c) @ ada_w[l] + ada_b[l]
        mod_c = jax.nn.silu(c_ctx) @ ada_w[l] + ada_b[l]
        ml = jnp.split(mod_l[:, None, :], 6, axis=-1)
        mc = jnp.split(mod_c, 6, axis=-1)
        h = modulate(rms_norm(xs, norm_mix_g[l]), mc[0], mc[1], ml[0], ml[1])
        y = token_mixer(h, rows, cols, w_in[l], dn_conv_w[l], dn_a_log[l], dn_dt_bias[l],
                        dn_norm_g[l], gla_w2[l], gla_b2[l], gla_norm_g[l], attn_q_norm_g[l],
                        attn_k_norm_g[l], attn_sink[l], w_branch_a[l], w_branch_b[l],
                        w_branch_c[l], w_out[l])
        xs = xs + gate_streams(y, mc[2], ml[2])
        h = modulate(rms_norm(xs, norm_ffn_g[l]), mc[3], mc[4], ml[3], ml[4])
        y = moe_ffn(h, router_w[l], router_b[l], w_gate_up[l], b_gate_up[l], w_down[l], b_down[l])
        xs = xs + gate_streams(y, mc[5], ml[5])
    return xs[:, CTX_LEN:]
```

```cpp
#include <hip/hip_runtime.h>
#include <cstdio>
#include <cstdint>
#ifndef MK_MULTI
#define MK_MULTI 0
#endif
namespace pg8 {
#define PG8_LAS __attribute__((address_space(3)))
typedef unsigned short bf16_t;
typedef short bf16x8 __attribute__((ext_vector_type(8)));
typedef float f32x4 __attribute__((ext_vector_type(4)));
typedef unsigned u32x4 __attribute__((ext_vector_type(4)));
constexpr int BM = 256, BK = 64, HALF = 128, HTB = HALF * BK * 2  , STAGE_BYTES = 8 * HTB, NXCD = 8, WGM = 8;

__host__ __device__ __forceinline__ int lds_byte(int r, int c) { const int st = (r >> 4) * 2 + (c >> 5), rr = r & 15, cc = c & 31, ob = rr * 64 + cc * 2; return st * 1024 + (ob ^ (((ob >> 9) & 1) << 5)); }
__host__ __device__ __forceinline__ void stage_rc(int b, int& R, int& C) { const int st = b / 1024, sb = b % 1024, swz = sb ^ (((sb >> 9) & 1) << 5); R = (st >> 1) * 16 + swz / 64; C = (st & 1) * 32 + (swz % 64) / 2; }
__host__ __device__ __forceinline__ int perm32(int rho) { const int n = rho >> 4, i = rho & 15; return 8 * (i >> 2) + 4 * n + (i & 3); }


struct Unit { int pm, pn, z; };
typedef float f32x2_t __attribute__((ext_vector_type(2)));
typedef __bf16 bf16x2_t __attribute__((ext_vector_type(2)));
__device__ __forceinline__ unsigned cvt_pk_bf16(float lo, float hi) { const f32x2_t v = {lo, hi}; return __builtin_bit_cast(unsigned, __builtin_convertvector(v, bf16x2_t)); }
template <class Epi, class Sched, bool ALIGN_EPI = false, bool SP2 = false>
__device__ __forceinline__ void gemm_phase(PG8_LAS unsigned char* lds, const int tid, const int K, const Sched& S, const Epi& E) {
    const int wid = __builtin_amdgcn_readfirstlane(tid >> 6), lane = tid & 63, wr = wid >> 2, wc = wid & 3, fr = lane & 15, fq = lane >> 4;
    const int nt = K / BK;
    unsigned voffA[2], voffB[2];
#pragma unroll
    for (int i = 0; i < 2; ++i) { int R, C; stage_rc(tid * 16 + i * 8192, R, C); const int Rb = Epi::PERM ? ((R & ~31) + perm32(R & 31)) : R;
        voffA[i] = (unsigned)(R * K + C) * 2u; voffB[i] = (unsigned)(Rb * K + C) * 2u; }
    unsigned gcu[2][2] = {{0u, 0u}, {0u, 0u}}; int gR[2] = {0, 0}, gC[2] = {0, 0};
    if constexpr (Sched::GATHER) {
#pragma unroll
        for (int i = 0; i < 2; ++i) stage_rc(tid * 16 + i * 8192, gR[i], gC[i]); }
    const size_t kstep = (size_t)(BK * 2);
    const size_t hstep = (size_t)HALF * K * 2;
    const size_t tstep = 2 * hstep;
    const unsigned ldsw = (unsigned)wid * 1024u;
    const int aoff = lds_byte(wr * 64 + fr, fq * 8), boff = lds_byte(wc * 32 + fr, fq * 8);
#define PG8_SA(b, h) (((b) * 2 + (h)) * HTB)
#define PG8_SB(b, h) ((4 + (b) * 2 + (h)) * HTB)
#define PG8_STAGE(bufoff, gbase, voff) do { _Pragma("unroll") for (int _i = 0; _i < 2; ++_i) \
        __builtin_amdgcn_global_load_lds((const unsigned*)((const char*)(gbase) + (voff)[_i]), (PG8_LAS unsigned*)(lds + (bufoff) + ldsw + _i * 8192), 16, 0, 0); } while (0)
#define PG8_STAGE_A(b, h, base, nx) do { if constexpr (Sched::GATHER) { if (nx) { unsigned gn_[2]; _Pragma("unroll") for (int i_ = 0; i_ < 2; ++i_) gn_[i_] = S.a_off(ui + 1, (h) * HALF + gR[i_]) + (unsigned)gC[i_] * 2u; PG8_STAGE(PG8_SA(b, h), base, gn_); } else PG8_STAGE(PG8_SA(b, h), base, gcu[h]); } else PG8_STAGE(PG8_SA(b, h), (base) + (h) * hstep, voffA); } while (0)
#define PG8_LDA(dst, b, h) do { _Pragma("unroll") for (int m = 0; m < 4; ++m) _Pragma("unroll") for (int k = 0; k < 2; ++k) dst[m][k] = *(const PG8_LAS bf16x8*)(lds + PG8_SA(b, h) + aoff + m * 2048 + k * 1024); } while (0)
#define PG8_LDB(dst, b, h) do { _Pragma("unroll") for (int n = 0; n < 2; ++n) _Pragma("unroll") for (int k = 0; k < 2; ++k) dst[n][k] = *(const PG8_LAS bf16x8*)(lds + PG8_SB(b, h) + boff + n * 2048 + k * 1024); } while (0)
#define PG8_MMA(ai, bj, At, Bt) do { __builtin_amdgcn_s_setprio(1); _Pragma("unroll") for (int m = 0; m < 4; ++m) _Pragma("unroll") for (int n = 0; n < 2; ++n) _Pragma("unroll") for (int k = 0; k < 2; ++k) \
        acc[ai][bj][m][n] = __builtin_amdgcn_mfma_f32_16x16x32_bf16(Bt[n][k], At[m][k], acc[ai][bj][m][n], 0, 0, 0); __builtin_amdgcn_s_setprio(0); } while (0)
#define PG8_WAIT_V(n) asm volatile("s_waitcnt vmcnt(" #n ")" ::: "memory")
#define PG8_WAIT_L(n) asm volatile("s_waitcnt lgkmcnt(" #n ")" ::: "memory")
#define PG8_BAR __builtin_amdgcn_s_barrier()
#define PG8_SCHED __builtin_amdgcn_sched_barrier(0)
    Unit cur, nxt; int ui = 0;
    if (!S.next(0, cur)) return;
    f32x4 acc[2][2][4][2];
#pragma unroll
    for (int a = 0; a < 2; ++a)
#pragma unroll
        for (int b = 0; b < 2; ++b)
#pragma unroll
            for (int m = 0; m < 4; ++m)
#pragma unroll
                for (int n = 0; n < 2; ++n) acc[a][b][m][n] = (f32x4){0.f, 0.f, 0.f, 0.f};
    bf16x8 At[4][2], B0[2][2], B1[2][2];
    const char* cA = S.a_ptr(cur); const char* cB = S.b_ptr(cur);
    if constexpr (Sched::GATHER) {
#pragma unroll
        for (int h = 0; h < 2; ++h)
#pragma unroll
            for (int i = 0; i < 2; ++i) gcu[h][i] = S.a_off(0, h * HALF + gR[i]) + (unsigned)gC[i] * 2u; }
    S.a_ready(cur);
    if constexpr (SP2) {
        PG8_STAGE(PG8_SB(0, 0), cB, voffB); PG8_STAGE(PG8_SB(0, 1), cB + hstep, voffB); PG8_STAGE_A(0, 0, cA, false); PG8_STAGE_A(0, 1, cA, false);
        if (wr == 1) PG8_BAR;
        PG8_WAIT_V(2); PG8_BAR;
        PG8_STAGE(PG8_SB(1, 0), cB + kstep, voffB); PG8_STAGE_A(1, 0, cA + kstep, false); PG8_STAGE(PG8_SB(1, 1), cB + hstep + kstep, voffB);
        PG8_WAIT_V(6); PG8_BAR;
    } else {
        PG8_STAGE(PG8_SB(0, 0), cB, voffB); PG8_STAGE_A(0, 0, cA, false); PG8_STAGE(PG8_SB(0, 1), cB + hstep, voffB); PG8_STAGE_A(0, 1, cA, false);
        if (wr == 1) PG8_BAR;
        PG8_WAIT_V(4); PG8_BAR;
        PG8_STAGE(PG8_SB(1, 0), cB + kstep, voffB); PG8_STAGE_A(1, 0, cA + kstep, false); PG8_STAGE(PG8_SB(1, 1), cB + hstep + kstep, voffB);
        PG8_WAIT_V(6); PG8_BAR;
    }
    for (;;) {
        const bool has_next = S.next(ui + 1, nxt);
        const char* nA = has_next ? S.a_ptr(nxt) : cA; const char* nB = has_next ? S.b_ptr(nxt) : cB;

        for (int t = 0; t < nt; t += 2) {
            const bool last = (t == nt - 2);
            const char* a1 = cA + (size_t)(t + 1) * kstep;
            const char* a2 = last ? nA : cA + (size_t)(t + 2) * kstep; const char* b2 = last ? nB : cB + (size_t)(t + 2) * kstep;
            const char* a3 = a2 + kstep; const char* b3 = b2 + kstep;
            if (last && has_next) S.a_ready(nxt);
            if constexpr (SP2) {
            PG8_LDB(B0, 0, 0); PG8_LDB(B1, 0, 1); PG8_SCHED; PG8_LDA(At, 0, 0); PG8_STAGE_A(1, 1, a1, false);
            PG8_WAIT_V(8); PG8_WAIT_L(0); PG8_BAR; PG8_MMA(0, 0, At, B0); PG8_MMA(0, 1, At, B1); PG8_BAR; PG8_SCHED;
            PG8_LDA(At, 0, 1); PG8_STAGE(PG8_SB(0, 0), b2, voffB); PG8_STAGE(PG8_SB(0, 1), b2 + hstep, voffB); PG8_STAGE_A(0, 0, a2, (last && has_next));
            PG8_WAIT_V(8); PG8_WAIT_L(0); PG8_BAR; PG8_MMA(1, 0, At, B0); PG8_MMA(1, 1, At, B1); PG8_BAR; PG8_SCHED;
            PG8_LDB(B0, 1, 0); PG8_LDB(B1, 1, 1); PG8_SCHED; PG8_LDA(At, 1, 0); PG8_STAGE_A(0, 1, a2, (last && has_next));
            PG8_WAIT_V(8); PG8_WAIT_L(0); PG8_BAR; PG8_MMA(0, 0, At, B0); PG8_MMA(0, 1, At, B1); PG8_BAR; PG8_SCHED;
            PG8_LDA(At, 1, 1); PG8_STAGE(PG8_SB(1, 0), b3, voffB); PG8_STAGE(PG8_SB(1, 1), b3 + hstep, voffB); PG8_STAGE_A(1, 0, a3, (last && has_next));
            PG8_WAIT_V(8); PG8_WAIT_L(0); PG8_BAR; PG8_MMA(1, 0, At, B0); PG8_MMA(1, 1, At, B1); PG8_BAR; PG8_SCHED;
            } else {
            PG8_LDB(B0, 0, 0); PG8_SCHED; PG8_LDA(At, 0, 0); PG8_STAGE_A(1, 1, a1, false);
            PG8_WAIT_L(8); PG8_BAR; PG8_WAIT_L(0); PG8_MMA(0, 0, At, B0); PG8_BAR; PG8_SCHED;
            PG8_LDB(B1, 0, 1); PG8_STAGE(PG8_SB(0, 0), b2, voffB);
            PG8_BAR; PG8_WAIT_L(0); PG8_MMA(0, 1, At, B1); PG8_BAR;
            PG8_LDA(At, 0, 1); PG8_STAGE_A(0, 0, a2, (last && has_next));
            PG8_BAR; PG8_WAIT_L(0); PG8_MMA(1, 0, At, B0); PG8_BAR; PG8_SCHED;
            PG8_STAGE(PG8_SB(0, 1), b2 + hstep, voffB);
            PG8_WAIT_V(6); PG8_BAR; PG8_MMA(1, 1, At, B1); PG8_BAR;
            PG8_LDB(B0, 1, 0); PG8_SCHED; PG8_LDA(At, 1, 0); PG8_STAGE_A(0, 1, a2, (last && has_next));
            PG8_WAIT_L(8); PG8_BAR; PG8_WAIT_L(0); PG8_MMA(0, 0, At, B0); PG8_BAR; PG8_SCHED;
            PG8_LDB(B1, 1, 1); PG8_STAGE(PG8_SB(1, 0), b3, voffB);
            PG8_BAR; PG8_WAIT_L(0); PG8_MMA(0, 1, At, B1); PG8_BAR;
            PG8_LDA(At, 1, 1); PG8_STAGE_A(1, 0, a3, (last && has_next));
            PG8_BAR; PG8_WAIT_L(0); PG8_MMA(1, 0, At, B0); PG8_BAR; PG8_SCHED;
            PG8_STAGE(PG8_SB(1, 1), b3 + hstep, voffB);
            PG8_WAIT_V(6); PG8_BAR; PG8_MMA(1, 1, At, B1); PG8_BAR;
            }
        }
        if constexpr (ALIGN_EPI) { if (wr == 0) PG8_BAR; }
        bool keep_acc = false;
        if constexpr (Epi::CHAIN) { keep_acc = E.chain(acc, cur, wr, wc, fr, fq); S.done(cur); }
        else if constexpr (!Epi::AFTER_DRAIN) { E(acc, cur, wr, wc, fr, fq); S.done(cur); }
        if (!has_next) break;
        if (!keep_acc) {
#pragma unroll
        for (int a = 0; a < 2; ++a)
#pragma unroll
            for (int b = 0; b < 2; ++b)
#pragma unroll
                for (int m = 0; m < 4; ++m)
#pragma unroll
                    for (int n = 0; n < 2; ++n) acc[a][b][m][n] = (f32x4){0.f, 0.f, 0.f, 0.f};
        }
        cur = nxt; cA = nA; cB = nB; ++ui;
        if constexpr (Sched::GATHER) {
#pragma unroll
            for (int h = 0; h < 2; ++h)
#pragma unroll
                for (int i = 0; i < 2; ++i) gcu[h][i] = S.a_off(ui, h * HALF + gR[i]) + (unsigned)gC[i] * 2u; }
        if constexpr (ALIGN_EPI) { if (wr == 1) PG8_BAR; }
    }
    PG8_WAIT_V(0);
    if constexpr (!ALIGN_EPI) { if (wr == 0) PG8_BAR; }
    PG8_BAR;
    if constexpr (Epi::AFTER_DRAIN) { E.fused(acc, cur, wr, wc, fr, fq, lds, wid, lane); S.done(cur); }
#undef PG8_SA
#undef PG8_SB
#undef PG8_STAGE
#undef PG8_STAGE_A
#undef PG8_LDA
#undef PG8_LDB
#undef PG8_MMA
#undef PG8_WAIT_V
#undef PG8_WAIT_L
#undef PG8_BAR
#undef PG8_SCHED
}
}

constexpr int NL = 4, D = 1024, SEQ = 16384, CTX = 256, T = SEQ + CTX;
constexpr int IN_COLS = 7472, NIN = 7680;
constexpr int PC_AQ = 0, PC_AK = 512, PC_AV = 1024, PC_AZ = 1536, PC_BQ = 2048, PC_BK = 2304, PC_BV = 2560, PC_BZ = 3072, PC_CQ = 3584, PC_CK = 4096, PC_CV = 4224, PC_GL = 4352, PC_SM = 7424;
constexpr int NE = 32, TOPK = 4, DFF = 1024, MAXRT = 292;
constexpr float EPS = 1e-6f;
constexpr int NPH_PRO = 2, NPH_LAYER = 11, NPH = NPH_PRO + NL * NPH_LAYER;

constexpr size_t MiB = 1u << 20;
constexpr size_t WS_CTL = 0, CTL_ZERO_BYTES = 1 * MiB;
constexpr size_t WS_MOD = 1 * MiB;
constexpr size_t WS_ROPE = 1 * MiB + 512 * 1024;
constexpr size_t WS_WIN = 2 * MiB;
constexpr size_t WS_WBR = 62 * MiB;
constexpr size_t WS_WO = 74 * MiB;
constexpr size_t WS_WGU = 82 * MiB;
constexpr size_t WS_WDN = 594 * MiB;
constexpr size_t WS_XS = 850 * MiB;
constexpr size_t WS_H = 915 * MiB;
constexpr size_t WS_P = 948 * MiB;
constexpr size_t WS_SM = 1192 * MiB;
constexpr size_t WS_DQ = 1197 * MiB, WS_DK = 1230 * MiB, WS_DV = 1263 * MiB;
constexpr size_t WS_DG = 1296 * MiB, WS_DB = 1297 * MiB;
constexpr size_t WS_GK = 1298 * MiB;
constexpr size_t WS_DO = 1331 * MiB, WS_GO = 1396 * MiB;
constexpr size_t WS_YABC = 1461 * MiB, YSTRIDE = (size_t)T * 512 * 2;
constexpr size_t WS_MF = 1510 * MiB;
constexpr size_t WS_MG = 1575 * MiB;
constexpr size_t WS_RT = 1608 * MiB;
constexpr size_t WS_XG = 1610 * MiB, WS_ACT = 1756 * MiB, WS_Y = 1902 * MiB;
constexpr size_t WS_QH = 2048 * MiB;
constexpr size_t WS_GG = 2066 * MiB;
constexpr size_t WS_GD = 2131 * MiB;
constexpr size_t WS_ST = 2132 * MiB;
constexpr size_t WS_DF = 2165 * MiB;
constexpr size_t WS_DU = 2280 * MiB;
constexpr size_t WS_DGT = 2345 * MiB;
constexpr size_t WS_DSN = 1298 * MiB;
constexpr int DSN_BYTES = 49152, DSN_V = 32768;
constexpr size_t WS_WRT = 2346 * MiB;
constexpr size_t WS_HLO = 2347 * MiB;
constexpr size_t WS_QN = WS_DQ, WS_KN = WS_DK;
constexpr size_t WS_END = 2400 * MiB;
constexpr int DF_NW = 0, DF_QD = 16384, DF_QK = 32768, DF_KDT = 40960, DF_BYTES = 57344;
constexpr int CW_BAR = 4096, CW_CNT = 16384;

constexpr int RING_BYTES = 131072, MISC_OFF = RING_BYTES, LDS_BYTES = 163840;

#define GAS __attribute__((address_space(1)))
#define LAS __attribute__((address_space(3)))
typedef unsigned short bf16;
typedef unsigned v4u __attribute__((ext_vector_type(4)));
typedef unsigned v2u __attribute__((ext_vector_type(2)));
typedef float f32x4 __attribute__((ext_vector_type(4)));
typedef short bf16x8 __attribute__((ext_vector_type(8)));
#define LDS_WAIT() asm volatile("s_waitcnt lgkmcnt(0)" ::: "memory")
using pg8::cvt_pk_bf16; using pg8::Unit;
__device__ __forceinline__ float bf_lo(unsigned u) { return __uint_as_float(u << 16); }
__device__ __forceinline__ float bf_hi(unsigned u) { return __uint_as_float(u & 0xffff0000u); }
__device__ __forceinline__ float bf2f(bf16 b) { return __uint_as_float((unsigned)b << 16); }
template <int CTRL> __device__ __forceinline__ float dppf(float v) { return __builtin_bit_cast(float, __builtin_amdgcn_update_dpp(0, __builtin_bit_cast(int, v), CTRL, 0xf, 0xf, true)); }
template <int CTRL> __device__ __forceinline__ int dppi(int v) { return __builtin_amdgcn_update_dpp(0, v, CTRL, 0xf, 0xf, true); }
__device__ __forceinline__ float row_sum4(float v) { v += dppf<0xB1>(v); v += dppf<0x4E>(v); return v; }
__device__ __forceinline__ float row_sum8(float v) { v = row_sum4(v); v += dppf<0x141>(v); return v; }
__device__ __forceinline__ float row_sum16(float v) { v = row_sum8(v); v += dppf<0x140>(v); return v; }
__device__ __forceinline__ float row_max16(float v) { v = fmaxf(v, dppf<0xB1>(v)); v = fmaxf(v, dppf<0x4E>(v)); v = fmaxf(v, dppf<0x141>(v)); v = fmaxf(v, dppf<0x140>(v)); return v; }
__device__ __forceinline__ int row_min16(int v) { v = min(v, dppi<0xB1>(v)); v = min(v, dppi<0x4E>(v)); v = min(v, dppi<0x141>(v)); v = min(v, dppi<0x140>(v)); return v; }
__device__ __forceinline__ float wave_sum(float v) { v = row_sum16(v);
    return (__builtin_bit_cast(float, __builtin_amdgcn_readlane(__builtin_bit_cast(int, v), 0)) + __builtin_bit_cast(float, __builtin_amdgcn_readlane(__builtin_bit_cast(int, v), 16))) + (__builtin_bit_cast(float, __builtin_amdgcn_readlane(__builtin_bit_cast(int, v), 32)) + __builtin_bit_cast(float, __builtin_amdgcn_readlane(__builtin_bit_cast(int, v), 48))); }
__device__ __forceinline__ float wave_max(float v) { v = row_max16(v);
    return fmaxf(fmaxf(__builtin_bit_cast(float, __builtin_amdgcn_readlane(__builtin_bit_cast(int, v), 0)), __builtin_bit_cast(float, __builtin_amdgcn_readlane(__builtin_bit_cast(int, v), 16))), fmaxf(__builtin_bit_cast(float, __builtin_amdgcn_readlane(__builtin_bit_cast(int, v), 32)), __builtin_bit_cast(float, __builtin_amdgcn_readlane(__builtin_bit_cast(int, v), 48)))); }
__device__ __forceinline__ float fexp2(float x) { return __builtin_amdgcn_exp2f(x); }
__device__ __forceinline__ float fexp(float x) { return __builtin_amdgcn_exp2f(x * 1.4426950408889634f); }
__device__ __forceinline__ float flog(float x) { return __builtin_amdgcn_logf(x) * 0.6931471805599453f; }
__device__ __forceinline__ float sigmoid_f(float x) { return __builtin_amdgcn_rcpf(1.0f + fexp(-x)); }
__device__ __forceinline__ float softplus_f(float x) { return fmaxf(x, 0.f) + flog(1.0f + fexp(-fabsf(x))); }


#ifndef PROBE_KIND
#define PROBE_KIND -1
#endif
#ifndef PROBE_N
#define PROBE_N 0
#endif
__device__ __forceinline__ int opq_s(int v);
#define PROBE_REPS(k) (((k) == PROBE_KIND) ? opq_s(PROBE_N + 1) : 1)
#define XB_TMO      128
#define XB_XCNT(j)  (256  + 64 * (j))
#define XB_XSUB(j)  (1280 + 64 * (j))
#define XB_XGEN(j)  (2304 + 64 * (j))
#define XB_TOP      3328
#define XB_TOPGEN   3392
#define XCD_BAR_WORDS 3456
#define XB_SPIN_CAP (1u << 18)

__device__ __forceinline__ unsigned xb_ld(unsigned* p)              { return __hip_atomic_load(p, __ATOMIC_RELAXED, __HIP_MEMORY_SCOPE_AGENT); }
__device__ __forceinline__ unsigned xb_add(unsigned* p, unsigned v) { return __hip_atomic_fetch_add(p, v, __ATOMIC_RELAXED, __HIP_MEMORY_SCOPE_AGENT); }
__device__ __forceinline__ unsigned xb_xcc_id() { return (unsigned)__builtin_amdgcn_s_getreg((3 << 11) | 20) & 0xFu; }
#define XB_SPIN(cond, bar) do { unsigned _sp = 0; while (cond) { __builtin_amdgcn_s_sleep(1); \
    if ((++_sp & 255u) == 0u) { if (xb_ld(&(bar)[XB_TMO])) break; if (_sp > XB_SPIN_CAP) { atomicAdd(&(bar)[XB_TMO], 1u); break; } } } } while (0)

struct XcdBarrier {
    bool lead;
    unsigned* bar; unsigned x;
    volatile LAS unsigned* st;
};

__device__ __forceinline__ XcdBarrier xcd_barrier_post(unsigned* bar, volatile LAS unsigned* st, bool lead) {
    XcdBarrier b; b.lead = lead; b.bar = bar; b.x = xb_xcc_id(); b.st = st;
    if (lead) (void)xb_add(&bar[XB_XCNT(b.x)], 1u);
    return b;
}
__device__ __forceinline__ void xcd_barrier_complete(unsigned* bar, unsigned x, unsigned& nloc, unsigned& nx) {
    const unsigned G = gridDim.x * gridDim.y * gridDim.z;
    unsigned sum, cnt, mine, sp = 0u;
    for (;;) {
        sum = 0u; cnt = 0u; mine = 0u;
#pragma unroll
        for (unsigned j = 0; j < 16; ++j) { const unsigned c = xb_ld(&bar[XB_XCNT(j)]); sum += c; cnt += (c > 0u) ? 1u : 0u; mine = (j == x) ? c : mine; }
        if (sum == G) break;
        __builtin_amdgcn_s_sleep(1);
        if ((++sp & 255u) == 0u) { if (xb_ld(&bar[XB_TMO])) break; if (sp > XB_SPIN_CAP) { atomicAdd(&bar[XB_TMO], 1u); break; } }
    }
    nloc = mine > 0u ? mine : 1u; nx = cnt > 0u ? cnt : 1u;
}

__device__ __forceinline__ void xcd_barrier(const XcdBarrier& b) {
    asm volatile("s_waitcnt vmcnt(0)" ::: "memory");
    __syncthreads();
    if (b.lead) {
        unsigned* bar = b.bar;
        __builtin_amdgcn_s_waitcnt(0);
        unsigned nloc = b.st[0], nx = b.st[1];
        if (nloc == 0u) { xcd_barrier_complete(bar, b.x, nloc, nx); b.st[0] = nloc; b.st[1] = nx; }
        const unsigned old = xb_add(&bar[XB_XSUB(b.x)], 1u);
        const unsigned gen = old / nloc;
        if (old + 1u == (gen + 1u) * nloc) {
            __builtin_amdgcn_fence(__ATOMIC_RELEASE, "agent");
            asm volatile("s_waitcnt vmcnt(0)" ::: "memory");
            const unsigned og = xb_add(&bar[XB_TOP], 1u);
            const unsigned tg = og / nx;
            if (og + 1u == (tg + 1u) * nx) xb_add(&bar[XB_TOPGEN], 1u);
            else XB_SPIN(xb_ld(&bar[XB_TOPGEN]) == tg, bar);
            __builtin_amdgcn_fence(__ATOMIC_ACQUIRE, "agent");
            xb_add(&bar[XB_XGEN(b.x)], 1u);
            asm volatile("s_waitcnt vmcnt(0)" ::: "memory");
        } else {
            XB_SPIN(xb_ld(&bar[XB_XGEN(b.x)]) == gen, bar);
            __builtin_amdgcn_fence(__ATOMIC_ACQUIRE, "agent");
            asm volatile("s_waitcnt vmcnt(0)" ::: "memory");
        }
    }
    __syncthreads();
}

struct Args { const float* in[29]; float* out; unsigned char* ws; int ph_lo, ph_hi; };
typedef const __attribute__((address_space(4))) Args* ArgsP;
__device__ __forceinline__ const float* inp(ArgsP a, int k) { return (const float*)(const GAS float*)a->in[k]; }
__device__ __forceinline__ float* outp(ArgsP a) { return (float*)(GAS float*)a->out; }
struct Frame {
    LAS unsigned char* lds;
    unsigned* ctl;
    int tid, lane, wave, G, bid;
    unsigned char* ws;
};

struct TileOrder {
    static constexpr bool GATHER = false; __device__ __forceinline__ unsigned a_off(int, int) const { return 0u; }
    int nM, nN, nwg, G, c, pm0; const char* A; const char* B; size_t tstepA, tstepB;
    __device__ __forceinline__ void init(int nM_, int nN_, int G_, int c_, const void* A_, const void* B_, int K, int pm0_ = 0) { nM = nM_; nN = nN_; nwg = nM * nN; G = G_; c = c_; pm0 = pm0_; A = (const char*)A_; B = (const char*)B_; tstepA = tstepB = (size_t)256 * K * 2; }
    __device__ __forceinline__ void map(int wgid, Unit& u) const {
        { const int q = nwg / pg8::NXCD, r = nwg % pg8::NXCD, xcd = wgid % pg8::NXCD, off = wgid / pg8::NXCD; wgid = (xcd < r ? xcd * (q + 1) : r * (q + 1) + (xcd - r) * q) + off; }
        const int nig = pg8::WGM * nN, gid = wgid / nig, fm = gid * pg8::WGM, gsz = (nM - fm) < pg8::WGM ? (nM - fm) : pg8::WGM;
        u.pm = pm0 + fm + ((wgid % nig) % gsz); u.pn = (wgid % nig) / gsz;
    }
    __device__ __forceinline__ bool next(int i, Unit& u) const { const long L = (long)i * G + c; if (L >= nwg) return false; map((int)L, u); u.z = 0; return true; }
    __device__ __forceinline__ const char* a_ptr(const Unit& u) const { return A + (size_t)u.pm * tstepA; }
    __device__ __forceinline__ const char* b_ptr(const Unit& u) const { return B + (size_t)u.pn * tstepB; }
    __device__ __forceinline__ void a_ready(const Unit&) const {}
    __device__ __forceinline__ void done(const Unit&) const {}
};
struct BranchOrder : TileOrder {
    size_t zA, zB;
    __device__ __forceinline__ bool next(int i, Unit& u) const { const long L = (long)(i / 3) * G + c; if (L >= nwg) return false; map((int)L, u); u.z = i % 3; return true; }
    __device__ __forceinline__ const char* a_ptr(const Unit& u) const { return A + (size_t)u.z * zA + (size_t)u.pm * tstepA; }
    __device__ __forceinline__ const char* b_ptr(const Unit& u) const { return B + (size_t)u.z * zB + (size_t)u.pn * tstepB; }
};
template <bool GATHER_> struct MoeOrderT {
    static constexpr bool GATHER = GATHER_;
    const LAS int* gidx; unsigned rowbytes;
    __device__ __forceinline__ unsigned a_off(int ui, int row) const { return (unsigned)gidx[ui * 256 + row] * rowbytes; }
    int rt, nN, G, c; const LAS unsigned char* tile_e; const char* A; const char* B; size_t tstepA, tstepB, zB;
    __device__ __forceinline__ bool next(int i, Unit& u) const {
        if ((G & 7) != 0) { const long L = (long)i * G + c; if (L >= (long)rt * nN) return false; u.pm = (int)(L / nN); u.pn = (int)(L % nN); }
        else { const int x = c & 7, cx = c >> 3, gx = G >> 3, lo = (rt * x) >> 3, hi = (rt * (x + 1)) >> 3; const int Lx = i * gx + cx; if (Lx >= (hi - lo) * nN) return false; u.pm = lo + Lx / nN; u.pn = Lx % nN; }
        u.z = __builtin_amdgcn_readfirstlane((int)tile_e[u.pm]); return true; }
    __device__ __forceinline__ const char* a_ptr(const Unit& u) const { return GATHER_ ? A : A + (size_t)u.pm * tstepA; }
    __device__ __forceinline__ const char* b_ptr(const Unit& u) const { return B + (size_t)u.z * zB + (size_t)u.pn * tstepB; }
    __device__ __forceinline__ void a_ready(const Unit&) const {}
    __device__ __forceinline__ void done(const Unit&) const {}
};
typedef MoeOrderT<false> MoeOrder; typedef MoeOrderT<true> MoeGatherOrder;

typedef const pg8::f32x4 (&AccRef)[2][2][4][2];
struct EpiIn {
    static constexpr bool PERM = true, AFTER_DRAIN = false, CHAIN = false;
    bf16* P; float* SM;
    __device__ __forceinline__ void operator()(AccRef acc, const Unit& u, int wr, int wc, int fr, int fq) const {
        const int row0 = u.pm * 256 + wr * 64 + fr, pn = u.pn;
        if (pn == 29) {
            if (wc == 0 || (wc == 1 && fq < 2)) {
#pragma unroll
                for (int ai = 0; ai < 2; ++ai)
#pragma unroll
                    for (int m = 0; m < 4; ++m) { float* rp = SM + (size_t)(row0 + ai * 128 + m * 16) * 64 + wc * 32 + 8 * fq;
                        *(f32x4*)(rp) = acc[ai][0][m][0]; *(f32x4*)(rp + 4) = acc[ai][0][m][1]; }
            }
            return;
        }
        const int kind = (pn <= 5) ? 0 : (pn <= 7) ? 1 : (pn == 8) ? 3 : (pn <= 11) ? 0 : (pn <= 13) ? 1 : (pn <= 16) ? 0 : 2;
#pragma unroll
        for (int ai = 0; ai < 2; ++ai)
#pragma unroll
            for (int m = 0; m < 4; ++m) { bf16* rowp = P + (size_t)(row0 + ai * 128 + m * 16) * NIN + pn * 256 + wc * 32 + 8 * fq;
#pragma unroll
                for (int bj = 0; bj < 2; ++bj) { f32x4 v0 = acc[ai][bj][m][0], v1 = acc[ai][bj][m][1];
                    if (kind == 1) {
#pragma unroll
                        for (int j = 0; j < 4; ++j) { v0[j] = v0[j] * sigmoid_f(v0[j]); v1[j] = v1[j] * sigmoid_f(v1[j]); } }
                    else if (kind == 2) {
#pragma unroll
                        for (int j = 0; j < 4; ++j) { v0[j] = sigmoid_f(v0[j]); v1[j] = sigmoid_f(v1[j]); } }
                    else if (kind == 3) { v0 = v0 * 0.125f; v1 = v1 * 0.125f; }
                    v4u w; w.x = cvt_pk_bf16(v0[0], v0[1]); w.y = cvt_pk_bf16(v0[2], v0[3]); w.z = cvt_pk_bf16(v1[0], v1[1]); w.w = cvt_pk_bf16(v1[2], v1[3]);
                    *(v4u*)(rowp + bj * 128) = w; } }
    }
};
struct EpiBranch {
    static constexpr bool PERM = false, AFTER_DRAIN = false, CHAIN = true;
    const bf16* P; bf16* MG;
    __device__ __forceinline__ bool chain(pg8::f32x4 (&acc)[2][2][4][2], const Unit& u, int wr, int wc, int fr, int fq) const {
        const int row0 = u.pm * 256 + wr * 64 + fr, col0 = u.pn * 256 + wc * 32 + 4 * fq, z = u.z;
#pragma unroll
        for (int ai = 0; ai < 2; ++ai)
#pragma unroll
            for (int m = 0; m < 4; ++m) { const unsigned row = (unsigned)(row0 + ai * 128 + m * 16);
#pragma unroll
                for (int bj = 0; bj < 2; ++bj)
#pragma unroll
                    for (int n = 0; n < 2; ++n) { const int col = col0 + bj * 128 + n * 16;
                        const v2u gw = *(const v2u*)(P + (row * (unsigned)NIN + PC_GL + z * 1024 + col));
                        f32x4 g = (f32x4){bf_lo(gw.x), bf_hi(gw.x), bf_lo(gw.y), bf_hi(gw.y)};
                        if (z < 2) { const v2u gn = *(const v2u*)(P + (row * (unsigned)NIN + PC_GL + (z + 1) * 1024 + col));
                            g[0] *= __builtin_amdgcn_rcpf(fmaxf(bf_lo(gn.x), 1e-30f)); g[1] *= __builtin_amdgcn_rcpf(fmaxf(bf_hi(gn.x), 1e-30f)); g[2] *= __builtin_amdgcn_rcpf(fmaxf(bf_lo(gn.y), 1e-30f)); g[3] *= __builtin_amdgcn_rcpf(fmaxf(bf_hi(gn.y), 1e-30f));
                            acc[ai][bj][m][n] = acc[ai][bj][m][n] * g; }
                        else { const f32x4 v = acc[ai][bj][m][n] * g; v2u o; o.x = cvt_pk_bf16(v[0], v[1]); o.y = cvt_pk_bf16(v[2], v[3]); *(v2u*)(MG + (row * 1024u + col)) = o; } } }
        return z < 2;
    }
    __device__ __forceinline__ void operator()(AccRef, const Unit&, int, int, int, int) const {}
};
struct EpiWo {
    static constexpr bool PERM = false, AFTER_DRAIN = false, CHAIN = false;
    float* XS; const float* modl; const float* modc; bool commit;
    __device__ __forceinline__ void operator()(AccRef acc, const Unit& u, int wr, int wc, int fr, int fq) const {
        const int row0 = u.pm * 256 + wr * 64 + fr, col0 = u.pn * 256 + wc * 32 + 4 * fq; const float* mv = (u.pm == 0) ? modc : modl;
#pragma unroll
        for (int bj = 0; bj < 2; ++bj)
#pragma unroll
            for (int n = 0; n < 2; ++n) { const int col = col0 + bj * 128 + n * 16; const f32x4 g = *(const f32x4*)(mv + col);
#pragma unroll
                for (int ai = 0; ai < 2; ++ai)
#pragma unroll
                    for (int m = 0; m < 4; ++m) { float* xp = XS + (size_t)(row0 + ai * 128 + m * 16) * 1024 + col; const f32x4 v = *(const f32x4*)xp + g * acc[ai][bj][m][n]; if (commit) *(f32x4*)xp = v; else if (v[0] == 1.2345e30f) *xp = 0.f; } }
    }
};
struct EpiMoe1 {
    static constexpr bool PERM = true, AFTER_DRAIN = false, CHAIN = false;
    bf16* ACT; const float* bgu;
    __device__ __forceinline__ void operator()(AccRef acc, const Unit& u, int wr, int wc, int fr, int fq) const {
        const int row0 = u.pm * 256 + wr * 64 + fr, c0 = u.pn * 128 + wc * 32 + 8 * fq; const float* be = bgu + (size_t)u.z * 2048;
        const f32x4 bg0 = *(const f32x4*)(be + c0), bg1 = *(const f32x4*)(be + c0 + 4), bu0 = *(const f32x4*)(be + 1024 + c0), bu1 = *(const f32x4*)(be + 1024 + c0 + 4);
#pragma unroll
        for (int ai = 0; ai < 2; ++ai)
#pragma unroll
            for (int m = 0; m < 4; ++m) { f32x4 g0 = acc[ai][0][m][0] + bg0, g1 = acc[ai][0][m][1] + bg1, u0 = acc[ai][1][m][0] + bu0, u1 = acc[ai][1][m][1] + bu1; f32x4 o0, o1;
#pragma unroll
                for (int j = 0; j < 4; ++j) { float g = fminf(g0[j], 7.0f), uu = fminf(fmaxf(u0[j], -7.0f), 7.0f); o0[j] = (uu + 1.0f) * (g * sigmoid_f(1.702f * g));
                    g = fminf(g1[j], 7.0f); uu = fminf(fmaxf(u1[j], -7.0f), 7.0f); o1[j] = (uu + 1.0f) * (g * sigmoid_f(1.702f * g)); }
                v4u w; w.x = cvt_pk_bf16(o0[0], o0[1]); w.y = cvt_pk_bf16(o0[2], o0[3]); w.z = cvt_pk_bf16(o1[0], o1[1]); w.w = cvt_pk_bf16(o1[2], o1[3]);
                *(v4u*)(ACT + (size_t)(row0 + ai * 128 + m * 16) * 1024 + c0) = w; }
    }
};
struct EpiMoe2 {
    static constexpr bool PERM = true, AFTER_DRAIN = false, CHAIN = false;
    bf16* Y; const float* bdn;
    __device__ __forceinline__ void operator()(AccRef acc, const Unit& u, int wr, int wc, int fr, int fq) const {
        const int row0 = u.pm * 256 + wr * 64 + fr, c0 = u.pn * 256 + wc * 32 + 8 * fq; const float* be = bdn + (size_t)u.z * 1024;
#pragma unroll
        for (int bj = 0; bj < 2; ++bj) { const f32x4 b0 = *(const f32x4*)(be + c0 + bj * 128), b1 = *(const f32x4*)(be + c0 + bj * 128 + 4);
#pragma unroll
            for (int ai = 0; ai < 2; ++ai)
#pragma unroll
                for (int m = 0; m < 4; ++m) { const f32x4 v0 = acc[ai][bj][m][0] + b0, v1 = acc[ai][bj][m][1] + b1;
                    v4u w; w.x = cvt_pk_bf16(v0[0], v0[1]); w.y = cvt_pk_bf16(v0[2], v0[3]); w.z = cvt_pk_bf16(v1[0], v1[1]); w.w = cvt_pk_bf16(v1[2], v1[3]);
                    *(v4u*)(Y + (size_t)(row0 + ai * 128 + m * 16) * 1024 + c0 + bj * 128) = w; } }
    }
};

__device__ __forceinline__ void transpose_item(const float* W, int N, int K, bf16* WT, int k0, int src0, int dst0, int nvalid, LAS float* scr, int lane) {
    const int n = lane & 31;
    float v[32];
#pragma unroll
    for (int i = 0; i < 32; ++i) { const int kk = 2 * i + (lane >> 5); v[i] = (n < nvalid) ? W[(size_t)(k0 + kk) * N + src0 + n] : 0.f; }
    __builtin_amdgcn_sched_barrier(0);
#pragma unroll
    for (int i = 0; i < 32; ++i) { const int kk = 2 * i + (lane >> 5); scr[kk * 33 + n] = v[i]; }
    LDS_WAIT(); asm volatile("" ::: "memory");
    const int c = lane & 7;
#pragma unroll
    for (int j = 0; j < 4; ++j) { const int nn = (lane >> 3) + 8 * j; const LAS float* s = scr + (8 * c) * 33 + nn;
        v4u o; o.x = cvt_pk_bf16(s[0 * 33], s[1 * 33]); o.y = cvt_pk_bf16(s[2 * 33], s[3 * 33]); o.z = cvt_pk_bf16(s[4 * 33], s[5 * 33]); o.w = cvt_pk_bf16(s[6 * 33], s[7 * 33]);
        if (nn < nvalid) *(v4u*)(WT + (size_t)(dst0 + nn) * K + k0 + 8 * c) = o; }
    LDS_WAIT(); asm volatile("" ::: "memory");
}
constexpr int I_IN_L = 16 * 234, I_BR_L = 3 * 8 * 32, I_WO_L = 16 * 32, I_SMALL_L = I_IN_L + I_BR_L + I_WO_L;
__device__ __forceinline__ void convert_small_item(Frame& F, ArgsP a, int l, int r, LAS float* scr) {
    bf16* WIN = (bf16*)(F.ws + WS_WIN); bf16* WBR = (bf16*)(F.ws + WS_WBR); bf16* WO = (bf16*)(F.ws + WS_WO);
    if (r < I_IN_L) { const int kb = r / 234, nb = r % 234; int src, dst, nv = 32;
        if (nb < 64) { src = 32 * nb; dst = 32 * nb; }
        else if (nb < 80) { src = 2064 + 32 * (nb - 64); dst = 2048 + 32 * (nb - 64); }
        else if (nb < 112) { src = 2576 + 32 * (nb - 80); dst = 2560 + 32 * (nb - 80); }
        else if (nb < 136) { src = 3632 + 32 * (nb - 112); dst = 3584 + 32 * (nb - 112); }
        else if (nb < 232) { src = 4400 + 32 * (nb - 136); dst = 4352 + 32 * (nb - 136); }
        else if (nb == 232) { src = 2048; dst = 7424; nv = 16; }
        else { src = 3600; dst = 7440; }
        transpose_item(inp(a, 8) + (size_t)l * 1024 * IN_COLS, IN_COLS, 1024, WIN + (size_t)l * NIN * 1024, kb * 64, src, dst, nv, scr, F.lane); return; }
    r -= I_IN_L;
    if (r < I_BR_L) { const int z = r / 256, q = r % 256, kb = q / 32, nb = q % 32;
        transpose_item(inp(a, 19 + z) + (size_t)l * 512 * 1024, 1024, 512, WBR + (size_t)(l * 3 + z) * 1024 * 512, kb * 64, 32 * nb, 32 * nb, 32, scr, F.lane); return; }
    r -= I_BR_L;
    { const int kb = r / 32, nb = r % 32;
        transpose_item(inp(a, 22) + (size_t)l * 1024 * 1024, 1024, 1024, WO + (size_t)l * 1024 * 1024, kb * 64, 32 * nb, 32 * nb, 32, scr, F.lane); }
}
__device__ __forceinline__ void phase_prologue(Frame& F, ArgsP a) {
    {
        LAS float* sc = (LAS float*)F.lds; LAS float* part = sc + 2048;
        for (int i = F.tid; i < 2048; i += 512) { const float v = (i < 1024) ? inp(a, 1)[i] : inp(a, 3)[i - 1024]; sc[i] = v * sigmoid_f(v); }
        __syncthreads();
        float* MOD = (float*)(F.ws + WS_MOD);
        for (int bi = F.bid; bi < NL * 96; bi += F.G) {
            const int l = bi / 96, jb = bi % 96, cl = F.tid & 63, seg = F.tid >> 6;
            const float* W = inp(a, 4) + (size_t)l * 1024 * 6144 + jb * 64 + cl;
            float a0 = 0.f, a1 = 0.f;
#pragma unroll 8
            for (int k = seg * 128; k < seg * 128 + 128; ++k) { const float w = W[(size_t)k * 6144]; a0 += sc[k] * w; a1 += sc[1024 + k] * w; }
            part[(seg * 64 + cl) * 2] = a0; part[(seg * 64 + cl) * 2 + 1] = a1;
            __syncthreads();
            if (F.tid < 128) { const int c = F.tid & 63, s = F.tid >> 6; float sum = inp(a, 5)[l * 6144 + jb * 64 + c];
                for (int g = 0; g < 8; ++g) sum += part[(g * 64 + c) * 2 + s];
                MOD[(size_t)(l * 2 + s) * 6144 + jb * 64 + c] = sum; }
            __syncthreads();
        }
    }
    for (int i = F.bid * 512 + F.tid; i < 256 * 16; i += F.G * 512) { const float inv = exp2f(-(float)(i & 15) * (13.287712379549449f / 16.0f)); float sn, cs; sincosf((float)(i >> 4) * inv, &sn, &cs);
        float* rp = (float*)(F.ws + WS_ROPE) + (size_t)i * 2; rp[0] = cs; rp[1] = sn; }
    __syncthreads();
    for (int i = F.bid * 512 + F.tid; i < NL * 32 * 1024; i += F.G * 512) { const int l = i >> 15, e = (i >> 10) & 31, c = i & 1023; const float w = inp(a, 23)[(size_t)l * 32768 + c * 32 + e];
        const unsigned hi = cvt_pk_bf16(w, 0.f) & 0xffffu; const float lo = w - __uint_as_float(hi << 16);
        bf16* wr = (bf16*)(F.ws + WS_WRT) + (size_t)l * 65536 + e * 1024 + c; wr[0] = (bf16)hi; wr[32768] = (bf16)(cvt_pk_bf16(lo, 0.f) & 0xffffu); }
    LAS float* scr = (LAS float*)(F.lds + F.wave * 16384);
    const int gw = F.bid * 8 + F.wave, NGW = F.G * 8;
    bf16* WIN = (bf16*)(F.ws + WS_WIN); bf16* WBR = (bf16*)(F.ws + WS_WBR); bf16* WO = (bf16*)(F.ws + WS_WO); bf16* WGU = (bf16*)(F.ws + WS_WGU); bf16* WDN = (bf16*)(F.ws + WS_WDN);
    constexpr int I_IN = 16 * 234, I_BR = 8 * 32, I_WO = 16 * 32, I_GU = 16 * 64, I_DN = 16 * 32;
    constexpr int N_IN = NL * I_IN, N_BR = NL * 3 * I_BR, N_WO = NL * I_WO, N_GU = NL * NE * I_GU, N_DN = NL * NE * I_DN;
    if (F.G >= 160) { for (int it = gw; it < I_IN_L; it += NGW) convert_small_item(F, a, 0, it, scr); }
    else for (int it = gw; it < N_IN + N_BR + N_WO + N_GU + N_DN; it += NGW) {
        int r = it;
        if (r < N_IN) { const int l = r / I_IN; r %= I_IN; const int kb = r / 234, nb = r % 234; int src, dst, nv = 32;
            if (nb < 64) { src = 32 * nb; dst = 32 * nb; }
            else if (nb < 80) { src = 2064 + 32 * (nb - 64); dst = 2048 + 32 * (nb - 64); }
            else if (nb < 112) { src = 2576 + 32 * (nb - 80); dst = 2560 + 32 * (nb - 80); }
            else if (nb < 136) { src = 3632 + 32 * (nb - 112); dst = 3584 + 32 * (nb - 112); }
            else if (nb < 232) { src = 4400 + 32 * (nb - 136); dst = 4352 + 32 * (nb - 136); }
            else if (nb == 232) { src = 2048; dst = 7424; nv = 16; }
            else { src = 3600; dst = 7440; }
            transpose_item(inp(a, 8) + (size_t)l * 1024 * IN_COLS, IN_COLS, 1024, WIN + (size_t)l * NIN * 1024, kb * 64, src, dst, nv, scr, F.lane); continue; }
        r -= N_IN;
        if (r < N_BR) { const int lz = r / I_BR; r %= I_BR; const int l = lz / 3, z = lz % 3, kb = r / 32, nb = r % 32;
            transpose_item(inp(a, 19 + z) + (size_t)l * 512 * 1024, 1024, 512, WBR + (size_t)lz * 1024 * 512, kb * 64, 32 * nb, 32 * nb, 32, scr, F.lane); continue; }
        r -= N_BR;
        if (r < N_WO) { const int l = r / I_WO; r %= I_WO; const int kb = r / 32, nb = r % 32;
            transpose_item(inp(a, 22) + (size_t)l * 1024 * 1024, 1024, 1024, WO + (size_t)l * 1024 * 1024, kb * 64, 32 * nb, 32 * nb, 32, scr, F.lane); continue; }
        r -= N_WO;
        if (r < N_GU) { const int le = r / I_GU; r %= I_GU; const int kb = r / 64, nb = r % 64;
            const int dst = (nb < 32) ? 256 * (nb >> 2) + 32 * (nb & 3) : 256 * ((nb - 32) >> 2) + 128 + 32 * ((nb - 32) & 3);
            transpose_item(inp(a, 25) + (size_t)le * 1024 * 2048, 2048, 1024, WGU + (size_t)le * 2048 * 1024, kb * 64, 32 * nb, dst, 32, scr, F.lane); continue; }
        r -= N_GU;
        { const int le = r / I_DN; r %= I_DN; const int kb = r / 32, nb = r % 32;
            transpose_item(inp(a, 27) + (size_t)le * 1024 * 1024, 1024, 1024, WDN + (size_t)le * 1024 * 1024, kb * 64, 32 * nb, 32 * nb, 32, scr, F.lane); }
    }
    for (int i = F.bid * 512 + F.tid; i < NL * 208 * 128; i += F.G * 512) { const int l = i / (208 * 128), r = i % (208 * 128);
        *(v4u*)(WIN + (size_t)l * NIN * 1024 + (size_t)7472 * 1024 + (size_t)r * 8) = (v4u){0u, 0u, 0u, 0u}; }
}

__device__ __forceinline__ void norm_mod_store(const f32x4 (&x)[4], const float* gain, const float* shift, const float* scale, bf16* hrow, int lane, f32x4 (&h)[4]) {
    float ss = 0.f;
#pragma unroll
    for (int j = 0; j < 4; ++j) ss += (x[j][0] * x[j][0] + x[j][1] * x[j][1]) + (x[j][2] * x[j][2] + x[j][3] * x[j][3]);
    const float rstd = rsqrtf(wave_sum(ss) * (1.0f / 1024.0f) + EPS);
#pragma unroll
    for (int j = 0; j < 4; ++j) { const int c = 4 * lane + 256 * j; const f32x4 g = *(const f32x4*)(gain + c), sh = *(const f32x4*)(shift + c), sc = *(const f32x4*)(scale + c);
        h[j] = (x[j] * rstd * g) * (sc + 1.0f) + sh;
        v2u o; o.x = cvt_pk_bf16(h[j][0], h[j][1]); o.y = cvt_pk_bf16(h[j][2], h[j][3]); *(v2u*)(hrow + c) = o; }
}
__device__ __forceinline__ void load_mod(const float* gain, const float* shift, const float* scale, int lane, f32x4 (&gs)[4], f32x4 (&sh)[4]) {
#pragma unroll
    for (int j = 0; j < 4; ++j) { const int c = 4 * lane + 256 * j; gs[j] = *(const f32x4*)(gain + c) * (*(const f32x4*)(scale + c) + 1.0f); sh[j] = *(const f32x4*)(shift + c); }
}
__device__ __forceinline__ void norm_mod_store2(const f32x4 (&x)[4], const f32x4 (&gs)[4], const f32x4 (&sh)[4], bf16* hrow, int lane, f32x4 (&h)[4]) {
    float ss = 0.f;
#pragma unroll
    for (int j = 0; j < 4; ++j) ss += (x[j][0] * x[j][0] + x[j][1] * x[j][1]) + (x[j][2] * x[j][2] + x[j][3] * x[j][3]);
    const float rstd = rsqrtf(wave_sum(ss) * (1.0f / 1024.0f) + EPS);
#pragma unroll
    for (int j = 0; j < 4; ++j) { h[j] = (x[j] * rstd) * gs[j] + sh[j];
        v2u o; o.x = cvt_pk_bf16(h[j][0], h[j][1]); o.y = cvt_pk_bf16(h[j][2], h[j][3]); *(v2u*)(hrow + 4 * lane + 256 * j) = o; }
}
__device__ __forceinline__ void phase_norm0(Frame& F, ArgsP a) {
    float* XS = (float*)(F.ws + WS_XS); bf16* H = (bf16*)(F.ws + WS_H); const float* MOD = (const float*)(F.ws + WS_MOD);
    for (int t = F.bid * 8 + F.wave; t < T; t += F.G * 8) {
        const float* src = (t < CTX) ? inp(a, 2) + (size_t)t * 1024 : inp(a, 0) + (size_t)(t - CTX) * 1024;
        f32x4 x[4], h[4];
#pragma unroll
        for (int j = 0; j < 4; ++j) { x[j] = *(const f32x4*)(src + 4 * F.lane + 256 * j); *(f32x4*)(XS + (size_t)t * 1024 + 4 * F.lane + 256 * j) = x[j]; }
        const float* mv = MOD + (size_t)((t < CTX) ? 1 : 0) * 6144;
        norm_mod_store(x, inp(a, 6), mv, mv + 1024, H + (size_t)t * 1024, F.lane, h);
    }
}

__device__ __forceinline__ void phase_prep(Frame& F, ArgsP a, int l) {
    const bf16* P = (const bf16*)(F.ws + WS_P);
    const int lane = F.lane;
    for (int t = F.bid * 8 + F.wave; t < T; t += F.G * 8) {
#pragma unroll
        for (int qk = 0; qk < 2; ++qk) {
            const bf16* ptr = P + (size_t)t * NIN + (qk == 0 ? PC_CQ : PC_CK) + 8 * lane;
            bf16* optr = (qk == 0) ? (bf16*)(F.ws + WS_QN) + (size_t)t * 512 + 8 * lane : (bf16*)(F.ws + WS_KN) + (size_t)t * 128 + 8 * lane;
            const bool act = (qk == 0) || (lane < 16);
            const v4u xv = act ? *(const v4u*)ptr : (v4u){0u, 0u, 0u, 0u};
            float y[8] = {bf_lo(xv.x), bf_hi(xv.x), bf_lo(xv.y), bf_hi(xv.y), bf_lo(xv.z), bf_hi(xv.z), bf_lo(xv.w), bf_hi(xv.w)};
            float ss = 0.f;
#pragma unroll
            for (int i = 0; i < 8; ++i) ss += y[i] * y[i];
            ss = row_sum8(ss);
            const float r = rsqrtf(ss * (1.0f / 64.0f) + EPS); const float* gn = inp(a, qk == 0 ? 16 : 17) + l * 64 + 8 * (lane & 7);
#pragma unroll
            for (int i = 0; i < 8; ++i) y[i] = y[i] * r * gn[i];
            if (t >= CTX) { const int p = t - CTX, hl = lane & 7; const int pos = (hl < 4) ? (p >> 6) : (p & 63); const int i0 = 8 * (hl & 1); const bool first = (hl & 2) == 0;
                const float* rp = (const float*)(F.ws + WS_ROPE) + ((size_t)pos * 16 + i0) * 2;
#pragma unroll
                for (int i2 = 0; i2 < 4; ++i2) { const f32x4 cs = *(const f32x4*)(rp + 4 * i2);
#pragma unroll
                    for (int u = 0; u < 2; ++u) { const int i = 2 * i2 + u; const float other = dppf<0x4E>(y[i]); const float c_ = cs[2 * u], s_ = cs[2 * u + 1];
                        y[i] = first ? (y[i] * c_ - other * s_) : (y[i] * c_ + other * s_); } } }
            if (act) { v4u o; o.x = cvt_pk_bf16(y[0], y[1]); o.y = cvt_pk_bf16(y[2], y[3]); o.z = cvt_pk_bf16(y[4], y[5]); o.w = cvt_pk_bf16(y[6], y[7]); *(v4u*)optr = o; }
        }
    }
}

__device__ __forceinline__ int scan_tok(int d, int n, int i) {
    if (n < 4) { const int p = 64 * n + i; return d ? (CTX - 1 - p) : p; }
    const int p = 64 * (n - 4) + i; return CTX + (d ? (SEQ - 1 - p) : p);
}
#define LSYNC() do { asm volatile("s_waitcnt lgkmcnt(0)" ::: "memory"); __builtin_amdgcn_s_barrier(); asm volatile("" ::: "memory"); } while (0)
__device__ __forceinline__ int chunk_tok0(int n) { return (n < 4) ? 64 * n : CTX + 64 * (n - 4); }
__device__ __forceinline__ int scan_chunk(int d, int s) { return d ? ((s < 4) ? 3 - s : 263 - s) : s; }
template <class Emit> __device__ __forceinline__ void tri_solve_blocked(const LAS float* L, const LAS bf16* Lbf, LAS bf16* TT  , LAS float* Y  , int lane, const Emit& emit) {
    const int fr = lane & 15, fq = lane >> 4;
#pragma unroll
    for (int k = 0; k < 8; ++k) *(LAS v4u*)(TT + lane * 64 + 8 * k) = (v4u){0u, 0u, 0u, 0u};
#pragma unroll
    for (int i = 0; i < 4; ++i) {
        float y[16];
#pragma unroll
        for (int r = 0; r < 16; ++r) y[r] = 0.f;
        if (i > 0) {
#pragma unroll
            for (int nt = 0; nt < i; ++nt) { f32x4 acc = (f32x4){0.f, 0.f, 0.f, 0.f};
#pragma unroll
                for (int ks = 0; ks < (i + 1) / 2; ++ks) { bf16x8 af = *(const LAS bf16x8*)(Lbf + (16 * i + fr) * 72 + 32 * ks + 8 * fq); if (32 * ks + 8 * fq >= 16 * i) af = (bf16x8){0, 0, 0, 0, 0, 0, 0, 0};
                    acc = __builtin_amdgcn_mfma_f32_16x16x32_bf16(af, *(const LAS bf16x8*)(TT + (16 * nt + fr) * 64 + 32 * ks + 8 * fq), acc, 0, 0, 0); }
#pragma unroll
                for (int jj = 0; jj < 4; ++jj) Y[(4 * fq + jj) * 64 + 16 * nt + fr] = acc[jj]; }
            asm volatile("s_waitcnt lgkmcnt(0)" ::: "memory");
#pragma unroll
            for (int r = 0; r < 16; ++r) { const float v = Y[r * 64 + lane]; y[r] = (lane < 16 * i) ? v : 0.f; }
        }
        float X[16];
#pragma unroll
        for (int r = 0; r < 16; ++r) { float acc = ((lane == 16 * i + r) ? 1.0f : 0.0f) - y[r];
#pragma unroll
            for (int s4 = 0; s4 < (r + 3) / 4; ++s4) { const f32x4 lv = *(const LAS f32x4*)(L + (16 * i + r) * 64 + 16 * i + 4 * s4);
#pragma unroll
                for (int u = 0; u < 4; ++u) if (4 * s4 + u < r) acc -= lv[u] * X[4 * s4 + u]; }
            X[r] = acc; emit(16 * i + r, acc); }
        { v4u w0, w1; w0.x = cvt_pk_bf16(X[0], X[1]); w0.y = cvt_pk_bf16(X[2], X[3]); w0.z = cvt_pk_bf16(X[4], X[5]); w0.w = cvt_pk_bf16(X[6], X[7]); w1.x = cvt_pk_bf16(X[8], X[9]); w1.y = cvt_pk_bf16(X[10], X[11]); w1.z = cvt_pk_bf16(X[12], X[13]); w1.w = cvt_pk_bf16(X[14], X[15]);
          *(LAS v4u*)(TT + lane * 64 + 16 * i) = w0; *(LAS v4u*)(TT + lane * 64 + 16 * i + 8) = w1; }
        asm volatile("s_waitcnt lgkmcnt(0)" ::: "memory");
    }
}
__device__ __forceinline__ void dn_prep_item(Frame& F, ArgsP a, int l, int item) {
    int tid_ = F.tid; asm volatile("" : "+v"(tid_));
    const int n = item % 260, h = item / 260, t0 = chunk_tok0(n), s0 = (n < 4) ? 0 : CTX, s1 = (n < 4) ? CTX : T, tid = tid_, lane = tid & 63, wv = __builtin_amdgcn_readfirstlane(tid >> 6), fr = lane & 15, fq = lane >> 4;
    LAS bf16* RAW = (LAS bf16*)F.lds;
    LAS float* Lm = (LAS float*)F.lds;
    LAS bf16* Lb = (LAS bf16*)(F.lds + 32768);
    LAS bf16* Qs = (LAS bf16*)(F.lds + 52224); LAS bf16* Ks = Qs + 64 * 136;
    LAS bf16* TPb = Qs;
    LAS bf16* KT = (LAS bf16*)(F.lds + 87040); LAS bf16* VT = KT + 128 * 72;
    LAS float* gc = (LAS float*)(F.lds + 123904); LAS float* be = gc + 128; LAS float* SS = be + 128;
    const bf16* P = (const bf16*)(F.ws + WS_P); const float* SM = (const float*)(F.ws + WS_SM);
    unsigned char* DF0 = F.ws + WS_DF + (size_t)(h * 260 + n) * DF_BYTES; unsigned char* DF1 = DF0 + (size_t)4 * 260 * DF_BYTES;
    bf16* DU0 = (bf16*)(F.ws + WS_DU) + (size_t)(h * 260 + n) * 8192; bf16* DU1 = DU0 + (size_t)4 * 260 * 8192;
    __syncthreads();
    LAS float* CW = (LAS float*)(F.lds + MISC_OFF + 2560);
    for (int idx = tid; idx < 68 * 48; idx += 512) { const int rr = idx / 48, ch = idx % 48, p = ch >> 4, c8 = (ch & 15) * 8, tok = t0 - 2 + rr;
        v4u x = (v4u){0u, 0u, 0u, 0u}; if (tok >= s0 && tok < s1) x = *(const v4u*)(P + (size_t)tok * NIN + PC_AQ + p * 512 + h * 128 + c8);
        *(LAS v4u*)(RAW + rr * 384 + p * 128 + c8) = x; }
    for (int idx = tid; idx < 5 * 384; idx += 512) { const int j = idx / 384, c = idx % 384; CW[idx] = inp(a, 9)[(size_t)(l * 5 + j) * 1536 + (c >> 7) * 512 + h * 128 + (c & 127)]; }
    if (wv < 2) { const int d = wv; const float aa = SM[(size_t)(t0 + lane) * 64 + d * 4 + h], ab = SM[(size_t)(t0 + lane) * 64 + 8 + d * 4 + h];
        float v = -fexp(inp(a, 10)[l * 8 + d * 4 + h]) * softplus_f(aa + inp(a, 11)[l * 8 + d * 4 + h]);
#pragma unroll
        for (int o = 1; o < 64; o <<= 1) { const float u = d ? __shfl_down(v, o) : __shfl_up(v, o); if (d ? (lane + o < 64) : (lane >= o)) v += u; }
        gc[d * 64 + lane] = v; be[d * 64 + lane] = sigmoid_f(ab); }
    __syncthreads();
    if (tid < 384) { const int co = tid % 48, pg = tid / 48, p = co >> 4, c0 = 8 * (co & 15), cr = p * 128 + c0;
        float w[5][8];
#pragma unroll
        for (int j = 0; j < 5; ++j) { const f32x4 wa = *(const LAS f32x4*)(CW + j * 384 + cr), wb = *(const LAS f32x4*)(CW + j * 384 + cr + 4);
            w[j][0] = wa[0]; w[j][1] = wa[1]; w[j][2] = wa[2]; w[j][3] = wa[3]; w[j][4] = wb[0]; w[j][5] = wb[1]; w[j][6] = wb[2]; w[j][7] = wb[3]; }
        float val[8][8];
#pragma unroll
        for (int i = 0; i < 8; ++i)
#pragma unroll
            for (int c = 0; c < 8; ++c) val[i][c] = 0.f;
#pragma unroll
        for (int rr = 0; rr < 12; ++rr) { const v4u xv = *(const LAS v4u*)(RAW + (8 * pg + rr) * 384 + cr);
            const float x[8] = {bf_lo(xv.x), bf_hi(xv.x), bf_lo(xv.y), bf_hi(xv.y), bf_lo(xv.z), bf_hi(xv.z), bf_lo(xv.w), bf_hi(xv.w)};
#pragma unroll
            for (int j = 0; j < 5; ++j) { const int i = rr - j; if (i >= 0 && i < 8) {
#pragma unroll
                for (int c = 0; c < 8; ++c) val[i][c] += x[c] * w[j][c]; } } }
        unsigned pk[8][4];
#pragma unroll
        for (int i = 0; i < 8; ++i) { float ss = 0.f;
#pragma unroll
            for (int c = 0; c < 8; ++c) { val[i][c] = val[i][c] * sigmoid_f(val[i][c]); ss += val[i][c] * val[i][c]; }
            ss = row_sum16(ss);
            const float rn = (p == 2) ? 1.0f : rsqrtf(ss + EPS) * ((p == 0) ? 0.08838834764831845f : 1.0f);
#pragma unroll
            for (int c2 = 0; c2 < 4; ++c2) pk[i][c2] = cvt_pk_bf16(val[i][2 * c2] * rn, val[i][2 * c2 + 1] * rn);
            if (p < 2) *(LAS v4u*)(((p == 0) ? Qs : Ks) + (8 * pg + i) * 136 + c0) = (v4u){pk[i][0], pk[i][1], pk[i][2], pk[i][3]}; }
        if (p >= 1) { LAS bf16* TT = (p == 1) ? KT : VT;
#pragma unroll
            for (int c2 = 0; c2 < 4; ++c2) { v4u lo_, hi_;
                lo_.x = (pk[0][c2] & 0xffffu) | (pk[1][c2] << 16); lo_.y = (pk[2][c2] & 0xffffu) | (pk[3][c2] << 16); lo_.z = (pk[4][c2] & 0xffffu) | (pk[5][c2] << 16); lo_.w = (pk[6][c2] & 0xffffu) | (pk[7][c2] << 16);
                hi_.x = (pk[0][c2] >> 16) | (pk[1][c2] & 0xffff0000u); hi_.y = (pk[2][c2] >> 16) | (pk[3][c2] & 0xffff0000u); hi_.z = (pk[4][c2] >> 16) | (pk[5][c2] & 0xffff0000u); hi_.w = (pk[6][c2] >> 16) | (pk[7][c2] & 0xffff0000u);
                *(LAS v4u*)(TT + (c0 + 2 * c2) * 72 + 8 * pg) = lo_; *(LAS v4u*)(TT + (c0 + 2 * c2 + 1) * 72 + 8 * pg) = hi_; } } }
    __syncthreads();
    for (int r33_ = 0; r33_ < PROBE_REPS(33); ++r33_)
    { const int which = wv >> 2, it = wv & 3; const LAS bf16* Bsrc = which ? Qs : Ks;
      f32x4 gt4[4];
#pragma unroll
      for (int jt = 0; jt < 4; ++jt) { f32x4 acc = (f32x4){0.f, 0.f, 0.f, 0.f};
#pragma unroll
          for (int ks = 0; ks < 4; ++ks) acc = __builtin_amdgcn_mfma_f32_16x16x32_bf16(*(const LAS bf16x8*)(Ks + (16 * jt + fr) * 136 + 32 * ks + 8 * fq), *(const LAS bf16x8*)(Bsrc + (16 * it + fr) * 136 + 32 * ks + 8 * fq), acc, 0, 0, 0);
          gt4[jt] = acc; }
      const int i = 16 * it + fr;
#pragma unroll
      for (int d = 0; d < 2; ++d) { const float gi = gc[d * 64 + i], bi = be[d * 64 + i];
          if (which == 0) {
#pragma unroll
              for (int jt = 0; jt < 4; ++jt) { const int j0 = 16 * jt + 4 * fq; const f32x4 gj = *(const LAS f32x4*)(gc + d * 64 + j0); f32x4 lv;
#pragma unroll
                  for (int jj = 0; jj < 4; ++jj) { const int j = j0 + jj; const bool keep = d ? (i < j) : (i > j); lv[jj] = keep ? bi * gt4[jt][jj] * fexp(gi - gj[jj]) : 0.f; }
                  if (d == 0) { *(LAS f32x4*)(Lm + i * 64 + j0) = lv; v2u b; b.x = cvt_pk_bf16(lv[0], lv[1]); b.y = cvt_pk_bf16(lv[2], lv[3]); *(LAS v2u*)(Lb + i * 72 + j0) = b; }
                  else { *(LAS f32x4*)(Lm + 4096 + (63 - i) * 64 + (60 - j0)) = (f32x4){lv[3], lv[2], lv[1], lv[0]}; v2u b; b.x = cvt_pk_bf16(lv[3], lv[2]); b.y = cvt_pk_bf16(lv[1], lv[0]); *(LAS v2u*)(Lb + 4608 + (63 - i) * 72 + (60 - j0)) = b; } } }
          else { unsigned char* DF = d ? DF1 : DF0;
#pragma unroll
              for (int ks = 0; ks < 2; ++ks) { float f[8];
#pragma unroll
                  for (int t2 = 0; t2 < 2; ++t2) { const int jt = 2 * ks + t2, j0 = 16 * jt + 4 * fq; const f32x4 gj = *(const LAS f32x4*)(gc + d * 64 + j0);
#pragma unroll
                      for (int jj = 0; jj < 4; ++jj) { const int j = j0 + jj; const bool keep = d ? (i <= j) : (i >= j); f[4 * t2 + jj] = keep ? gt4[jt][jj] * fexp(gi - gj[jj]) : 0.f; } }
                  v4u w; w.x = cvt_pk_bf16(f[0], f[1]); w.y = cvt_pk_bf16(f[2], f[3]); w.z = cvt_pk_bf16(f[4], f[5]); w.w = cvt_pk_bf16(f[6], f[7]);
                  *(v4u*)(DF + DF_QK + (size_t)((it * 2 + ks) * 64 + lane) * 16) = w; } } }
      { const int mt = wv & 3, pos = 16 * mt + fr;
#pragma unroll
        for (int kk = 0; kk < 2; ++kk) { const int ks = (wv >> 2) * 2 + kk; const v2u qa = *(const LAS v2u*)(Qs + pos * 136 + 32 * ks + 4 * fq), qb = *(const LAS v2u*)(Qs + pos * 136 + 32 * ks + 16 + 4 * fq);
#pragma unroll
            for (int d = 0; d < 2; ++d) { const float e = fexp(gc[d * 64 + pos]); v4u w; w.x = cvt_pk_bf16(bf_lo(qa.x) * e, bf_hi(qa.x) * e); w.y = cvt_pk_bf16(bf_lo(qa.y) * e, bf_hi(qa.y) * e); w.z = cvt_pk_bf16(bf_lo(qb.x) * e, bf_hi(qb.x) * e); w.w = cvt_pk_bf16(bf_lo(qb.y) * e, bf_hi(qb.y) * e);
                *(v4u*)((d ? DF1 : DF0) + DF_QD + (size_t)((mt * 4 + ks) * 64 + lane) * 16) = w; } } }
      { const int d = wv >> 2; const float ge = gc[d * 64 + (d ? 0 : 63)];
#pragma unroll
        for (int q2 = 0; q2 < 2; ++q2) { const int dt = 2 * (wv & 3) + q2, dk = 16 * dt + fr;
#pragma unroll
            for (int ks = 0; ks < 2; ++ks) { const int p0 = 32 * ks + 4 * fq; const v2u ka = *(const LAS v2u*)(KT + dk * 72 + p0), kb = *(const LAS v2u*)(KT + dk * 72 + p0 + 16);
                const f32x4 ga = *(const LAS f32x4*)(gc + d * 64 + p0), gb = *(const LAS f32x4*)(gc + d * 64 + p0 + 16);
                v4u w; w.x = cvt_pk_bf16(bf_lo(ka.x) * fexp(ge - ga[0]), bf_hi(ka.x) * fexp(ge - ga[1])); w.y = cvt_pk_bf16(bf_lo(ka.y) * fexp(ge - ga[2]), bf_hi(ka.y) * fexp(ge - ga[3]));
                w.z = cvt_pk_bf16(bf_lo(kb.x) * fexp(ge - gb[0]), bf_hi(kb.x) * fexp(ge - gb[1])); w.w = cvt_pk_bf16(bf_lo(kb.y) * fexp(ge - gb[2]), bf_hi(kb.y) * fexp(ge - gb[3]));
                *(v4u*)((d ? DF1 : DF0) + DF_KDT + (size_t)((dt * 2 + ks) * 64 + lane) * 16) = w; } } }
      if (tid < 2) ((float*)(F.ws + WS_DGT))[(size_t)(tid * 4 + h) * 260 + n] = fexp(gc[tid * 64 + (tid ? 0 : 63)]);
    }
    __syncthreads();
    if (wv < 2) { const int d = wv; const int j = d ? 63 - lane : lane; const float bj = be[d * 64 + j], ej = bj * fexp(gc[d * 64 + j]);
        LAS bf16* TP = TPb + (2 * d) * 4096; LAS bf16* TPP = TP + 4096;
        LAS bf16* TT = (LAS bf16*)(F.lds + MISC_OFF + 2560) + d * 4096; LAS float* Yb = (LAS float*)(F.lds + MISC_OFF + 2560 + 16384) + d * 1024;
        tri_solve_blocked(Lm + d * 4096, Lb + d * 4608, TT, Yb, lane, [&](int r, float x) { const int i = d ? 63 - r : r; const unsigned w = cvt_pk_bf16(x * ej, x * bj); TP[i * 64 + j] = (bf16)(w & 0xffffu); TPP[i * 64 + j] = (bf16)(w >> 16); }); }
    __syncthreads();
    for (int r34_ = 0; r34_ < PROBE_REPS(34); ++r34_)
    { const int d = wv >> 2, w4 = wv & 3; const LAS bf16* TP = TPb + (2 * d) * 4096; const LAS bf16* TPP = TP + 4096; unsigned char* DF = d ? DF1 : DF0; bf16* DU = d ? DU1 : DU0;
#pragma unroll
      for (int it = 0; it < 4; ++it) { f32x4 acc[2];
#pragma unroll
          for (int q2 = 0; q2 < 2; ++q2) { acc[q2] = (f32x4){0.f, 0.f, 0.f, 0.f};
#pragma unroll
              for (int ks = 0; ks < 2; ++ks) acc[q2] = __builtin_amdgcn_mfma_f32_16x16x32_bf16(*(const LAS bf16x8*)(KT + (16 * (2 * w4 + q2) + fr) * 72 + 32 * ks + 8 * fq), *(const LAS bf16x8*)(TP + (16 * it + fr) * 64 + 32 * ks + 8 * fq), acc[q2], 0, 0, 0); }
          v4u w; w.x = cvt_pk_bf16(-acc[0][0], -acc[0][1]); w.y = cvt_pk_bf16(-acc[0][2], -acc[0][3]); w.z = cvt_pk_bf16(-acc[1][0], -acc[1][1]); w.w = cvt_pk_bf16(-acc[1][2], -acc[1][3]);
          *(v4u*)(DF + DF_NW + (size_t)((it * 4 + w4) * 64 + lane) * 16) = w; }
#pragma unroll
      for (int q2 = 0; q2 < 2; ++q2) { const int dvt = 2 * w4 + q2;
#pragma unroll
          for (int it = 0; it < 4; ++it) { f32x4 acc = (f32x4){0.f, 0.f, 0.f, 0.f};
#pragma unroll
              for (int ks = 0; ks < 2; ++ks) acc = __builtin_amdgcn_mfma_f32_16x16x32_bf16(*(const LAS bf16x8*)(TPP + (16 * it + fr) * 64 + 32 * ks + 8 * fq), *(const LAS bf16x8*)(VT + (16 * dvt + fr) * 72 + 32 * ks + 8 * fq), acc, 0, 0, 0);
              { v2u w; w.x = cvt_pk_bf16(acc[0], acc[1]); w.y = cvt_pk_bf16(acc[2], acc[3]); *(v2u*)(DU + (size_t)((dvt * 4 + it) * 64 + lane) * 4) = w; } } } }
}
__device__ __forceinline__ void dn_scan_item(Frame& F, int item) {
    int tid_ = F.tid; asm volatile("" : "+v"(tid_));
    const int dh = item >> 3, d = dh >> 2, tid = tid_, lane = tid & 63, wv = __builtin_amdgcn_readfirstlane(tid >> 6);
    const unsigned char* DF = F.ws + WS_DF; const unsigned char* DU = F.ws + WS_DU; unsigned char* SN = F.ws + WS_DSN;
    LAS float* gts = (LAS float*)(F.lds + MISC_OFF + 1024);
    LAS unsigned char* uring = F.lds + MISC_OFF + 2560;
    const int dvl = 0, dvt = item & 7;
    const bool comp = wv < 1, stg = wv >= 4;
    f32x4 S[8]; bf16x8 Sb[4]; bf16x8 fw[4][4];
#pragma unroll
    for (int i = 0; i < 8; ++i) S[i] = (f32x4){0.f, 0.f, 0.f, 0.f};
#pragma unroll
    for (int i = 0; i < 4; ++i) Sb[i] = (bf16x8){0, 0, 0, 0, 0, 0, 0, 0};
    auto issue_nk = [&](int s) { const int sc = s < 260 ? s : 259; const unsigned char* src = DF + (size_t)(dh * 260 + scan_chunk(d, sc)) * DF_BYTES; const int slot = s & 3;
#pragma unroll
        for (int k = 0; k < 8; ++k) { const int p = (wv - 4) + 4 * k; const int off = (p < 16) ? DF_NW + p * 1024 : DF_KDT + (p - 16) * 1024;
            __builtin_amdgcn_global_load_lds((const unsigned*)(src + off + lane * 16), (LAS unsigned*)(F.lds + slot * 32768 + p * 1024), 16, 0, 0); } };
    auto issue_u = [&](int s, int uslot) { const int sc = s < 260 ? s : 259; const unsigned char* src = DU + (size_t)(dh * 260 + scan_chunk(d, sc)) * 16384 + dvt * 2048;
        if (wv < 6) { const int p = wv - 4; __builtin_amdgcn_global_load_lds((const unsigned*)(src + p * 1024 + lane * 16), (LAS unsigned*)(uring + uslot * 4096 + p * 1024), 16, 0, 0); } };
    __syncthreads();
    if (tid < 260) gts[tid] = ((const float*)(F.ws + WS_DGT))[dh * 260 + tid];
    if (stg) { issue_nk(0); issue_nk(1); issue_u(0, 0); issue_nk(2); issue_u(1, 1); }
    auto step = [&](int s, int uslot, int uslot2) {
        if (stg) { if (wv < 6) asm volatile("s_waitcnt vmcnt(9)" ::: "memory"); else asm volatile("s_waitcnt vmcnt(8)" ::: "memory"); }
        asm volatile("s_waitcnt lgkmcnt(0)" ::: "memory"); __builtin_amdgcn_s_barrier(); asm volatile("" ::: "memory");
        if (stg) { issue_nk(s + 3); issue_u(s + 2, uslot2); }
        if (comp) {
            const int n = scan_chunk(d, s);
            const LAS unsigned char* buf = F.lds + (s & 3) * 32768;
            const float gt = gts[n];
            unsigned char* sn = SN + (size_t)(dh * 260 + n) * DSN_BYTES;
            v2u uw[4];
#pragma unroll
            for (int mt = 0; mt < 4; ++mt) uw[mt] = *(const LAS v2u*)(uring + uslot * 4096 + ((dvl * 4 + mt) * 64 + lane) * 8);
            bf16x8 fk[2][8];
            if (s == 0) {
#pragma unroll
                for (int ks = 0; ks < 4; ++ks)
#pragma unroll
                    for (int mt = 0; mt < 4; ++mt) fw[ks][mt] = *(const LAS bf16x8*)(buf + ((mt * 4 + ks) * 64 + lane) * 16); }
            __builtin_amdgcn_sched_barrier(0);
#pragma unroll
            for (int ks = 0; ks < 4; ++ks) *(bf16x8*)(sn + (size_t)((dvt * 4 + ks) * 64 + lane) * 16) = Sb[ks];
            f32x4 vn[4];
#pragma unroll
            for (int mt = 0; mt < 4; ++mt) vn[mt] = (f32x4){bf_lo(uw[mt].x), bf_hi(uw[mt].x), bf_lo(uw[mt].y), bf_hi(uw[mt].y)};
#pragma unroll
            for (int mt = 0; mt < 4; ++mt) vn[mt] = __builtin_amdgcn_mfma_f32_16x16x32_bf16(fw[0][mt], Sb[0], vn[mt], 0, 0, 0);
            __builtin_amdgcn_sched_barrier(0);
#pragma unroll
            for (int dt = 0; dt < 8; ++dt) fk[0][dt] = *(const LAS bf16x8*)(buf + 16384 + ((dt * 2 + 0) * 64 + lane) * 16);
            __builtin_amdgcn_sched_barrier(0);
#pragma unroll
            for (int mt = 0; mt < 4; ++mt) vn[mt] = __builtin_amdgcn_mfma_f32_16x16x32_bf16(fw[1][mt], Sb[1], vn[mt], 0, 0, 0);
            __builtin_amdgcn_sched_barrier(0);
#pragma unroll
            for (int dt = 0; dt < 8; ++dt) fk[1][dt] = *(const LAS bf16x8*)(buf + 16384 + ((dt * 2 + 1) * 64 + lane) * 16);
            __builtin_amdgcn_sched_barrier(0);
#pragma unroll
            for (int ks = 2; ks < 4; ++ks)
#pragma unroll
                for (int mt = 0; mt < 4; ++mt) vn[mt] = __builtin_amdgcn_mfma_f32_16x16x32_bf16(fw[ks][mt], Sb[ks], vn[mt], 0, 0, 0);
            bf16x8 vb[2];
#pragma unroll
            for (int ks = 0; ks < 2; ++ks) { v4u w; w.x = cvt_pk_bf16(vn[2 * ks][0], vn[2 * ks][1]); w.y = cvt_pk_bf16(vn[2 * ks][2], vn[2 * ks][3]); w.z = cvt_pk_bf16(vn[2 * ks + 1][0], vn[2 * ks + 1][1]); w.w = cvt_pk_bf16(vn[2 * ks + 1][2], vn[2 * ks + 1][3]); vb[ks] = __builtin_bit_cast(bf16x8, w);
                *(bf16x8*)(sn + DSN_V + (size_t)((dvt * 2 + ks) * 64 + lane) * 16) = vb[ks]; }
#pragma unroll
            for (int dt = 0; dt < 8; ++dt) S[dt] = S[dt] * gt;
#pragma unroll
            for (int ks = 0; ks < 2; ++ks)
#pragma unroll
                for (int dt = 0; dt < 8; ++dt) S[dt] = __builtin_amdgcn_mfma_f32_16x16x32_bf16(fk[ks][dt], vb[ks], S[dt], 0, 0, 0);
            __builtin_amdgcn_sched_barrier(0);
            { const LAS unsigned char* nb = F.lds + ((s + 1) & 3) * 32768;
#pragma unroll
              for (int ks = 0; ks < 4; ++ks)
#pragma unroll
                  for (int mt = 0; mt < 4; ++mt) fw[ks][mt] = *(const LAS bf16x8*)(nb + ((mt * 4 + ks) * 64 + lane) * 16); }
            __builtin_amdgcn_sched_barrier(0);
#pragma unroll
            for (int ks = 0; ks < 4; ++ks) { v4u w; w.x = cvt_pk_bf16(S[2 * ks][0], S[2 * ks][1]); w.y = cvt_pk_bf16(S[2 * ks][2], S[2 * ks][3]); w.z = cvt_pk_bf16(S[2 * ks + 1][0], S[2 * ks + 1][1]); w.w = cvt_pk_bf16(S[2 * ks + 1][2], S[2 * ks + 1][3]); Sb[ks] = __builtin_bit_cast(bf16x8, w); }
        }
    };
    asm volatile("s_waitcnt lgkmcnt(0)" ::: "memory");
    for (int s = 0; s < 258; s += 3) { step(s, 0, 2); step(s + 1, 1, 0); step(s + 2, 2, 1); }
    step(258, 0, 2); step(259, 1, 0);
    asm volatile("s_waitcnt vmcnt(0)" ::: "memory");
    __syncthreads();
}
__device__ __forceinline__ void dn_post_witem(Frame& F, ArgsP a, int l, int wi) {
    const int item = wi >> 2, mt = wi & 3, n = item % 260, h = item / 260, t0 = chunk_tok0(n), lane = F.lane, fr = lane & 15, fq = lane >> 4;
    const bf16* P = (const bf16*)(F.ws + WS_P); bf16* YA = (bf16*)(F.ws + WS_YABC);
    f32x4 o[8];
#pragma unroll
    for (int dvt = 0; dvt < 8; ++dvt) o[dvt] = (f32x4){0.f, 0.f, 0.f, 0.f};
#pragma unroll
    for (int d = 0; d < 2; ++d) { const size_t it = (size_t)(d * 4 + h) * 260 + n; const unsigned char* df = F.ws + WS_DF + it * DF_BYTES; const unsigned char* sn = F.ws + WS_DSN + it * DSN_BYTES;
        bf16x8 qd[4], qk[2];
#pragma unroll
        for (int ks = 0; ks < 4; ++ks) qd[ks] = *(const bf16x8*)(df + DF_QD + (unsigned)(((mt * 4 + ks) * 64 + lane) * 16));
#pragma unroll
        for (int ks = 0; ks < 2; ++ks) qk[ks] = *(const bf16x8*)(df + DF_QK + (unsigned)(((mt * 2 + ks) * 64 + lane) * 16));
#pragma unroll
        for (int g4 = 0; g4 < 2; ++g4) { bf16x8 sf[4][4], vf[4][2];
#pragma unroll
            for (int q = 0; q < 4; ++q) { const int dvt = 4 * g4 + q;
#pragma unroll
                for (int ks = 0; ks < 4; ++ks) sf[q][ks] = *(const bf16x8*)(sn + (unsigned)(((dvt * 4 + ks) * 64 + lane) * 16));
#pragma unroll
                for (int ks = 0; ks < 2; ++ks) vf[q][ks] = *(const bf16x8*)(sn + DSN_V + (unsigned)(((dvt * 2 + ks) * 64 + lane) * 16)); }
            __builtin_amdgcn_sched_barrier(0);
#pragma unroll
            for (int q = 0; q < 4; ++q) { const int dvt = 4 * g4 + q;
#pragma unroll
                for (int ks = 0; ks < 4; ++ks) o[dvt] = __builtin_amdgcn_mfma_f32_16x16x32_bf16(sf[q][ks], qd[ks], o[dvt], 0, 0, 0);
#pragma unroll
                for (int ks = 0; ks < 2; ++ks) o[dvt] = __builtin_amdgcn_mfma_f32_16x16x32_bf16(vf[q][ks], qk[ks], o[dvt], 0, 0, 0); }
            __builtin_amdgcn_sched_barrier(0); } }
    float ss = 0.f;
#pragma unroll
    for (int dvt = 0; dvt < 8; ++dvt) ss += (o[dvt][0] * o[dvt][0] + o[dvt][1] * o[dvt][1]) + (o[dvt][2] * o[dvt][2] + o[dvt][3] * o[dvt][3]);
    ss += __shfl_xor(ss, 16); ss += __shfl_xor(ss, 32);
    const float r = rsqrtf(ss * (1.0f / 128.0f) + EPS); const unsigned tok = (unsigned)(t0 + 16 * mt + fr);
#pragma unroll
    for (int dvt = 0; dvt < 8; ++dvt) { const f32x4 gv = *(const f32x4*)(inp(a, 12) + l * 128 + 16 * dvt + 4 * fq); const v2u zv = *(const v2u*)(P + (tok * (unsigned)NIN + PC_AZ + h * 128 + 16 * dvt + 4 * fq));
        v2u w; w.x = cvt_pk_bf16(o[dvt][0] * r * gv[0] * bf_lo(zv.x), o[dvt][1] * r * gv[1] * bf_hi(zv.x)); w.y = cvt_pk_bf16(o[dvt][2] * r * gv[2] * bf_lo(zv.y), o[dvt][3] * r * gv[3] * bf_hi(zv.y));
        *(v2u*)(YA + (tok * 512u + h * 128 + 16 * dvt + 4 * fq)) = w; }
}
__device__ __forceinline__ void gla_prep_item(Frame& F, ArgsP a, int l, int item) {
    int tid_ = F.tid; asm volatile("" : "+v"(tid_));
    const int n = item % 260, dh = item / 260, d = dh >> 2, h = dh & 3, t0 = chunk_tok0(n), tid = tid_, lane = tid & 63, wv = __builtin_amdgcn_readfirstlane(tid >> 6), fr = lane & 15, fq = lane >> 4;
    LAS float* Bc = (LAS float*)F.lds;
    LAS bf16* Qt = (LAS bf16*)(F.lds + 16640); LAS bf16* Kt = Qt + 64 * 72; LAS bf16* KHT = Kt + 64 * 72; LAS bf16* VT = KHT + 64 * 72;
    LAS float* W2s = (LAS float*)(F.lds + 62720); LAS float* bgs = W2s + 1024;
    const bf16* P = (const bf16*)(F.ws + WS_P); const float* SM = (const float*)(F.ws + WS_SM);
    bf16* QH = (bf16*)(F.ws + WS_QH) + (size_t)item * 4096; bf16* GG = (bf16*)(F.ws + WS_GG) + (size_t)item * 8192; float* GD = (float*)(F.ws + WS_GD) + (size_t)item * 64; bf16* GO = (bf16*)(F.ws + WS_GO);
    __syncthreads();
    for (int i = tid; i < 1024; i += 512) { W2s[i] = inp(a, 13)[(size_t)((l * 2 + d) * 16 + (i >> 6)) * 256 + h * 64 + (i & 63)]; bgs[i] = SM[(size_t)(t0 + (i >> 4)) * 64 + 16 + d * 16 + (i & 15)]; }
    __syncthreads();
    const int pos = tid >> 3, c8 = (tid & 7) * 8;
    { float x[8];
#pragma unroll
      for (int i = 0; i < 8; ++i) x[i] = inp(a, 14)[(l * 2 + d) * 256 + h * 64 + c8 + i];
#pragma unroll
      for (int r = 0; r < 16; ++r) { const float bg = bgs[pos * 16 + r];
#pragma unroll
          for (int i = 0; i < 8; ++i) x[i] += bg * W2s[r * 64 + c8 + i]; }
#pragma unroll
      for (int i = 0; i < 8; ++i) Bc[pos * 65 + c8 + i] = -softplus_f(-x[i]) * (1.0f / 16.0f); }
    __syncthreads();
    if (tid < 64) { float cv[64];
#pragma unroll
        for (int i = 0; i < 64; ++i) cv[i] = Bc[i * 65 + tid];
        if (d) {
#pragma unroll
            for (int i = 62; i >= 0; --i) cv[i] += cv[i + 1]; }
        else {
#pragma unroll
            for (int i = 1; i < 64; ++i) cv[i] += cv[i - 1]; }
#pragma unroll
        for (int i = 0; i < 64; ++i) Bc[i * 65 + tid] = cv[i]; }
    __syncthreads();
    { const bf16* pr = P + (size_t)(t0 + pos) * NIN; const v4u qx = *(const v4u*)(pr + PC_BQ + h * 64 + c8), kx = *(const v4u*)(pr + PC_BK + h * 64 + c8);
      const float qv[8] = {bf_lo(qx.x), bf_hi(qx.x), bf_lo(qx.y), bf_hi(qx.y), bf_lo(qx.z), bf_hi(qx.z), bf_lo(qx.w), bf_hi(qx.w)}, kv[8] = {bf_lo(kx.x), bf_hi(kx.x), bf_lo(kx.y), bf_hi(kx.y), bf_lo(kx.z), bf_hi(kx.z), bf_lo(kx.w), bf_hi(kx.w)};
      float qt[8], kt[8], qh[8];
#pragma unroll
      for (int i = 0; i < 8; ++i) { const float b = Bc[pos * 65 + c8 + i], br = Bc[32 * 65 + c8 + i], be = Bc[(d ? 0 : 63) * 65 + c8 + i];
          qt[i] = qv[i] * fexp(fminf(b - br, 60.f)); kt[i] = kv[i] * fexp(fminf(br - b, 60.f)); qh[i] = qv[i] * fexp(b);
          KHT[(c8 + i) * 72 + pos] = (bf16)(cvt_pk_bf16(kv[i] * fexp(be - b), 0.f) & 0xffffu); }
      v4u w; w.x = cvt_pk_bf16(qt[0], qt[1]); w.y = cvt_pk_bf16(qt[2], qt[3]); w.z = cvt_pk_bf16(qt[4], qt[5]); w.w = cvt_pk_bf16(qt[6], qt[7]); *(LAS v4u*)(Qt + pos * 72 + c8) = w;
      w.x = cvt_pk_bf16(kt[0], kt[1]); w.y = cvt_pk_bf16(kt[2], kt[3]); w.z = cvt_pk_bf16(kt[4], kt[5]); w.w = cvt_pk_bf16(kt[6], kt[7]); *(LAS v4u*)(Kt + pos * 72 + c8) = w;
      w.x = cvt_pk_bf16(qh[0], qh[1]); w.y = cvt_pk_bf16(qh[2], qh[3]); w.z = cvt_pk_bf16(qh[4], qh[5]); w.w = cvt_pk_bf16(qh[6], qh[7]); *(v4u*)(QH + pos * 64 + c8) = w;
#pragma unroll
      for (int hv = 0; hv < 2; ++hv) { const v4u vx = *(const v4u*)(pr + PC_BV + h * 128 + 16 * (tid & 7) + 8 * hv); const unsigned vw[4] = {vx.x, vx.y, vx.z, vx.w};
#pragma unroll
          for (int j = 0; j < 4; ++j) { VT[(16 * (tid & 7) + 8 * hv + 2 * j) * 72 + pos] = (bf16)(vw[j] & 0xffffu); VT[(16 * (tid & 7) + 8 * hv + 2 * j + 1) * 72 + pos] = (bf16)(vw[j] >> 16); } }
      if (tid < 64) GD[tid] = fexp(Bc[(d ? 0 : 63) * 65 + tid]); }
    __syncthreads();
    const int it = wv & 3, hf = wv >> 2;
    f32x4 at[4];
#pragma unroll
    for (int jt = 0; jt < 4; ++jt) { f32x4 acc = (f32x4){0.f, 0.f, 0.f, 0.f};
#pragma unroll
        for (int ks = 0; ks < 2; ++ks) acc = __builtin_amdgcn_mfma_f32_16x16x32_bf16(*(const LAS bf16x8*)(Kt + (16 * jt + fr) * 72 + 32 * ks + 8 * fq), *(const LAS bf16x8*)(Qt + (16 * it + fr) * 72 + 32 * ks + 8 * fq), acc, 0, 0, 0);
#pragma unroll
        for (int jj = 0; jj < 4; ++jj) { const int i = 16 * it + fr, j = 16 * jt + 4 * fq + jj; if (d ? (i > j) : (i < j)) acc[jj] = 0.f; }
        at[jt] = acc; }
    bf16x8 pb[2];
#pragma unroll
    for (int ks2 = 0; ks2 < 2; ++ks2) { v4u w; w.x = cvt_pk_bf16(at[2 * ks2][0], at[2 * ks2][1]); w.y = cvt_pk_bf16(at[2 * ks2][2], at[2 * ks2][3]); w.z = cvt_pk_bf16(at[2 * ks2 + 1][0], at[2 * ks2 + 1][1]); w.w = cvt_pk_bf16(at[2 * ks2 + 1][2], at[2 * ks2 + 1][3]); pb[ks2] = __builtin_bit_cast(bf16x8, w); }
#pragma unroll
    for (int dq = 0; dq < 4; ++dq) { const int dvt = 4 * hf + dq; f32x4 acc = (f32x4){0.f, 0.f, 0.f, 0.f};
#pragma unroll
        for (int ks2 = 0; ks2 < 2; ++ks2) { const LAS bf16* vp = VT + (16 * dvt + fr) * 72 + 32 * ks2 + 4 * fq; const v2u va = *(const LAS v2u*)vp, vb = *(const LAS v2u*)(vp + 16);
            acc = __builtin_amdgcn_mfma_f32_16x16x32_bf16(__builtin_bit_cast(bf16x8, ((v4u){va.x, va.y, vb.x, vb.y})), pb[ks2], acc, 0, 0, 0); }
        { v2u w; w.x = cvt_pk_bf16(acc[0], acc[1]); w.y = cvt_pk_bf16(acc[2], acc[3]); *(v2u*)(GO + ((size_t)d * T + t0 + 16 * it + fr) * 512 + h * 128 + 16 * dvt + 4 * fq) = w; } }
    const int dkt = wv & 3;
#pragma unroll
    for (int dq = 0; dq < 4; ++dq) { const int dvt = 4 * hf + dq; f32x4 acc = (f32x4){0.f, 0.f, 0.f, 0.f};
#pragma unroll
        for (int ks = 0; ks < 2; ++ks) acc = __builtin_amdgcn_mfma_f32_16x16x32_bf16(*(const LAS bf16x8*)(KHT + (16 * dkt + fr) * 72 + 32 * ks + 8 * fq), *(const LAS bf16x8*)(VT + (16 * dvt + fr) * 72 + 32 * ks + 8 * fq), acc, 0, 0, 0);
#pragma unroll
        for (int jj = 0; jj < 4; ++jj) GG[(16 * dkt + 4 * fq + jj) * 128 + 16 * dvt + fr] = (bf16)(cvt_pk_bf16(acc[jj], 0.f) & 0xffffu); }
}
__device__ __forceinline__ void gla_scan_item(Frame& F, int item) {
    const int dh = item >> 3, d = dh >> 2, dv = F.tid & 127, dk0 = 8 * (item & 7) + 2 * (F.tid >> 7);
    const bf16* GG = (const bf16*)(F.ws + WS_GG); const float* GD = (const float*)(F.ws + WS_GD); bf16* ST = (bf16*)(F.ws + WS_ST);
    float S0 = 0.f, S1 = 0.f;
#pragma nounroll
    for (int s4 = 0; s4 < 260; s4 += 20) {
        float g0[20], g1[20], c0[20], c1[20];
#pragma unroll
        for (int u = 0; u < 20; ++u) { const size_t it = (size_t)dh * 260 + scan_chunk(d, s4 + u); g0[u] = bf2f(GG[it * 8192 + dk0 * 128 + dv]); g1[u] = bf2f(GG[it * 8192 + (dk0 + 1) * 128 + dv]); c0[u] = GD[it * 64 + dk0]; c1[u] = GD[it * 64 + dk0 + 1]; }
#pragma unroll
        for (int u = 0; u < 20; ++u) { const size_t it = (size_t)dh * 260 + scan_chunk(d, s4 + u); const unsigned w = cvt_pk_bf16(S0, S1); *(unsigned*)(ST + it * 8192 + (size_t)((((dv >> 4) * 2 + (dk0 >> 5)) * 64 + (dv & 15) + 16 * ((dk0 & 31) >> 3)) * 8 + (dk0 & 7))) = w;
            S0 = c0[u] * S0 + g0[u]; S1 = c1[u] * S1 + g1[u]; }
    }
}
__device__ __forceinline__ void gla_post_witem(Frame& F, ArgsP a, int l, int wi) {
    const int item = wi >> 2, pt = wi & 3, n = item % 260, h = item / 260, t0 = chunk_tok0(n), lane = F.lane, fr = lane & 15, fq = lane >> 4;
    const bf16* P = (const bf16*)(F.ws + WS_P); const bf16* GO = (const bf16*)(F.ws + WS_GO); bf16* YB = (bf16*)(F.ws + WS_YABC + YSTRIDE);
    const unsigned tok = (unsigned)(t0 + 16 * pt + fr);
    f32x4 os[8];
#pragma unroll
    for (int dvt = 0; dvt < 8; ++dvt) os[dvt] = (f32x4){0.f, 0.f, 0.f, 0.f};
#pragma unroll
    for (int d = 0; d < 2; ++d) { const size_t it = (size_t)(d * 4 + h) * 260 + n; const bf16* ST = (const bf16*)(F.ws + WS_ST) + it * 8192; const bf16* QH = (const bf16*)(F.ws + WS_QH) + it * 4096;
        const bf16x8 q0 = *(const bf16x8*)(QH + (unsigned)((16 * pt + fr) * 64 + 8 * fq)), q1 = *(const bf16x8*)(QH + (unsigned)((16 * pt + fr) * 64 + 32 + 8 * fq));
        bf16x8 s0[8], s1[8]; f32x4 gi[8];
#pragma unroll
        for (int dvt = 0; dvt < 8; ++dvt) { { const v2u gw = *(const v2u*)(GO + ((size_t)d * T + tok) * 512 + h * 128 + 16 * dvt + 4 * fq); gi[dvt] = (f32x4){bf_lo(gw.x), bf_hi(gw.x), bf_lo(gw.y), bf_hi(gw.y)}; }
            s0[dvt] = *(const bf16x8*)(ST + (unsigned)(((dvt * 2 + 0) * 64 + lane) * 8)); s1[dvt] = *(const bf16x8*)(ST + (unsigned)(((dvt * 2 + 1) * 64 + lane) * 8)); }
        __builtin_amdgcn_sched_barrier(0);
#pragma unroll
        for (int dvt = 0; dvt < 8; ++dvt) { f32x4 acc = __builtin_amdgcn_mfma_f32_16x16x32_bf16(s0[dvt], q0, gi[dvt], 0, 0, 0); acc = __builtin_amdgcn_mfma_f32_16x16x32_bf16(s1[dvt], q1, acc, 0, 0, 0); os[dvt] += acc; }
        __builtin_amdgcn_sched_barrier(0); }
    float ss = 0.f;
#pragma unroll
    for (int dvt = 0; dvt < 8; ++dvt) ss += (os[dvt][0] * os[dvt][0] + os[dvt][1] * os[dvt][1]) + (os[dvt][2] * os[dvt][2] + os[dvt][3] * os[dvt][3]);
    ss += __shfl_xor(ss, 16); ss += __shfl_xor(ss, 32);
    const float r = rsqrtf(ss * (1.0f / 128.0f) + EPS);
#pragma unroll
    for (int dvt = 0; dvt < 8; ++dvt) { const f32x4 gv = *(const f32x4*)(inp(a, 15) + l * 128 + 16 * dvt + 4 * fq); const v2u zv = *(const v2u*)(P + (tok * (unsigned)NIN + PC_BZ + h * 128 + 16 * dvt + 4 * fq));
        v2u w; w.x = cvt_pk_bf16(os[dvt][0] * r * gv[0] * bf_lo(zv.x), os[dvt][1] * r * gv[1] * bf_hi(zv.x)); w.y = cvt_pk_bf16(os[dvt][2] * r * gv[2] * bf_lo(zv.y), os[dvt][3] * r * gv[3] * bf_hi(zv.y));
        *(v2u*)(YB + (tok * 512u + h * 128 + 16 * dvt + 4 * fq)) = w; }
}
constexpr int AT_KSTR = 72, AT_BUF = 2 * 64 * AT_KSTR * 2;
__device__ __forceinline__ void attn_unit(Frame& F, ArgsP a, int l, int unit) {
    int tid_ = F.tid; asm volatile("" : "+v"(tid_));
    const int qb = unit >> 1, g = unit & 1, tid = tid_, lane = tid & 63, wv = __builtin_amdgcn_readfirstlane(tid >> 6), r = wv >> 1, hf = wv & 1, hq = 4 * g + r, fr = lane & 15, fq = lane >> 4;
    const bool lat = qb >= 2; const int lb = qb - 2;
    const int qtok0 = (lat ? CTX + 128 * lb : 128 * qb) + 64 * hf;
    const bf16* P = (const bf16*)(F.ws + WS_P); bf16* YC = (bf16*)(F.ws + WS_YABC + 2 * YSTRIDE);
    const int kb_lo = lat ? max(lb - 1, 0) : 0, kb_hi = lat ? min(lb + 1, SEQ / 128 - 1) : -1;
    const int nloc = lat ? 2 * (kb_hi - kb_lo + 1) : 0, nt = nloc + 4;
    bf16x8 qf[4][2];
#pragma unroll
    for (int n = 0; n < 4; ++n)
#pragma unroll
        for (int ks = 0; ks < 2; ++ks) qf[n][ks] = *(const bf16x8*)((const bf16*)(F.ws + WS_QN) + (unsigned)((qtok0 + 16 * n + fr) * 512 + hq * 64 + 32 * ks + 8 * fq));
    const float LOG2E = 1.4426950408889634f, SC = 0.125f * LOG2E;
    const float sink2 = inp(a, 18)[l * 8 + hq] * LOG2E;
    float mrun[4], lrun[4];
    f32x4 o[4][4];
#pragma unroll
    for (int n = 0; n < 4; ++n) { mrun[n] = sink2; lrun[n] = (fq == 0) ? 1.0f : 0.0f;
#pragma unroll
        for (int dt = 0; dt < 4; ++dt) o[dt][n] = (f32x4){0.f, 0.f, 0.f, 0.f}; }
    LAS bf16* lds = (LAS bf16*)F.lds;
    const int skey = tid >> 3, sch = tid & 7;
    v4u kreg, vreg;
    auto tile_tok0 = [&](int t) -> int { return (t < nloc) ? (CTX + 128 * kb_lo + 64 * t) : 64 * (t - nloc); };
    auto g_load = [&](int t) { const unsigned tk = (unsigned)(tile_tok0(t) + skey); kreg = *(const v4u*)((const bf16*)(F.ws + WS_KN) + (tk * 128u + g * 64 + 8 * sch)); vreg = *(const v4u*)(P + (tk * (unsigned)NIN + PC_CV + g * 64 + 8 * sch)); };
    auto l_store = [&](int b) { LAS bf16* Kb = lds + b * (AT_BUF / 2); LAS bf16* Vb = Kb + 64 * AT_KSTR;
        *(LAS v4u*)(Kb + skey * AT_KSTR + 8 * sch) = kreg;
        const unsigned vw[4] = {vreg.x, vreg.y, vreg.z, vreg.w};
#pragma unroll
        for (int j = 0; j < 4; ++j) { Vb[(8 * sch + 2 * j) * AT_KSTR + skey] = (bf16)(vw[j] & 0xffffu); Vb[(8 * sch + 2 * j + 1) * AT_KSTR + skey] = (bf16)(vw[j] >> 16); } };
    __syncthreads();
    g_load(0); l_store(0);
    __syncthreads();
    for (int t = 0; t < nt; ++t) {
        if (t + 1 < nt) g_load(t + 1);
        const LAS bf16* Kb = lds + (t & 1) * (AT_BUF / 2); const LAS bf16* Vb = Kb + 64 * AT_KSTR;
        const bool local = t < nloc; const int kp0 = 128 * kb_lo + 64 * t;
        const bool need_mask = local && ((kp0 >> 7) != lb);
#pragma unroll
        for (int nh = 0; nh < 2; ++nh) {
            f32x4 s[4][2];
#pragma unroll
            for (int kt = 0; kt < 4; ++kt) {
                const bf16x8 ka0 = *(const LAS bf16x8*)(Kb + (16 * kt + fr) * AT_KSTR + 8 * fq), ka1 = *(const LAS bf16x8*)(Kb + (16 * kt + fr) * AT_KSTR + 32 + 8 * fq);
#pragma unroll
                for (int n2 = 0; n2 < 2; ++n2) { f32x4 acc = (f32x4){0.f, 0.f, 0.f, 0.f};
                    acc = __builtin_amdgcn_mfma_f32_16x16x32_bf16(ka0, qf[2 * nh + n2][0], acc, 0, 0, 0); acc = __builtin_amdgcn_mfma_f32_16x16x32_bf16(ka1, qf[2 * nh + n2][1], acc, 0, 0, 0); s[kt][n2] = acc; }
            }
#pragma unroll
            for (int n2 = 0; n2 < 2; ++n2) { const int n = 2 * nh + n2; const int qp = qtok0 - CTX + 16 * n + fr;
#pragma unroll
                for (int kt = 0; kt < 4; ++kt)
#pragma unroll
                    for (int i = 0; i < 4; ++i) { float v = s[kt][n2][i] * SC; if (need_mask) { const int d = qp - (kp0 + 16 * kt + 4 * fq + i); if (d > 128 || d < -128) v = -INFINITY; } s[kt][n2][i] = v; }
                float mx = s[0][n2][0];
#pragma unroll
                for (int kt = 0; kt < 4; ++kt)
#pragma unroll
                    for (int i = 0; i < 4; ++i) mx = fmaxf(mx, s[kt][n2][i]);
                mx = fmaxf(mx, __shfl_xor(mx, 16)); mx = fmaxf(mx, __shfl_xor(mx, 32));
                const float mnew = fmaxf(mrun[n], mx), alpha = fexp2(mrun[n] - mnew); mrun[n] = mnew; float ps = 0.f;
#pragma unroll
                for (int kt = 0; kt < 4; ++kt)
#pragma unroll
                    for (int i = 0; i < 4; ++i) { const float p = fexp2(s[kt][n2][i] - mnew); s[kt][n2][i] = p; ps += p; }
                lrun[n] = lrun[n] * alpha + ps;
#pragma unroll
                for (int dt = 0; dt < 4; ++dt) o[dt][n] = o[dt][n] * alpha; }
#pragma unroll
            for (int ks2 = 0; ks2 < 2; ++ks2) {
                bf16x8 pb[2];
#pragma unroll
                for (int n2 = 0; n2 < 2; ++n2) { v4u w; w.x = cvt_pk_bf16(s[2 * ks2][n2][0], s[2 * ks2][n2][1]); w.y = cvt_pk_bf16(s[2 * ks2][n2][2], s[2 * ks2][n2][3]); w.z = cvt_pk_bf16(s[2 * ks2 + 1][n2][0], s[2 * ks2 + 1][n2][1]); w.w = cvt_pk_bf16(s[2 * ks2 + 1][n2][2], s[2 * ks2 + 1][n2][3]); pb[n2] = __builtin_bit_cast(bf16x8, w); }
#pragma unroll
                for (int dt = 0; dt < 4; ++dt) { const LAS bf16* vp = Vb + (16 * dt + fr) * AT_KSTR + 32 * ks2 + 4 * fq;
                    const v2u va = *(const LAS v2u*)vp, vb2 = *(const LAS v2u*)(vp + 16); const v4u vv = (v4u){va.x, va.y, vb2.x, vb2.y}; const bf16x8 vf = __builtin_bit_cast(bf16x8, vv);
#pragma unroll
                    for (int n2 = 0; n2 < 2; ++n2) o[dt][2 * nh + n2] = __builtin_amdgcn_mfma_f32_16x16x32_bf16(vf, pb[n2], o[dt][2 * nh + n2], 0, 0, 0); }
            }
        }
        if (t + 1 < nt) l_store((t + 1) & 1);
        __syncthreads();
    }
#pragma unroll
    for (int n = 0; n < 4; ++n) { float lt = lrun[n]; lt += __shfl_xor(lt, 16); lt += __shfl_xor(lt, 32); const float inv = 1.0f / lt;
        bf16* yp = YC + (unsigned)((qtok0 + 16 * n + fr) * 512 + hq * 64 + 4 * fq);
#pragma unroll
        for (int dt = 0; dt < 4; ++dt) { v2u w; w.x = cvt_pk_bf16(o[dt][n][0] * inv, o[dt][n][1] * inv); w.y = cvt_pk_bf16(o[dt][n][2] * inv, o[dt][n][3] * inv); *(v2u*)(yp + 16 * dt) = w; } }
}
__device__ __forceinline__ void moe_convert_pool(Frame& F, ArgsP a, int l) {
    unsigned* qhead = F.ctl + CW_CNT + 512 + 64 * l;
    LAS float* scr = (LAS float*)(F.lds + F.wave * 16384); bf16* WGU = (bf16*)(F.ws + WS_WGU); bf16* WDN = (bf16*)(F.ws + WS_WDN);
    constexpr int NGU = NE * 1024, NDN = NE * 512, GRAB = 8;
    const int nsm = (I_BR_L + I_WO_L) + ((l + 1 < NL) ? I_IN_L : 0), ntot = NGU + NDN + ((nsm + GRAB - 1) / GRAB) * GRAB;
    for (;;) { unsigned g0 = 0; if (F.lane == 0) g0 = __hip_atomic_fetch_add(qhead, 1u, __ATOMIC_RELAXED, __HIP_MEMORY_SCOPE_AGENT); g0 = (unsigned)__builtin_amdgcn_readfirstlane((int)g0);
        if (g0 >= (unsigned)(ntot / GRAB)) break;
        for (int q = 0; q < GRAB; ++q) { int it = (int)g0 * GRAB + q;
            if (it >= NGU + NDN) { const int r = it - (NGU + NDN); if (r < I_BR_L + I_WO_L) convert_small_item(F, a, l, I_IN_L + r, scr); else if (r < nsm) convert_small_item(F, a, l + 1, r - (I_BR_L + I_WO_L), scr); }
            else if (it < NGU) { const int le = l * NE + it / 1024, r = it % 1024, kb = r / 64, nb = r % 64; const int dst = (nb < 32) ? 256 * (nb >> 2) + 32 * (nb & 3) : 256 * ((nb - 32) >> 2) + 128 + 32 * ((nb - 32) & 3);
                transpose_item(inp(a, 25) + (size_t)le * 1024 * 2048, 2048, 1024, WGU + (size_t)le * 2048 * 1024, kb * 64, 32 * nb, dst, 32, scr, F.lane); }
            else { it -= NGU; const int le = l * NE + it / 512, r = it % 512, kb = r / 32, nb = r % 32;
                transpose_item(inp(a, 27) + (size_t)le * 1024 * 1024, 1024, 1024, WDN + (size_t)le * 1024 * 1024, kb * 64, 32 * nb, 32 * nb, 32, scr, F.lane); } } }
}
__device__ __forceinline__ void phase_mixers(Frame& F, ArgsP a, int l) {
    const bool split = F.G >= 160;
    unsigned* gflag = F.ctl + CW_CNT + 256 + 64 * l;
    for (int item = F.bid; item < 128; item += F.G) {
        if (item < 64) { for (int r_ = 0; r_ < PROBE_REPS(21); ++r_) dn_scan_item(F, split ? ((item & 7) * 8 + (item >> 3)) : item); }
        else { for (int r_ = 0; r_ < PROBE_REPS(22); ++r_) gla_scan_item(F, item - 64);
            if (split) { asm volatile("s_waitcnt vmcnt(0)" ::: "memory"); __syncthreads();
                if (F.tid == 0) { __builtin_amdgcn_fence(__ATOMIC_RELEASE, "agent"); asm volatile("s_waitcnt vmcnt(0)" ::: "memory"); __hip_atomic_fetch_add(gflag, 1u, __ATOMIC_RELAXED, __HIP_MEMORY_SCOPE_AGENT); }
                __syncthreads(); moe_convert_pool(F, a, l); } }
        __syncthreads(); }
    const int ab = split ? F.bid - 128 : F.bid, nab = split ? F.G - 128 : F.G;
    if (ab >= 0) { for (int r_ = 0; r_ < PROBE_REPS(23); ++r_) for (int u = ab; u < 260; u += nab) attn_unit(F, a, l, u);
        if (split) {
            __syncthreads();
            if (F.tid == 0) { unsigned sp = 0; while (__hip_atomic_load(gflag, __ATOMIC_RELAXED, __HIP_MEMORY_SCOPE_AGENT) < 64u) { __builtin_amdgcn_s_sleep(8); if (++sp > (1u << 22)) break; }
                __builtin_amdgcn_fence(__ATOMIC_ACQUIRE, "agent"); asm volatile("s_waitcnt vmcnt(0)" ::: "memory"); }
            __syncthreads();
            for (int wi = ab * 8 + F.wave; wi < 4160; wi += nab * 8) gla_post_witem(F, a, l, wi);
            __syncthreads(); moe_convert_pool(F, a, l); } }
}
__device__ __forceinline__ void phase_post(Frame& F, ArgsP a, int l) {
    const int nwi = (F.G >= 160) ? 4160 : 8320;
    for (int wi = F.bid * 8 + F.wave; wi < nwi; wi += F.G * 8) { if (wi < 4160) dn_post_witem(F, a, l, wi); else gla_post_witem(F, a, l, wi - 4160); }
}

template <int KQ> __device__ __forceinline__ void ctx_tile_acc(const bf16* Arow0, const bf16* Wt, int K, int k0, int r0, int c0, int fr, int fq, f32x4 (&acc)[2]) {
    const bf16* ap = Arow0 + (unsigned)((r0 + fr) * K + k0 + 8 * fq); const bf16* b0 = Wt + (unsigned)((c0 + fr) * K + k0 + 8 * fq); const bf16* b1 = b0 + 16 * K;
    bf16x8 av[KQ / 32], w0[KQ / 32], w1[KQ / 32];
#pragma unroll
    for (int ks = 0; ks < KQ / 32; ++ks) { av[ks] = *(const bf16x8*)(ap + 32 * ks); w0[ks] = *(const bf16x8*)(b0 + 32 * ks); w1[ks] = *(const bf16x8*)(b1 + 32 * ks); }
#pragma unroll
    for (int ks = 0; ks < KQ / 32; ++ks) { acc[0] = __builtin_amdgcn_mfma_f32_16x16x32_bf16(w0[ks], av[ks], acc[0], 0, 0, 0); acc[1] = __builtin_amdgcn_mfma_f32_16x16x32_bf16(w1[ks], av[ks], acc[1], 0, 0, 0); }
}
__device__ __forceinline__ void ctx_branch_rows(Frame& F, int l) {
    const bf16* P = (const bf16*)(F.ws + WS_P); bf16* MG = (bf16*)(F.ws + WS_MG); const int fr = F.lane & 15, fq = F.lane >> 4;
    LAS f32x4* red = (LAS f32x4*)F.lds;
    for (int base = F.bid * 8; base < 2048; base += F.G * 8) { const int wi = base + F.wave, it = wi >> 2, kq = wi & 3, r0 = (it >> 5) * 16, c0 = (it & 31) * 32;
        f32x4 sum[2] = {(f32x4){0.f, 0.f, 0.f, 0.f}, (f32x4){0.f, 0.f, 0.f, 0.f}};
#pragma unroll
        for (int z = 0; z < 3; ++z) { f32x4 acc[2] = {(f32x4){0.f, 0.f, 0.f, 0.f}, (f32x4){0.f, 0.f, 0.f, 0.f}};
            ctx_tile_acc<128>((const bf16*)(F.ws + WS_YABC + z * YSTRIDE), (const bf16*)(F.ws + WS_WBR) + (size_t)(l * 3 + z) * 1024 * 512, 512, 128 * kq, r0, c0, fr, fq, acc);
#pragma unroll
            for (int t = 0; t < 2; ++t) { const v2u gw = *(const v2u*)(P + (unsigned)((r0 + fr) * NIN + PC_GL + z * 1024 + c0 + 16 * t + 4 * fq));
                sum[t][0] += acc[t][0] * bf_lo(gw.x); sum[t][1] += acc[t][1] * bf_hi(gw.x); sum[t][2] += acc[t][2] * bf_lo(gw.y); sum[t][3] += acc[t][3] * bf_hi(gw.y); } }
        __syncthreads();
        red[(F.wave * 2 + 0) * 64 + F.lane] = sum[0]; red[(F.wave * 2 + 1) * 64 + F.lane] = sum[1];
        __syncthreads();
        if (kq == 0) {
#pragma unroll
            for (int t = 0; t < 2; ++t) { f32x4 s = sum[t];
#pragma unroll
                for (int q = 1; q < 4; ++q) s += red[((F.wave + q) * 2 + t) * 64 + F.lane];
                v2u o; o.x = cvt_pk_bf16(s[0], s[1]); o.y = cvt_pk_bf16(s[2], s[3]); *(v2u*)(MG + (unsigned)((r0 + fr) * 1024 + c0 + 16 * t + 4 * fq)) = o; } } }
}
__device__ __forceinline__ void ctx_wo_rows(Frame& F, int l) {
    float* XS = (float*)(F.ws + WS_XS); const float* modc = (const float*)(F.ws + WS_MOD) + (size_t)l * 2 * 6144 + 6144 + 2 * 1024; const int fr = F.lane & 15, fq = F.lane >> 4;
    LAS f32x4* red = (LAS f32x4*)F.lds;
    for (int base = F.bid * 8; base < 2048; base += F.G * 8) { const int wi = base + F.wave, it = wi >> 2, kq = wi & 3, r0 = (it >> 5) * 16, c0 = (it & 31) * 32;
        f32x4 acc[2] = {(f32x4){0.f, 0.f, 0.f, 0.f}, (f32x4){0.f, 0.f, 0.f, 0.f}};
        ctx_tile_acc<256>((const bf16*)(F.ws + WS_MG), (const bf16*)(F.ws + WS_WO) + (size_t)l * 1024 * 1024, 1024, 256 * kq, r0, c0, fr, fq, acc);
        __syncthreads();
        red[(F.wave * 2 + 0) * 64 + F.lane] = acc[0]; red[(F.wave * 2 + 1) * 64 + F.lane] = acc[1];
        __syncthreads();
        if (kq == 0) {
#pragma unroll
            for (int t = 0; t < 2; ++t) { f32x4 s = acc[t];
#pragma unroll
                for (int q = 1; q < 4; ++q) s += red[((F.wave + q) * 2 + t) * 64 + F.lane];
                float* xp = XS + (unsigned)((r0 + fr) * 1024 + c0 + 16 * t + 4 * fq); *(f32x4*)xp = *(const f32x4*)xp + *(const f32x4*)(modc + c0 + 16 * t + 4 * fq) * s; } } }
}
__device__ __forceinline__ void phase_route(Frame& F, ArgsP a, int l, bool commit = true) {
    const float* XS = (const float*)(F.ws + WS_XS); bf16* H = (bf16*)(F.ws + WS_H); bf16* HLO = (bf16*)(F.ws + WS_HLO); const float* MOD = (const float*)(F.ws + WS_MOD) + (size_t)l * 2 * 6144;
    int* RT = (int*)(F.ws + WS_RT); unsigned* cnt = F.ctl + CW_CNT + 32 * l;
    const bf16* WH = (const bf16*)(F.ws + WS_WRT) + (size_t)l * 65536; const bf16* WL = WH + 32768;
    const int lane = F.lane, fr = lane & 15, fq = lane >> 4;
    const float rb0 = inp(a, 24)[l * 32 + fr], rb1 = inp(a, 24)[l * 32 + 16 + fr];
    LAS unsigned* lcnt = (LAS unsigned*)F.lds;
    __syncthreads();
    if (F.tid < 32) lcnt[F.tid] = 0u;
    __syncthreads();
    for (int it = F.bid * 8 + F.wave; it < T / 16; it += F.G * 8) {
        f32x4 gsv[4], shv[4]; { const float* mv = MOD + (size_t)((16 * it < CTX) ? 1 : 0) * 6144; load_mod(inp(a, 7) + l * 1024, mv + 3 * 1024, mv + 4 * 1024, lane, gsv, shv); }
        for (int r4 = 0; r4 < 16; r4 += 4) { f32x4 xr[4][4];
#pragma unroll
          for (int rr = 0; rr < 4; ++rr)
#pragma unroll
            for (int j = 0; j < 4; ++j) xr[rr][j] = *(const f32x4*)(XS + (size_t)(16 * it + r4 + rr) * 1024 + 4 * lane + 256 * j);
          __builtin_amdgcn_sched_barrier(0);
#pragma unroll
          for (int rr = 0; rr < 4; ++rr) { const int t = 16 * it + r4 + rr; f32x4 x[4], h[4];
#pragma unroll
            for (int j = 0; j < 4; ++j) x[j] = xr[rr][j];
            norm_mod_store2(x, gsv, shv, H + (size_t)t * 1024, lane, h);
#pragma unroll
            for (int j = 0; j < 4; ++j) { const unsigned h01 = cvt_pk_bf16(h[j][0], h[j][1]), h23 = cvt_pk_bf16(h[j][2], h[j][3]);
                v2u o; o.x = cvt_pk_bf16(h[j][0] - bf_lo(h01), h[j][1] - bf_hi(h01)); o.y = cvt_pk_bf16(h[j][2] - bf_lo(h23), h[j][3] - bf_hi(h23)); *(v2u*)(HLO + (size_t)t * 1024 + 4 * lane + 256 * j) = o; } } }
        asm volatile("s_waitcnt vmcnt(0)" ::: "memory");
        f32x4 acc0 = (f32x4){0.f, 0.f, 0.f, 0.f}, acc1 = acc0;
        const bf16* ah = H + (size_t)(16 * it + fr) * 1024 + 8 * fq; const bf16* al = HLO + (size_t)(16 * it + fr) * 1024 + 8 * fq;
        const bf16* b0h = WH + (size_t)fr * 1024 + 8 * fq; const bf16* b1h = b0h + 16 * 1024; const bf16* b0l = WL + (size_t)fr * 1024 + 8 * fq; const bf16* b1l = b0l + 16 * 1024;
#pragma unroll 4
        for (int ks = 0; ks < 32; ++ks) { const bf16x8 xh = *(const bf16x8*)(ah + 32 * ks), xl = *(const bf16x8*)(al + 32 * ks), w0h = *(const bf16x8*)(b0h + 32 * ks), w1h = *(const bf16x8*)(b1h + 32 * ks), w0l = *(const bf16x8*)(b0l + 32 * ks), w1l = *(const bf16x8*)(b1l + 32 * ks);
            acc0 = __builtin_amdgcn_mfma_f32_16x16x32_bf16(xh, w0l, acc0, 0, 0, 0); acc1 = __builtin_amdgcn_mfma_f32_16x16x32_bf16(xh, w1l, acc1, 0, 0, 0);
            acc0 = __builtin_amdgcn_mfma_f32_16x16x32_bf16(xl, w0h, acc0, 0, 0, 0); acc1 = __builtin_amdgcn_mfma_f32_16x16x32_bf16(xl, w1h, acc1, 0, 0, 0);
            acc0 = __builtin_amdgcn_mfma_f32_16x16x32_bf16(xh, w0h, acc0, 0, 0, 0); acc1 = __builtin_amdgcn_mfma_f32_16x16x32_bf16(xh, w1h, acc1, 0, 0, 0); }
#pragma unroll
        for (int i = 0; i < 4; ++i) { float v0 = acc0[i] + rb0, v1 = acc1[i] + rb1; float tv[4]; int te[4];
#pragma unroll
            for (int k = 0; k < 4; ++k) { const float m = row_max16(fmaxf(v0, v1));
                const int sel = row_min16((v0 == m) ? fr : ((v1 == m) ? 16 + fr : 64));
                tv[k] = m; te[k] = sel; if (sel == fr) v0 = -INFINITY; if (sel == 16 + fr) v1 = -INFINITY; }
            const float e1 = fexp(tv[1] - tv[0]), e2 = fexp(tv[2] - tv[0]), e3 = fexp(tv[3] - tv[0]), inv = 1.0f / (1.0f + e1 + e2 + e3);
            if (fr < 4 && commit) { const int t = 16 * it + 4 * fq + i; const int ek = (fr == 0) ? te[0] : (fr == 1) ? te[1] : (fr == 2) ? te[2] : te[3]; const float gk = ((fr == 0) ? 1.0f : (fr == 1) ? e1 : (fr == 2) ? e2 : e3) * inv;
                const unsigned pos = __hip_atomic_fetch_add(lcnt + ek, 1u, __ATOMIC_RELAXED, __HIP_MEMORY_SCOPE_WORKGROUP);
                RT[(size_t)t * 4 + fr] = ek; RT[(size_t)T * 4 + (size_t)t * 4 + fr] = (int)pos; ((float*)RT)[(size_t)2 * T * 4 + (size_t)t * 4 + fr] = gk; } }
    }
    __syncthreads();
    if (F.tid < 32 && commit) ((unsigned*)(F.ws + WS_RT + 1536 * 1024))[F.bid * 32 + F.tid] = atomicAdd(cnt + F.tid, lcnt[F.tid]);
}
__device__ __forceinline__ int moe_tables(Frame& F, int l) {
    LAS int* off = (LAS int*)(F.lds + MISC_OFF + 64); LAS unsigned char* tile_e = (LAS unsigned char*)(F.lds + MISC_OFF + 256);
    __syncthreads();
    if (F.tid < 64) { const unsigned* cnt = F.ctl + CW_CNT + 32 * l; const int e = F.lane & 31;
        const int c = (int)__hip_atomic_load(cnt + e, __ATOMIC_RELAXED, __HIP_MEMORY_SCOPE_AGENT); const int nt = (F.lane < 32) ? ((c + 255) >> 8) : 0;
        int incl = nt;
#pragma unroll
        for (int o = 1; o < 32; o <<= 1) { const int up = __shfl_up(incl, o); if ((F.lane & 31) >= o) incl += up; }
        const int rt0 = incl - nt;
        if (F.lane < 32) { off[e] = rt0 * 256; if (e == 31) off[NE] = incl;
#pragma nounroll
            for (int i = 0; i < nt; ++i) tile_e[rt0 + i] = (unsigned char)e; } }
    __syncthreads();
    return __builtin_amdgcn_readfirstlane(off[NE]);
}
__device__ __forceinline__ void phase_gather(Frame& F, int l) {
    moe_tables(F, l);
    const LAS int* off = (const LAS int*)(F.lds + MISC_OFF + 64);
    int* RT = (int*)(F.ws + WS_RT); int* SRC = (int*)(F.ws + WS_XG) + (size_t)l * (MAXRT * 256);
    for (int i = F.bid * 512 + F.tid; i < T * 4; i += F.G * 512) { const int t = i >> 2;
        const int ek = RT[i], pos = RT[(size_t)T * 4 + i]; const int slot = off[ek] + (int)((const unsigned*)(F.ws + WS_RT + 1536 * 1024))[((t >> 7) % F.G) * 32 + ek] + pos;
        RT[(size_t)3 * T * 4 + i] = slot; SRC[slot] = t; }
}
template <class Sched> __device__ __forceinline__ void moe_gather_table(Frame& F, const Sched& S, int l, LAS int* gidx) {
    const int* SRC = (const int*)(F.ws + WS_XG) + (size_t)l * (MAXRT * 256);
    int nu = 0; { Unit u; while (nu < 24 && S.next(nu, u)) ++nu; }
    for (int idx = F.tid; idx < nu * 256; idx += 512) { Unit u; S.next(idx >> 8, u); gidx[idx] = SRC[u.pm * 256 + (idx & 255)]; }
    __syncthreads();
}
__device__ __forceinline__ void phase_combine(Frame& F, ArgsP a, int l, bool commit = true) {
    float* XS = (float*)(F.ws + WS_XS); bf16* H = (bf16*)(F.ws + WS_H); const bf16* Y = (const bf16*)(F.ws + WS_Y); const int* RT = (const int*)(F.ws + WS_RT);
    const float* MOD = (const float*)(F.ws + WS_MOD) + (size_t)l * 2 * 6144; const int lane = F.lane;
    for (int t0 = F.bid * 8 + F.wave; t0 < T; t0 += 2 * F.G * 8) {
        int tt[2]; tt[0] = t0; tt[1] = (t0 + F.G * 8 < T) ? t0 + F.G * 8 : t0;
        int slot[2][4]; float gk[2][4];
#pragma unroll
        for (int q = 0; q < 2; ++q)
#pragma unroll
            for (int k = 0; k < 4; ++k) { slot[q][k] = RT[(size_t)3 * T * 4 + (size_t)tt[q] * 4 + k]; gk[q][k] = ((const float*)RT)[(size_t)2 * T * 4 + (size_t)tt[q] * 4 + k]; }
        v2u yv[2][4][4]; f32x4 xv[2][4];
#pragma unroll
        for (int q = 0; q < 2; ++q) {
#pragma unroll
            for (int k = 0; k < 4; ++k)
#pragma unroll
                for (int j = 0; j < 4; ++j) yv[q][k][j] = *(const v2u*)(Y + (size_t)slot[q][k] * 1024 + 4 * lane + 256 * j);
#pragma unroll
            for (int j = 0; j < 4; ++j) xv[q][j] = *(const f32x4*)(XS + (size_t)tt[q] * 1024 + 4 * lane + 256 * j); }
        __builtin_amdgcn_sched_barrier(0);
#pragma unroll
        for (int q = 0; q < 2; ++q) { const int t = tt[q]; if (q == 1 && t == t0) break;
            const float* mv = MOD + (size_t)((t < CTX) ? 1 : 0) * 6144 + 5 * 1024;
            f32x4 x[4], h[4];
#pragma unroll
            for (int j = 0; j < 4; ++j) { f32x4 acc = (f32x4){0.f, 0.f, 0.f, 0.f};
#pragma unroll
                for (int k = 0; k < 4; ++k) acc += (f32x4){bf_lo(yv[q][k][j].x), bf_hi(yv[q][k][j].x), bf_lo(yv[q][k][j].y), bf_hi(yv[q][k][j].y)} * gk[q][k];
                x[j] = xv[q][j] + *(const f32x4*)(mv + 4 * lane + 256 * j) * acc; }
            if (!commit) { if (x[0][0] == 1.2345e30f) XS[0] = 0.f; }
            else if (l + 1 < NL) {
#pragma unroll
                for (int j = 0; j < 4; ++j) *(f32x4*)(XS + (size_t)t * 1024 + 4 * lane + 256 * j) = x[j];
                const float* mn = MOD + (size_t)2 * 6144 + (size_t)((t < CTX) ? 1 : 0) * 6144;
                norm_mod_store(x, inp(a, 6) + (l + 1) * 1024, mn, mn + 1024, H + (size_t)t * 1024, lane, h);
            } else if (t >= CTX) {
#pragma unroll
                for (int j = 0; j < 4; ++j) *(f32x4*)(outp(a) + (size_t)(t - CTX) * 1024 + 4 * lane + 256 * j) = x[j];
            } }
    }
}

__device__ __forceinline__ int opq_s(int v) { asm volatile("" : "+s"(v)); return __builtin_amdgcn_readfirstlane(v); }
__device__ __forceinline__ unsigned long long opq_u64(unsigned long long p) { unsigned lo_ = (unsigned)p, hi_ = (unsigned)(p >> 32); asm volatile("" : "+s"(lo_), "+s"(hi_));
    return ((unsigned long long)(unsigned)__builtin_amdgcn_readfirstlane((int)hi_) << 32) | (unsigned)__builtin_amdgcn_readfirstlane((int)lo_); }
#define TID_NOW() (opq_s(wave0) * 64 + (int)__builtin_amdgcn_mbcnt_hi(~0u, __builtin_amdgcn_mbcnt_lo(~0u, 0u)))
#define PHASE_BEGIN(LV) Frame F; ArgsP A; int l; { int t_ = TID_NOW(); asm volatile("" : "+v"(t_)); \
    F.ws = (unsigned char*)(GAS unsigned char*)opq_u64((unsigned long long)args.ws); F.ctl = (unsigned*)(F.ws + WS_CTL); F.lds = (LAS unsigned char*)lds_raw + opq_s(0); F.tid = t_; F.lane = t_ & 63; F.wave = __builtin_amdgcn_readfirstlane(t_ >> 6); \
    F.G = opq_s((int)gridDim.x); F.bid = opq_s((int)blockIdx.x); A = (ArgsP)opq_u64((unsigned long long)__builtin_amdgcn_kernarg_segment_ptr()); l = opq_s(LV); } \
    unsigned char* const ws = F.ws; (void)ws; (void)A; (void)l
__global__ void __launch_bounds__(512, 2) mk_fwd(Args args) {
    extern __shared__ __attribute__((aligned(16))) unsigned char lds_raw[];
    const int lo = args.ph_lo, hi = args.ph_hi;
    const int wave0 = __builtin_amdgcn_readfirstlane((int)(threadIdx.x >> 6));
    if (threadIdx.x < 4) ((LAS unsigned*)((LAS unsigned char*)lds_raw + MISC_OFF))[threadIdx.x] = 0u;
    __syncthreads();
    XcdBarrier bar; bar.lead = false; bar.bar = (unsigned*)(args.ws + WS_CTL) + CW_BAR; bar.x = 0; bar.st = (volatile LAS unsigned*)((LAS unsigned char*)lds_raw + MISC_OFF);
    if (hi - lo > 1) bar = xcd_barrier_post((unsigned*)(args.ws + WS_CTL) + CW_BAR, (volatile LAS unsigned*)((LAS unsigned char*)lds_raw + MISC_OFF), threadIdx.x == 0);
#define IN(k) (lo <= (k) && (k) < hi)
#define SEAM(k) do { if (IN(k) && IN((k) + 1)) { XcdBarrier b2_; b2_.lead = (TID_NOW() == 0); b2_.bar = (unsigned*)(GAS unsigned*)opq_u64((unsigned long long)bar.bar); b2_.x = (unsigned)opq_s((int)bar.x); b2_.st = (volatile LAS unsigned*)((LAS unsigned char*)lds_raw + opq_s(MISC_OFF)); xcd_barrier(b2_); } } while (0)
#define GRIDBAR() do { XcdBarrier b2_; b2_.lead = (TID_NOW() == 0); b2_.bar = (unsigned*)(GAS unsigned*)opq_u64((unsigned long long)bar.bar); b2_.x = (unsigned)opq_s((int)bar.x); b2_.st = (volatile LAS unsigned*)((LAS unsigned char*)lds_raw + opq_s(MISC_OFF)); xcd_barrier(b2_); } while (0)
#define PH_OUTER(k) (((k) == 5 || (k) == 6 || (k) == 10) ? 1 : PROBE_REPS(k))
#define PH(k, ...) for (int rep_ = 0; rep_ < PH_OUTER(k); ++rep_) { if (IN(pb + (k))) { __VA_ARGS__ } } SEAM(pb + (k));
    for (int rep_ = 0; rep_ < PROBE_REPS(100); ++rep_) { if (IN(0)) { PHASE_BEGIN(0); phase_prologue(F, A); } if (rep_ + 1 < PROBE_REPS(100)) { if (hi - lo > 1) GRIDBAR(); } } SEAM(0);
    if (IN(1)) { PHASE_BEGIN(0); phase_norm0(F, A); } SEAM(1);
#define LAYER_BODY(LIDX) { const int layer = (LIDX); \
        const int pb = NPH_PRO + layer * NPH_LAYER; \
        PH(0,  \
            PHASE_BEGIN(layer); \
            TileOrder S; S.init(T / 256, NIN / 256, F.G, F.bid, ws + WS_H, ws + WS_WIN + (size_t)l * NIN * 1024 * 2, 1024); \
            EpiIn E{(bf16*)(ws + WS_P), (float*)(ws + WS_SM)}; \
            for (int r_ = 0; r_ < PROBE_REPS(1000); ++r_) pg8::gemm_phase<EpiIn, TileOrder, true, true>(F.lds, F.tid, 1024, S, E); \
        ) \
        PH(1,  PHASE_BEGIN(layer); for (int r_ = 0; r_ < PROBE_REPS(11); ++r_) phase_prep(F, A, l); for (int r_ = 0; r_ < PROBE_REPS(12); ++r_) { for (int item = F.bid; item < 1040; item += F.G) dn_prep_item(F, A, l, item); \
              \
            if (F.G == 256) { for (int j = (F.bid < 16) ? 4 : 0; ; ++j) { const int item = (j < 4) ? j * 240 + (F.bid - 16) : 960 + (j - 4) * 256 + F.bid; if (item >= 2080) break; gla_prep_item(F, A, l, item); } } \
            else { for (int item = F.bid; item < 2080; item += F.G) gla_prep_item(F, A, l, item); } } ) \
        PH(2,  PHASE_BEGIN(layer); phase_mixers(F, A, l); ) \
        PH(3,  PHASE_BEGIN(layer); phase_post(F, A, l); ) \
        PH(4,  \
            PHASE_BEGIN(layer); \
            BranchOrder S; S.init(T / 256 - 1, 4, F.G, F.bid, ws + WS_YABC, ws + WS_WBR + (size_t)l * 3 * 1024 * 512 * 2, 512, 1); S.zA = YSTRIDE; S.zB = (size_t)1024 * 512 * 2; \
            EpiBranch E{(const bf16*)(ws + WS_P), (bf16*)(ws + WS_MG)}; \
            for (int r_ = 0; r_ < PROBE_REPS(41); ++r_) pg8::gemm_phase<EpiBranch, BranchOrder, true, true>(F.lds, F.tid, 512, S, E); for (int r_ = 0; r_ < PROBE_REPS(42); ++r_) ctx_branch_rows(F, l); \
        ) \
        PH(5,  \
            PHASE_BEGIN(layer); \
            const float* MOD = (const float*)(ws + WS_MOD) + (size_t)l * 2 * 6144; \
            TileOrder S; S.init(T / 256 - 1, 4, F.G, F.bid, ws + WS_MG, ws + WS_WO + (size_t)l * 1024 * 1024 * 2, 1024, 1); \
            EpiWo E{(float*)(ws + WS_XS), MOD + 2 * 1024, MOD + 6144 + 2 * 1024, true}; \
            for (int r_ = 0; r_ < PROBE_REPS(5); ++r_) { E.commit = opq_s(r_ + 1 == PROBE_REPS(5)) != 0; pg8::gemm_phase<EpiWo, TileOrder, true, true>(F.lds, F.tid, 1024, S, E); } ctx_wo_rows(F, l); \
        ) \
        PH(6,  PHASE_BEGIN(layer); for (int r_ = 0; r_ < PROBE_REPS(6); ++r_) phase_route(F, A, l, opq_s(r_ + 1 == PROBE_REPS(6)) != 0); ) \
        PH(7,  PHASE_BEGIN(layer); phase_gather(F, l); ) \
        PH(8,  \
            PHASE_BEGIN(layer); \
            const int rt = moe_tables(F, l); \
            MoeGatherOrder S; S.rt = rt; S.nN = 8; S.G = F.G; S.c = F.bid; S.tile_e = (const LAS unsigned char*)(F.lds + MISC_OFF + 256); S.gidx = (const LAS int*)(F.lds + MISC_OFF + 2560); S.rowbytes = 2048u; \
            S.A = (const char*)(ws + WS_H); S.B = (const char*)(ws + WS_WGU + (size_t)l * NE * 2048 * 1024 * 2); S.tstepA = S.tstepB = (size_t)256 * 1024 * 2; S.zB = (size_t)2048 * 1024 * 2; \
            EpiMoe1 E{(bf16*)(ws + WS_ACT), inp(A, 26) + (size_t)l * NE * 2048}; \
            moe_gather_table(F, S, l, (LAS int*)(F.lds + MISC_OFF + 2560)); for (int r_ = 0; r_ < PROBE_REPS(81); ++r_) pg8::gemm_phase<EpiMoe1, MoeGatherOrder, true, true>(F.lds, F.tid, 1024, S, E); \
        ) \
        PH(9,  \
            PHASE_BEGIN(layer); \
            const int rt = moe_tables(F, l); \
            MoeOrder S; S.rt = rt; S.nN = 4; S.G = F.G; S.c = F.bid; S.tile_e = (const LAS unsigned char*)(F.lds + MISC_OFF + 256); \
            S.A = (const char*)(ws + WS_ACT); S.B = (const char*)(ws + WS_WDN + (size_t)l * NE * 1024 * 1024 * 2); S.tstepA = S.tstepB = (size_t)256 * 1024 * 2; S.zB = (size_t)1024 * 1024 * 2; \
            EpiMoe2 E{(bf16*)(ws + WS_Y), inp(A, 28) + (size_t)l * NE * 1024}; \
            for (int r_ = 0; r_ < PROBE_REPS(91); ++r_) pg8::gemm_phase<EpiMoe2, MoeOrder, true, true>(F.lds, F.tid, 1024, S, E); \
        ) \
        PH(10,  PHASE_BEGIN(layer); for (int r_ = 0; r_ < PROBE_REPS(10); ++r_) phase_combine(F, A, l, opq_s(r_ + 1 == PROBE_REPS(10)) != 0); ) \
    }
    LAYER_BODY(0) LAYER_BODY(1) LAYER_BODY(2) LAYER_BODY(3)
#undef LAYER_BODY
#undef IN
#undef SEAM
}

extern "C" void kernel_launch(void* const* d_in, const int* in_sizes, int n_in, void* d_out, int out_size, void* d_ws, size_t ws_size, hipStream_t stream) {
    static int grid = 0;
    if (grid == 0) {
        if (n_in != 29 || out_size != SEQ * D || ws_size < WS_END) { fprintf(stderr, "kernel_launch: unexpected shapes (n_in %d, out %d, ws %zu); nothing launched\n", n_in, out_size, ws_size); grid = -1; return; }
        int dev = 0, cus = 0;
        if (hipGetDevice(&dev) != hipSuccess || hipDeviceGetAttribute(&cus, hipDeviceAttributeMultiprocessorCount, dev) != hipSuccess) { grid = -1; return; }
        if (hipFuncSetAttribute((const void*)mk_fwd, hipFuncAttributeMaxDynamicSharedMemorySize, LDS_BYTES) != hipSuccess) { fprintf(stderr, "kernel_launch: hipFuncSetAttribute failed\n"); grid = -1; return; }
        int per_cu = 0;
        if (hipOccupancyMaxActiveBlocksPerMultiprocessor(&per_cu, (const void*)mk_fwd, 512, LDS_BYTES) != hipSuccess || per_cu < 1) fprintf(stderr, "kernel_launch: occupancy query reports %d\n", per_cu);
        (void)hipGetLastError();
        grid = cus;
    }
    if (grid < 0) return;
    if (hipMemsetAsync((char*)d_ws + WS_CTL, 0, CTL_ZERO_BYTES, stream) != hipSuccess) return;
    if (hipMemsetAsync((char*)d_ws + WS_XG, 0, (size_t)NL * MAXRT * 256 * 4, stream) != hipSuccess) return;
    Args a{};
    for (int i = 0; i < 29; ++i) a.in[i] = (const float*)d_in[i];
    a.out = (float*)d_out; a.ws = (unsigned char*)d_ws;
#if MK_MULTI
    for (int ph = 0; ph < NPH; ++ph) { a.ph_lo = ph; a.ph_hi = ph + 1; hipLaunchKernelGGL(mk_fwd, dim3(grid), dim3(512), LDS_BYTES, stream, a); }
#else
    a.ph_lo = 0; a.ph_hi = NPH; hipLaunchKernelGGL(mk_fwd, dim3(grid), dim3(512), LDS_BYTES, stream, a);
#endif
}
```

```cpp
#include <hip/hip_runtime.h>
#include <cstdio>
#include <cstdint>
#ifndef MK_MULTI
#define MK_MULTI 0
#endif
namespace pg8 {
#define PG8_LAS __attribute__((address_space(3)))
typedef unsigned short bf16_t;
typedef short bf16x8 __attribute__((ext_vector_type(8)));
typedef float f32x4 __attribute__((ext_vector_type(4)));
typedef unsigned u32x4 __attribute__((ext_vector_type(4)));
constexpr int BM = 256, BK = 64, HALF = 128, HTB = HALF * BK * 2  , STAGE_BYTES = 8 * HTB, NXCD = 8, WGM = 8;

__host__ __device__ __forceinline__ int lds_byte(int r, int c) { const int st = (r >> 4) * 2 + (c >> 5), rr = r & 15, cc = c & 31, ob = rr * 64 + cc * 2; return st * 1024 + (ob ^ (((ob >> 9) & 1) << 5)); }
__host__ __device__ __forceinline__ void stage_rc(int b, int& R, int& C) { const int st = b / 1024, sb = b % 1024, swz = sb ^ (((sb >> 9) & 1) << 5); R = (st >> 1) * 16 + swz / 64; C = (st & 1) * 32 + (swz % 64) / 2; }
__host__ __device__ __forceinline__ int perm32(int rho) { const int n = rho >> 4, i = rho & 15; return 8 * (i >> 2) + 4 * n + (i & 3); }


struct Unit { int pm, pn, z; };
typedef float f32x2_t __attribute__((ext_vector_type(2)));
typedef __bf16 bf16x2_t __attribute__((ext_vector_type(2)));
__device__ __forceinline__ unsigned cvt_pk_bf16(float lo, float hi) { const f32x2_t v = {lo, hi}; return __builtin_bit_cast(unsigned, __builtin_convertvector(v, bf16x2_t)); }
template <class Epi, class Sched, bool ALIGN_EPI = false, bool SP2 = false>
__device__ __forceinline__ void gemm_phase(PG8_LAS unsigned char* lds, const int tid, const int K, const Sched& S, const Epi& E) {
    const int wid = __builtin_amdgcn_readfirstlane(tid >> 6), lane = tid & 63, wr = wid >> 2, wc = wid & 3, fr = lane & 15, fq = lane >> 4;
    const int nt = K / BK;
    unsigned voffA[2], voffB[2];
#pragma unroll
    for (int i = 0; i < 2; ++i) { int R, C; stage_rc(tid * 16 + i * 8192, R, C); const int Rb = Epi::PERM ? ((R & ~31) + perm32(R & 31)) : R;
        voffA[i] = (unsigned)(R * K + C) * 2u; voffB[i] = (unsigned)(Rb * K + C) * 2u; }
    unsigned gcu[2][2] = {{0u, 0u}, {0u, 0u}}; int gR[2] = {0, 0}, gC[2] = {0, 0};
    if constexpr (Sched::GATHER) {
#pragma unroll
        for (int i = 0; i < 2; ++i) stage_rc(tid * 16 + i * 8192, gR[i], gC[i]); }
    const size_t kstep = (size_t)(BK * 2);
    const size_t hstep = (size_t)HALF * K * 2;
    const size_t tstep = 2 * hstep;
    const unsigned ldsw = (unsigned)wid * 1024u;
    const int aoff = lds_byte(wr * 64 + fr, fq * 8), boff = lds_byte(wc * 32 + fr, fq * 8);
#define PG8_SA(b, h) (((b) * 2 + (h)) * HTB)
#define PG8_SB(b, h) ((4 + (b) * 2 + (h)) * HTB)
#define PG8_STAGE(bufoff, gbase, voff) do { _Pragma("unroll") for (int _i = 0; _i < 2; ++_i) \
        __builtin_amdgcn_global_load_lds((const unsigned*)((const char*)(gbase) + (voff)[_i]), (PG8_LAS unsigned*)(lds + (bufoff) + ldsw + _i * 8192), 16, 0, 0); } while (0)
#define PG8_STAGE_A(b, h, base, nx) do { if constexpr (Sched::GATHER) { if (nx) { unsigned gn_[2]; _Pragma("unroll") for (int i_ = 0; i_ < 2; ++i_) gn_[i_] = S.a_off(ui + 1, (h) * HALF + gR[i_]) + (unsigned)gC[i_] * 2u; PG8_STAGE(PG8_SA(b, h), base, gn_); } else PG8_STAGE(PG8_SA(b, h), base, gcu[h]); } else PG8_STAGE(PG8_SA(b, h), (base) + (h) * hstep, voffA); } while (0)
#define PG8_LDA(dst, b, h) do { _Pragma("unroll") for (int m = 0; m < 4; ++m) _Pragma("unroll") for (int k = 0; k < 2; ++k) dst[m][k] = *(const PG8_LAS bf16x8*)(lds + PG8_SA(b, h) + aoff + m * 2048 + k * 1024); } while (0)
#define PG8_LDB(dst, b, h) do { _Pragma("unroll") for (int n = 0; n < 2; ++n) _Pragma("unroll") for (int k = 0; k < 2; ++k) dst[n][k] = *(const PG8_LAS bf16x8*)(lds + PG8_SB(b, h) + boff + n * 2048 + k * 1024); } while (0)
#define PG8_MMA(ai, bj, At, Bt) do { __builtin_amdgcn_s_setprio(1); _Pragma("unroll") for (int m = 0; m < 4; ++m) _Pragma("unroll") for (int n = 0; n < 2; ++n) _Pragma("unroll") for (int k = 0; k < 2; ++k) \
        acc[ai][bj][m][n] = __builtin_amdgcn_mfma_f32_16x16x32_bf16(Bt[n][k], At[m][k], acc[ai][bj][m][n], 0, 0, 0); __builtin_amdgcn_s_setprio(0); } while (0)
#define PG8_WAIT_V(n) asm volatile("s_waitcnt vmcnt(" #n ")" ::: "memory")
#define PG8_WAIT_L(n) asm volatile("s_waitcnt lgkmcnt(" #n ")" ::: "memory")
#define PG8_BAR __builtin_amdgcn_s_barrier()
#define PG8_SCHED __builtin_amdgcn_sched_barrier(0)
    Unit cur, nxt; int ui = 0;
    if (!S.next(0, cur)) return;
    f32x4 acc[2][2][4][2];
#pragma unroll
    for (int a = 0; a < 2; ++a)
#pragma unroll
        for (int b = 0; b < 2; ++b)
#pragma unroll
            for (int m = 0; m < 4; ++m)
#pragma unroll
                for (int n = 0; n < 2; ++n) acc[a][b][m][n] = (f32x4){0.f, 0.f, 0.f, 0.f};
    bf16x8 At[4][2], B0[2][2], B1[2][2];
    const char* cA = S.a_ptr(cur); const char* cB = S.b_ptr(cur);
    if constexpr (Sched::GATHER) {
#pragma unroll
        for (int h = 0; h < 2; ++h)
#pragma unroll
            for (int i = 0; i < 2; ++i) gcu[h][i] = S.a_off(0, h * HALF + gR[i]) + (unsigned)gC[i] * 2u; }
    S.a_ready(cur);
    if constexpr (SP2) {
        PG8_STAGE(PG8_SB(0, 0), cB, voffB); PG8_STAGE(PG8_SB(0, 1), cB + hstep, voffB); PG8_STAGE_A(0, 0, cA, false); PG8_STAGE_A(0, 1, cA, false);
        if (wr == 1) PG8_BAR;
        PG8_WAIT_V(2); PG8_BAR;
        PG8_STAGE(PG8_SB(1, 0), cB + kstep, voffB); PG8_STAGE_A(1, 0, cA + kstep, false); PG8_STAGE(PG8_SB(1, 1), cB + hstep + kstep, voffB);
        PG8_WAIT_V(6); PG8_BAR;
    } else {
        PG8_STAGE(PG8_SB(0, 0), cB, voffB); PG8_STAGE_A(0, 0, cA, false); PG8_STAGE(PG8_SB(0, 1), cB + hstep, voffB); PG8_STAGE_A(0, 1, cA, false);
        if (wr == 1) PG8_BAR;
        PG8_WAIT_V(4); PG8_BAR;
        PG8_STAGE(PG8_SB(1, 0), cB + kstep, voffB); PG8_STAGE_A(1, 0, cA + kstep, false); PG8_STAGE(PG8_SB(1, 1), cB + hstep + kstep, voffB);
        PG8_WAIT_V(6); PG8_BAR;
    }
    for (;;) {
        const bool has_next = S.next(ui + 1, nxt);
        const char* nA = has_next ? S.a_ptr(nxt) : cA; const char* nB = has_next ? S.b_ptr(nxt) : cB;

        for (int t = 0; t < nt; t += 2) {
            const bool last = (t == nt - 2);
            const char* a1 = cA + (size_t)(t + 1) * kstep;
            const char* a2 = last ? nA : cA + (size_t)(t + 2) * kstep; const char* b2 = last ? nB : cB + (size_t)(t + 2) * kstep;
            const char* a3 = a2 + kstep; const char* b3 = b2 + kstep;
            if (last && has_next) S.a_ready(nxt);
            if constexpr (SP2) {
            PG8_LDB(B0, 0, 0); PG8_LDB(B1, 0, 1); PG8_SCHED; PG8_LDA(At, 0, 0); PG8_STAGE_A(1, 1, a1, false);
            PG8_WAIT_V(8); PG8_WAIT_L(0); PG8_BAR; PG8_MMA(0, 0, At, B0); PG8_MMA(0, 1, At, B1); PG8_BAR; PG8_SCHED;
            PG8_LDA(At, 0, 1); PG8_STAGE(PG8_SB(0, 0), b2, voffB); PG8_STAGE(PG8_SB(0, 1), b2 + hstep, voffB); PG8_STAGE_A(0, 0, a2, (last && has_next));
            PG8_WAIT_V(8); PG8_WAIT_L(0); PG8_BAR; PG8_MMA(1, 0, At, B0); PG8_MMA(1, 1, At, B1); PG8_BAR; PG8_SCHED;
            PG8_LDB(B0, 1, 0); PG8_LDB(B1, 1, 1); PG8_SCHED; PG8_LDA(At, 1, 0); PG8_STAGE_A(0, 1, a2, (last && has_next));
            PG8_WAIT_V(8); PG8_WAIT_L(0); PG8_BAR; PG8_MMA(0, 0, At, B0); PG8_MMA(0, 1, At, B1); PG8_BAR; PG8_SCHED;
            PG8_LDA(At, 1, 1); PG8_STAGE(PG8_SB(1, 0), b3, voffB); PG8_STAGE(PG8_SB(1, 1), b3 + hstep, voffB); PG8_STAGE_A(1, 0, a3, (last && has_next));
            PG8_WAIT_V(8); PG8_WAIT_L(0); PG8_BAR; PG8_MMA(1, 0, At, B0); PG8_MMA(1, 1, At, B1); PG8_BAR; PG8_SCHED;
            } else {
            PG8_LDB(B0, 0, 0); PG8_SCHED; PG8_LDA(At, 0, 0); PG8_STAGE_A(1, 1, a1, false);
            PG8_WAIT_L(8); PG8_BAR; PG8_WAIT_L(0); PG8_MMA(0, 0, At, B0); PG8_BAR; PG8_SCHED;
            PG8_LDB(B1, 0, 1); PG8_STAGE(PG8_SB(0, 0), b2, voffB);
            PG8_BAR; PG8_WAIT_L(0); PG8_MMA(0, 1, At, B1); PG8_BAR;
            PG8_LDA(At, 0, 1); PG8_STAGE_A(0, 0, a2, (last && has_next));
            PG8_BAR; PG8_WAIT_L(0); PG8_MMA(1, 0, At, B0); PG8_BAR; PG8_SCHED;
            PG8_STAGE(PG8_SB(0, 1), b2 + hstep, voffB);
            PG8_WAIT_V(6); PG8_BAR; PG8_MMA(1, 1, At, B1); PG8_BAR;
            PG8_LDB(B0, 1, 0); PG8_SCHED; PG8_LDA(At, 1, 0); PG8_STAGE_A(0, 1, a2, (last && has_next));
            PG8_WAIT_L(8); PG8_BAR; PG8_WAIT_L(0); PG8_MMA(0, 0, At, B0); PG8_BAR; PG8_SCHED;
            PG8_LDB(B1, 1, 1); PG8_STAGE(PG8_SB(1, 0), b3, voffB);
            PG8_BAR; PG8_WAIT_L(0); PG8_MMA(0, 1, At, B1); PG8_BAR;
            PG8_LDA(At, 1, 1); PG8_STAGE_A(1, 0, a3, (last && has_next));
            PG8_BAR; PG8_WAIT_L(0); PG8_MMA(1, 0, At, B0); PG8_BAR; PG8_SCHED;
            PG8_STAGE(PG8_SB(1, 1), b3 + hstep, voffB);
            PG8_WAIT_V(6); PG8_BAR; PG8_MMA(1, 1, At, B1); PG8_BAR;
            }
        }
        if constexpr (ALIGN_EPI) { if (wr == 0) PG8_BAR; }
        bool keep_acc = false;
        if constexpr (Epi::CHAIN) { keep_acc = E.chain(acc, cur, wr, wc, fr, fq); S.done(cur); }
        else if constexpr (!Epi::AFTER_DRAIN) { E(acc, cur, wr, wc, fr, fq); S.done(cur); }
        if (!has_next) break;
        if (!keep_acc) {
#pragma unroll
        for (int a = 0; a < 2; ++a)
#pragma unroll
            for (int b = 0; b < 2; ++b)
#pragma unroll
                for (int m = 0; m < 4; ++m)
#pragma unroll
                    for (int n = 0; n < 2; ++n) acc[a][b][m][n] = (f32x4){0.f, 0.f, 0.f, 0.f};
        }
        cur = nxt; cA = nA; cB = nB; ++ui;
        if constexpr (Sched::GATHER) {
#pragma unroll
            for (int h = 0; h < 2; ++h)
#pragma unroll
                for (int i = 0; i < 2; ++i) gcu[h][i] = S.a_off(ui, h * HALF + gR[i]) + (unsigned)gC[i] * 2u; }
        if constexpr (ALIGN_EPI) { if (wr == 1) PG8_BAR; }
    }
    PG8_WAIT_V(0);
    if constexpr (!ALIGN_EPI) { if (wr == 0) PG8_BAR; }
    PG8_BAR;
    if constexpr (Epi::AFTER_DRAIN) { E.fused(acc, cur, wr, wc, fr, fq, lds, wid, lane); S.done(cur); }
#undef PG8_SA
#undef PG8_SB
#undef PG8_STAGE
#undef PG8_STAGE_A
#undef PG8_LDA
#undef PG8_LDB
#undef PG8_MMA
#undef PG8_WAIT_V
#undef PG8_WAIT_L
#undef PG8_BAR
#undef PG8_SCHED
}
}

constexpr int NL = 4, D = 1024, SEQ = 16384, CTX = 256, T = SEQ + CTX;
constexpr int IN_COLS = 7472, NIN = 7680;
constexpr int PC_AQ = 0, PC_AK = 512, PC_AV = 1024, PC_AZ = 1536, PC_BQ = 2048, PC_BK = 2304, PC_BV = 2560, PC_BZ = 3072, PC_CQ = 3584, PC_CK = 4096, PC_CV = 4224, PC_GL = 4352, PC_SM = 7424;
constexpr int NE = 32, TOPK = 4, DFF = 1024, MAXRT = 292;
constexpr float EPS = 1e-6f;
constexpr int NPH_PRO = 2, NPH_LAYER = 11, NPH = NPH_PRO + NL * NPH_LAYER;

constexpr size_t MiB = 1u << 20;
constexpr size_t WS_CTL = 0, CTL_ZERO_BYTES = 1 * MiB;
constexpr size_t WS_MOD = 1 * MiB;
constexpr size_t WS_ROPE = 1 * MiB + 512 * 1024;
constexpr size_t WS_WIN = 2 * MiB;
constexpr size_t WS_WBR = 62 * MiB;
constexpr size_t WS_WO = 74 * MiB;
constexpr size_t WS_WGU = 82 * MiB;
constexpr size_t WS_WDN = 594 * MiB;
constexpr size_t WS_XS = 850 * MiB;
constexpr size_t WS_H = 915 * MiB;
constexpr size_t WS_P = 948 * MiB;
constexpr size_t WS_SM = 1192 * MiB;
constexpr size_t WS_DQ = 1197 * MiB, WS_DK = 1230 * MiB, WS_DV = 1263 * MiB;
constexpr size_t WS_DG = 1296 * MiB, WS_DB = 1297 * MiB;
constexpr size_t WS_GK = 1298 * MiB;
constexpr size_t WS_DO = 1331 * MiB, WS_GO = 1396 * MiB;
constexpr size_t WS_YABC = 1461 * MiB, YSTRIDE = (size_t)T * 512 * 2;
constexpr size_t WS_MF = 1510 * MiB;
constexpr size_t WS_MG = 1575 * MiB;
constexpr size_t WS_RT = 1608 * MiB;
constexpr size_t WS_XG = 1610 * MiB, WS_ACT = 1756 * MiB, WS_Y = 1902 * MiB;
constexpr size_t WS_QH = 2048 * MiB;
constexpr size_t WS_GG = 2066 * MiB;
constexpr size_t WS_GD = 2131 * MiB;
constexpr size_t WS_ST = 2132 * MiB;
constexpr size_t WS_DF = 2165 * MiB;
constexpr size_t WS_DU = 2280 * MiB;
constexpr size_t WS_DGT = 2345 * MiB;
constexpr size_t WS_DSN = 1298 * MiB;
constexpr int DSN_BYTES = 49152, DSN_V = 32768;
constexpr size_t WS_WRT = 2346 * MiB;
constexpr size_t WS_HLO = 2347 * MiB;
constexpr size_t WS_QN = WS_DQ, WS_KN = WS_DK;
constexpr size_t WS_END = 2400 * MiB;
constexpr int DF_NW = 0, DF_QD = 16384, DF_QK = 32768, DF_KDT = 40960, DF_BYTES = 57344;
constexpr int CW_BAR = 4096, CW_CNT = 16384;

constexpr int RING_BYTES = 131072, MISC_OFF = RING_BYTES, LDS_BYTES = 163840;

#define GAS __attribute__((address_space(1)))
#define LAS __attribute__((address_space(3)))
typedef unsigned short bf16;
typedef unsigned v4u __attribute__((ext_vector_type(4)));
typedef unsigned v2u __attribute__((ext_vector_type(2)));
typedef float f32x4 __attribute__((ext_vector_type(4)));
typedef short bf16x8 __attribute__((ext_vector_type(8)));
#define LDS_WAIT() asm volatile("s_waitcnt lgkmcnt(0)" ::: "memory")
using pg8::cvt_pk_bf16; using pg8::Unit;
__device__ __forceinline__ float bf_lo(unsigned u) { return __uint_as_float(u << 16); }
__device__ __forceinline__ float bf_hi(unsigned u) { return __uint_as_float(u & 0xffff0000u); }
__device__ __forceinline__ float bf2f(bf16 b) { return __uint_as_float((unsigned)b << 16); }
template <int CTRL> __device__ __forceinline__ float dppf(float v) { return __builtin_bit_cast(float, __builtin_amdgcn_update_dpp(0, __builtin_bit_cast(int, v), CTRL, 0xf, 0xf, true)); }
template <int CTRL> __device__ __forceinline__ int dppi(int v) { return __builtin_amdgcn_update_dpp(0, v, CTRL, 0xf, 0xf, true); }
__device__ __forceinline__ float row_sum4(float v) { v += dppf<0xB1>(v); v += dppf<0x4E>(v); return v; }
__device__ __forceinline__ float row_sum8(float v) { v = row_sum4(v); v += dppf<0x141>(v); return v; }
__device__ __forceinline__ float row_sum16(float v) { v = row_sum8(v); v += dppf<0x140>(v); return v; }
__device__ __forceinline__ float row_max16(float v) { v = fmaxf(v, dppf<0xB1>(v)); v = fmaxf(v, dppf<0x4E>(v)); v = fmaxf(v, dppf<0x141>(v)); v = fmaxf(v, dppf<0x140>(v)); return v; }
__device__ __forceinline__ int row_min16(int v) { v = min(v, dppi<0xB1>(v)); v = min(v, dppi<0x4E>(v)); v = min(v, dppi<0x141>(v)); v = min(v, dppi<0x140>(v)); return v; }
__device__ __forceinline__ float wave_sum(float v) { v = row_sum16(v);
    return (__builtin_bit_cast(float, __builtin_amdgcn_readlane(__builtin_bit_cast(int, v), 0)) + __builtin_bit_cast(float, __builtin_amdgcn_readlane(__builtin_bit_cast(int, v), 16))) + (__builtin_bit_cast(float, __builtin_amdgcn_readlane(__builtin_bit_cast(int, v), 32)) + __builtin_bit_cast(float, __builtin_amdgcn_readlane(__builtin_bit_cast(int, v), 48))); }
__device__ __forceinline__ float wave_max(float v) { v = row_max16(v);
    return fmaxf(fmaxf(__builtin_bit_cast(float, __builtin_amdgcn_readlane(__builtin_bit_cast(int, v), 0)), __builtin_bit_cast(float, __builtin_amdgcn_readlane(__builtin_bit_cast(int, v), 16))), fmaxf(__builtin_bit_cast(float, __builtin_amdgcn_readlane(__builtin_bit_cast(int, v), 32)), __builtin_bit_cast(float, __builtin_amdgcn_readlane(__builtin_bit_cast(int, v), 48)))); }
__device__ __forceinline__ float fexp2(float x) { return __builtin_amdgcn_exp2f(x); }
__device__ __forceinline__ float fexp(float x) { return __builtin_amdgcn_exp2f(x * 1.4426950408889634f); }
__device__ __forceinline__ float flog(float x) { return __builtin_amdgcn_logf(x) * 0.6931471805599453f; }
__device__ __forceinline__ float sigmoid_f(float x) { return __builtin_amdgcn_rcpf(1.0f + fexp(-x)); }
__device__ __forceinline__ float softplus_f(float x) { return fmaxf(x, 0.f) + flog(1.0f + fexp(-fabsf(x))); }


#ifndef PROBE_KIND
#define PROBE_KIND -1
#endif
#ifndef PROBE_N
#define PROBE_N 0
#endif
__device__ __forceinline__ int opq_s(int v);
#define PROBE_REPS(k) (((k) == PROBE_KIND) ? opq_s(PROBE_N + 1) : 1)
#define XB_TMO      128
#define XB_XCNT(j)  (256  + 64 * (j))
#define XB_XSUB(j)  (1280 + 64 * (j))
#define XB_XGEN(j)  (2304 + 64 * (j))
#define XB_TOP      3328
#define XB_TOPGEN   3392
#define XCD_BAR_WORDS 3456
#define XB_SPIN_CAP (1u << 18)

__device__ __forceinline__ unsigned xb_ld(unsigned* p)              { return __hip_atomic_load(p, __ATOMIC_RELAXED, __HIP_MEMORY_SCOPE_AGENT); }
__device__ __forceinline__ unsigned xb_add(unsigned* p, unsigned v) { return __hip_atomic_fetch_add(p, v, __ATOMIC_RELAXED, __HIP_MEMORY_SCOPE_AGENT); }
__device__ __forceinline__ unsigned xb_xcc_id() { return (unsigned)__builtin_amdgcn_s_getreg((3 << 11) | 20) & 0xFu; }
#define XB_SPIN(cond, bar) do { unsigned _sp = 0; while (cond) { __builtin_amdgcn_s_sleep(1); \
    if ((++_sp & 255u) == 0u) { if (xb_ld(&(bar)[XB_TMO])) break; if (_sp > XB_SPIN_CAP) { atomicAdd(&(bar)[XB_TMO], 1u); break; } } } } while (0)

struct XcdBarrier {
    bool lead;
    unsigned* bar; unsigned x;
    volatile LAS unsigned* st;
};

__device__ __forceinline__ XcdBarrier xcd_barrier_post(unsigned* bar, volatile LAS unsigned* st, bool lead) {
    XcdBarrier b; b.lead = lead; b.bar = bar; b.x = xb_xcc_id(); b.st = st;
    if (lead) (void)xb_add(&bar[XB_XCNT(b.x)], 1u);
    return b;
}
__device__ __forceinline__ void xcd_barrier_complete(unsigned* bar, unsigned x, unsigned& nloc, unsigned& nx) {
    const unsigned G = gridDim.x * gridDim.y * gridDim.z;
    unsigned sum, cnt, mine, sp = 0u;
    for (;;) {
        sum = 0u; cnt = 0u; mine = 0u;
#pragma unroll
        for (unsigned j = 0; j < 16; ++j) { const unsigned c = xb_ld(&bar[XB_XCNT(j)]); sum += c; cnt += (c > 0u) ? 1u : 0u; mine = (j == x) ? c : mine; }
        if (sum == G) break;
        __builtin_amdgcn_s_sleep(1);
        if ((++sp & 255u) == 0u) { if (xb_ld(&bar[XB_TMO])) break; if (sp > XB_SPIN_CAP) { atomicAdd(&bar[XB_TMO], 1u); break; } }
    }
    nloc = mine > 0u ? mine : 1u; nx = cnt > 0u ? cnt : 1u;
}

__device__ __forceinline__ void xcd_barrier(const XcdBarrier& b) {
    asm volatile("s_waitcnt vmcnt(0)" ::: "memory");
    __syncthreads();
    if (b.lead) {
        unsigned* bar = b.bar;
        __builtin_amdgcn_s_waitcnt(0);
        unsigned nloc = b.st[0], nx = b.st[1];
        if (nloc == 0u) { xcd_barrier_complete(bar, b.x, nloc, nx); b.st[0] = nloc; b.st[1] = nx; }
        const unsigned old = xb_add(&bar[XB_XSUB(b.x)], 1u);
        const unsigned gen = old / nloc;
        if (old + 1u == (gen + 1u) * nloc) {
            __builtin_amdgcn_fence(__ATOMIC_RELEASE, "agent");
            asm volatile("s_waitcnt vmcnt(0)" ::: "memory");
            const unsigned og = xb_add(&bar[XB_TOP], 1u);
            const unsigned tg = og / nx;
            if (og + 1u == (tg + 1u) * nx) xb_add(&bar[XB_TOPGEN], 1u);
            else XB_SPIN(xb_ld(&bar[XB_TOPGEN]) == tg, bar);
            __builtin_amdgcn_fence(__ATOMIC_ACQUIRE, "agent");
            xb_add(&bar[XB_XGEN(b.x)], 1u);
            asm volatile("s_waitcnt vmcnt(0)" ::: "memory");
        } else {
            XB_SPIN(xb_ld(&bar[XB_XGEN(b.x)]) == gen, bar);
            __builtin_amdgcn_fence(__ATOMIC_ACQUIRE, "agent");
            asm volatile("s_waitcnt vmcnt(0)" ::: "memory");
        }
    }
    __syncthreads();
}

struct Args { const float* in[29]; float* out; unsigned char* ws; int ph_lo, ph_hi; };
typedef const __attribute__((address_space(4))) Args* ArgsP;
__device__ __forceinline__ const float* inp(ArgsP a, int k) { return (const float*)(const GAS float*)a->in[k]; }
__device__ __forceinline__ float* outp(ArgsP a) { return (float*)(GAS float*)a->out; }
struct Frame {
    LAS unsigned char* lds;
    unsigned* ctl;
    int tid, lane, wave, G, bid;
    unsigned char* ws;
};

struct TileOrder {
    static constexpr bool GATHER = false; __device__ __forceinline__ unsigned a_off(int, int) const { return 0u; }
    int nM, nN, nwg, G, c, pm0; const char* A; const char* B; size_t tstepA, tstepB;
    __device__ __forceinline__ void init(int nM_, int nN_, int G_, int c_, const void* A_, const void* B_, int K, int pm0_ = 0) { nM = nM_; nN = nN_; nwg = nM * nN; G = G_; c = c_; pm0 = pm0_; A = (const char*)A_; B = (const char*)B_; tstepA = tstepB = (size_t)256 * K * 2; }
    __device__ __forceinline__ void map(int wgid, Unit& u) const {
        { const int q = nwg / pg8::NXCD, r = nwg % pg8::NXCD, xcd = wgid % pg8::NXCD, off = wgid / pg8::NXCD; wgid = (xcd < r ? xcd * (q + 1) : r * (q + 1) + (xcd - r) * q) + off; }
        const int nig = pg8::WGM * nN, gid = wgid / nig, fm = gid * pg8::WGM, gsz = (nM - fm) < pg8::WGM ? (nM - fm) : pg8::WGM;
        u.pm = pm0 + fm + ((wgid % nig) % gsz); u.pn = (wgid % nig) / gsz;
    }
    __device__ __forceinline__ bool next(int i, Unit& u) const { const long L = (long)i * G + c; if (L >= nwg) return false; map((int)L, u); u.z = 0; return true; }
    __device__ __forceinline__ const char* a_ptr(const Unit& u) const { return A + (size_t)u.pm * tstepA; }
    __device__ __forceinline__ const char* b_ptr(const Unit& u) const { return B + (size_t)u.pn * tstepB; }
    __device__ __forceinline__ void a_ready(const Unit&) const {}
    __device__ __forceinline__ void done(const Unit&) const {}
};
struct BranchOrder : TileOrder {
    size_t zA, zB;
    __device__ __forceinline__ bool next(int i, Unit& u) const { const long L = (long)(i / 3) * G + c; if (L >= nwg) return false; map((int)L, u); u.z = i % 3; return true; }
    __device__ __forceinline__ const char* a_ptr(const Unit& u) const { return A + (size_t)u.z * zA + (size_t)u.pm * tstepA; }
    __device__ __forceinline__ const char* b_ptr(const Unit& u) const { return B + (size_t)u.z * zB + (size_t)u.pn * tstepB; }
};
template <bool GATHER_> struct MoeOrderT {
    static constexpr bool GATHER = GATHER_;
    const LAS int* gidx; unsigned rowbytes;
    __device__ __forceinline__ unsigned a_off(int ui, int row) const { return (unsigned)gidx[ui * 256 + row] * rowbytes; }
    int rt, nN, G, c; const LAS unsigned char* tile_e; const char* A; const char* B; size_t tstepA, tstepB, zB;
    __device__ __forceinline__ bool next(int i, Unit& u) const {
        if ((G & 7) != 0) { const long L = (long)i * G + c; if (L >= (long)rt * nN) return false; u.pm = (int)(L / nN); u.pn = (int)(L % nN); }
        else { const int x = c & 7, cx = c >> 3, gx = G >> 3, lo = (rt * x) >> 3, hi = (rt * (x + 1)) >> 3; const int Lx = i * gx + cx; if (Lx >= (hi - lo) * nN) return false; u.pm = lo + Lx / nN; u.pn = Lx % nN; }
        u.z = __builtin_amdgcn_readfirstlane((int)tile_e[u.pm]); return true; }
    __device__ __forceinline__ const char* a_ptr(const Unit& u) const { return GATHER_ ? A : A + (size_t)u.pm * tstepA; }
    __device__ __forceinline__ const char* b_ptr(const Unit& u) const { return B + (size_t)u.z * zB + (size_t)u.pn * tstepB; }
    __device__ __forceinline__ void a_ready(const Unit&) const {}
    __device__ __forceinline__ void done(const Unit&) const {}
};
typedef MoeOrderT<false> MoeOrder; typedef MoeOrderT<true> MoeGatherOrder;

typedef const pg8::f32x4 (&AccRef)[2][2][4][2];
struct EpiIn {
    static constexpr bool PERM = true, AFTER_DRAIN = false, CHAIN = false;
    bf16* P; float* SM;
    __device__ __forceinline__ void operator()(AccRef acc, const Unit& u, int wr, int wc, int fr, int fq) const {
        const int row0 = u.pm * 256 + wr * 64 + fr, pn = u.pn;
        if (pn == 29) {
            if (wc == 0 || (wc == 1 && fq < 2)) {
#pragma unroll
                for (int ai = 0; ai < 2; ++ai)
#pragma unroll
                    for (int m = 0; m < 4; ++m) { float* rp = SM + (size_t)(row0 + ai * 128 + m * 16) * 64 + wc * 32 + 8 * fq;
                        *(f32x4*)(rp) = acc[ai][0][m][0]; *(f32x4*)(rp + 4) = acc[ai][0][m][1]; }
            }
            return;
        }
        const int kind = (pn <= 5) ? 0 : (pn <= 7) ? 1 : (pn == 8) ? 3 : (pn <= 11) ? 0 : (pn <= 13) ? 1 : (pn <= 16) ? 0 : 2;
#pragma unroll
        for (int ai = 0; ai < 2; ++ai)
#pragma unroll
            for (int m = 0; m < 4; ++m) { bf16* rowp = P + (size_t)(row0 + ai * 128 + m * 16) * NIN + pn * 256 + wc * 32 + 8 * fq;
#pragma unroll
                for (int bj = 0; bj < 2; ++bj) { f32x4 v0 = acc[ai][bj][m][0], v1 = acc[ai][bj][m][1];
                    if (kind == 1) {
#pragma unroll
                        for (int j = 0; j < 4; ++j) { v0[j] = v0[j] * sigmoid_f(v0[j]); v1[j] = v1[j] * sigmoid_f(v1[j]); } }
                    else if (kind == 2) {
#pragma unroll
                        for (int j = 0; j < 4; ++j) { v0[j] = sigmoid_f(v0[j]); v1[j] = sigmoid_f(v1[j]); } }
                    else if (kind == 3) { v0 = v0 * 0.125f; v1 = v1 * 0.125f; }
                    v4u w; w.x = cvt_pk_bf16(v0[0], v0[1]); w.y = cvt_pk_bf16(v0[2], v0[3]); w.z = cvt_pk_bf16(v1[0], v1[1]); w.w = cvt_pk_bf16(v1[2], v1[3]);
                    *(v4u*)(rowp + bj * 128) = w; } }
    }
};
struct EpiBranch {
    static constexpr bool PERM = false, AFTER_DRAIN = false, CHAIN = true;
    const bf16* P; bf16* MG;
    __device__ __forceinline__ bool chain(pg8::f32x4 (&acc)[2][2][4][2], const Unit& u, int wr, int wc, int fr, int fq) const {
        const int row0 = u.pm * 256 + wr * 64 + fr, col0 = u.pn * 256 + wc * 32 + 4 * fq, z = u.z;
#pragma unroll
        for (int ai = 0; ai < 2; ++ai)
#pragma unroll
            for (int m = 0; m < 4; ++m) { const unsigned row = (unsigned)(row0 + ai * 128 + m * 16);
#pragma unroll
                for (int bj = 0; bj < 2; ++bj)
#pragma unroll
                    for (int n = 0; n < 2; ++n) { const int col = col0 + bj * 128 + n * 16;
                        const v2u gw = *(const v2u*)(P + (row * (unsigned)NIN + PC_GL + z * 1024 + col));
                        f32x4 g = (f32x4){bf_lo(gw.x), bf_hi(gw.x), bf_lo(gw.y), bf_hi(gw.y)};
                        if (z < 2) { const v2u gn = *(const v2u*)(P + (row * (unsigned)NIN + PC_GL + (z + 1) * 1024 + col));
                            g[0] *= __builtin_amdgcn_rcpf(fmaxf(bf_lo(gn.x), 1e-30f)); g[1] *= __builtin_amdgcn_rcpf(fmaxf(bf_hi(gn.x), 1e-30f)); g[2] *= __builtin_amdgcn_rcpf(fmaxf(bf_lo(gn.y), 1e-30f)); g[3] *= __builtin_amdgcn_rcpf(fmaxf(bf_hi(gn.y), 1e-30f));
                            acc[ai][bj][m][n] = acc[ai][bj][m][n] * g; }
                        else { const f32x4 v = acc[ai][bj][m][n] * g; v2u o; o.x = cvt_pk_bf16(v[0], v[1]); o.y = cvt_pk_bf16(v[2], v[3]); *(v2u*)(MG + (row * 1024u + col)) = o; } } }
        return z < 2;
    }
    __device__ __forceinline__ void operator()(AccRef, const Unit&, int, int, int, int) const {}
};
struct EpiWo {
    static constexpr bool PERM = false, AFTER_DRAIN = false, CHAIN = false;
    float* XS; const float* modl; const float* modc; bool commit;
    __device__ __forceinline__ void operator()(AccRef acc, const Unit& u, int wr, int wc, int fr, int fq) const {
        const int row0 = u.pm * 256 + wr * 64 + fr, col0 = u.pn * 256 + wc * 32 + 4 * fq; const float* mv = (u.pm == 0) ? modc : modl;
#pragma unroll
        for (int bj = 0; bj < 2; ++bj)
#pragma unroll
            for (int n = 0; n < 2; ++n) { const int col = col0 + bj * 128 + n * 16; const f32x4 g = *(const f32x4*)(mv + col);
#pragma unroll
                for (int ai = 0; ai < 2; ++ai)
#pragma unroll
                    for (int m = 0; m < 4; ++m) { float* xp = XS + (size_t)(row0 + ai * 128 + m * 16) * 1024 + col; const f32x4 v = *(const f32x4*)xp + g * acc[ai][bj][m][n]; if (commit) *(f32x4*)xp = v; else if (v[0] == 1.2345e30f) *xp = 0.f; } }
    }
};
struct EpiMoe1 {
    static constexpr bool PERM = true, AFTER_DRAIN = false, CHAIN = false;
    bf16* ACT; const float* bgu;
    __device__ __forceinline__ void operator()(AccRef acc, const Unit& u, int wr, int wc, int fr, int fq) const {
        const int row0 = u.pm * 256 + wr * 64 + fr, c0 = u.pn * 128 + wc * 32 + 8 * fq; const float* be = bgu + (size_t)u.z * 2048;
        const f32x4 bg0 = *(const f32x4*)(be + c0), bg1 = *(const f32x4*)(be + c0 + 4), bu0 = *(const f32x4*)(be + 1024 + c0), bu1 = *(const f32x4*)(be + 1024 + c0 + 4);
#pragma unroll
        for (int ai = 0; ai < 2; ++ai)
#pragma unroll
            for (int m = 0; m < 4; ++m) { f32x4 g0 = acc[ai][0][m][0] + bg0, g1 = acc[ai][0][m][1] + bg1, u0 = acc[ai][1][m][0] + bu0, u1 = acc[ai][1][m][1] + bu1; f32x4 o0, o1;
#pragma unroll
                for (int j = 0; j < 4; ++j) { float g = fminf(g0[j], 7.0f), uu = fminf(fmaxf(u0[j], -7.0f), 7.0f); o0[j] = (uu + 1.0f) * (g * sigmoid_f(1.702f * g));
                    g = fminf(g1[j], 7.0f); uu = fminf(fmaxf(u1[j], -7.0f), 7.0f); o1[j] = (uu + 1.0f) * (g * sigmoid_f(1.702f * g)); }
                v4u w; w.x = cvt_pk_bf16(o0[0], o0[1]); w.y = cvt_pk_bf16(o0[2], o0[3]); w.z = cvt_pk_bf16(o1[0], o1[1]); w.w = cvt_pk_bf16(o1[2], o1[3]);
                *(v4u*)(ACT + (size_t)(row0 + ai * 128 + m * 16) * 1024 + c0) = w; }
    }
};
struct EpiMoe2 {
    static constexpr bool PERM = true, AFTER_DRAIN = false, CHAIN = false;
    bf16* Y; const float* bdn;
    __device__ __forceinline__ void operator()(AccRef acc, const Unit& u, int wr, int wc, int fr, int fq) const {
        const int row0 = u.pm * 256 + wr * 64 + fr, c0 = u.pn * 256 + wc * 32 + 8 * fq; const float* be = bdn + (size_t)u.z * 1024;
#pragma unroll
        for (int bj = 0; bj < 2; ++bj) { const f32x4 b0 = *(const f32x4*)(be + c0 + bj * 128), b1 = *(const f32x4*)(be + c0 + bj * 128 + 4);
#pragma unroll
            for (int ai = 0; ai < 2; ++ai)
#pragma unroll
                for (int m = 0; m < 4; ++m) { const f32x4 v0 = acc[ai][bj][m][0] + b0, v1 = acc[ai][bj][m][1] + b1;
                    v4u w; w.x = cvt_pk_bf16(v0[0], v0[1]); w.y = cvt_pk_bf16(v0[2], v0[3]); w.z = cvt_pk_bf16(v1[0], v1[1]); w.w = cvt_pk_bf16(v1[2], v1[3]);
                    *(v4u*)(Y + (size_t)(row0 + ai * 128 + m * 16) * 1024 + c0 + bj * 128) = w; } }
    }
};

__device__ __forceinline__ void transpose_item(const float* W, int N, int K, bf16* WT, int k0, int src0, int dst0, int nvalid, LAS float* scr, int lane) {
    const int n = lane & 31;
    float v[32];
#pragma unroll
    for (int i = 0; i < 32; ++i) { const int kk = 2 * i + (lane >> 5); v[i] = (n < nvalid) ? W[(size_t)(k0 + kk) * N + src0 + n] : 0.f; }
    __builtin_amdgcn_sched_barrier(0);
#pragma unroll
    for (int i = 0; i < 32; ++i) { const int kk = 2 * i + (lane >> 5); scr[kk * 33 + n] = v[i]; }
    LDS_WAIT(); asm volatile("" ::: "memory");
    const int c = lane & 7;
#pragma unroll
    for (int j = 0; j < 4; ++j) { const int nn = (lane >> 3) + 8 * j; const LAS float* s = scr + (8 * c) * 33 + nn;
        v4u o; o.x = cvt_pk_bf16(s[0 * 33], s[1 * 33]); o.y = cvt_pk_bf16(s[2 * 33], s[3 * 33]); o.z = cvt_pk_bf16(s[4 * 33], s[5 * 33]); o.w = cvt_pk_bf16(s[6 * 33], s[7 * 33]);
        if (nn < nvalid) *(v4u*)(WT + (size_t)(dst0 + nn) * K + k0 + 8 * c) = o; }
    LDS_WAIT(); asm volatile("" ::: "memory");
}
constexpr int I_IN_L = 16 * 234, I_BR_L = 3 * 8 * 32, I_WO_L = 16 * 32, I_SMALL_L = I_IN_L + I_BR_L + I_WO_L;
__device__ __forceinline__ void convert_small_item(Frame& F, ArgsP a, int l, int r, LAS float* scr) {
    bf16* WIN = (bf16*)(F.ws + WS_WIN); bf16* WBR = (bf16*)(F.ws + WS_WBR); bf16* WO = (bf16*)(F.ws + WS_WO);
    if (r < I_IN_L) { const int kb = r / 234, nb = r % 234; int src, dst, nv = 32;
        if (nb < 64) { src = 32 * nb; dst = 32 * nb; }
        else if (nb < 80) { src = 2064 + 32 * (nb - 64); dst = 2048 + 32 * (nb - 64); }
        else if (nb < 112) { src = 2576 + 32 * (nb - 80); dst = 2560 + 32 * (nb - 80); }
        else if (nb < 136) { src = 3632 + 32 * (nb - 112); dst = 3584 + 32 * (nb - 112); }
        else if (nb < 232) { src = 4400 + 32 * (nb - 136); dst = 4352 + 32 * (nb - 136); }
        else if (nb == 232) { src = 2048; dst = 7424; nv = 16; }
        else { src = 3600; dst = 7440; }
        transpose_item(inp(a, 8) + (size_t)l * 1024 * IN_COLS, IN_COLS, 1024, WIN + (size_t)l * NIN * 1024, kb * 64, src, dst, nv, scr, F.lane); return; }
    r -= I_IN_L;
    if (r < I_BR_L) { const int z = r / 256, q = r % 256, kb = q / 32, nb = q % 32;
        transpose_item(inp(a, 19 + z) + (size_t)l * 512 * 1024, 1024, 512, WBR + (size_t)(l * 3 + z) * 1024 * 512, kb * 64, 32 * nb, 32 * nb, 32, scr, F.lane); return; }
    r -= I_BR_L;
    { const int kb = r / 32, nb = r % 32;
        transpose_item(inp(a, 22) + (size_t)l * 1024 * 1024, 1024, 1024, WO + (size_t)l * 1024 * 1024, kb * 64, 32 * nb, 32 * nb, 32, scr, F.lane); }
}
__device__ __forceinline__ void phase_prologue(Frame& F, ArgsP a) {
    {
        LAS float* sc = (LAS float*)F.lds; LAS float* part = sc + 2048;
        for (int i = F.tid; i < 2048; i += 512) { const float v = (i < 1024) ? inp(a, 1)[i] : inp(a, 3)[i - 1024]; sc[i] = v * sigmoid_f(v); }
        __syncthreads();
        float* MOD = (float*)(F.ws + WS_MOD);
        for (int bi = F.bid; bi < NL * 96; bi += F.G) {
            const int l = bi / 96, jb = bi % 96, cl = F.tid & 63, seg = F.tid >> 6;
            const float* W = inp(a, 4) + (size_t)l * 1024 * 6144 + jb * 64 + cl;
            float a0 = 0.f, a1 = 0.f;
#pragma unroll 8
            for (int k = seg * 128; k < seg * 128 + 128; ++k) { const float w = W[(size_t)k * 6144]; a0 += sc[k] * w; a1 += sc[1024 + k] * w; }
            part[(seg * 64 + cl) * 2] = a0; part[(seg * 64 + cl) * 2 + 1] = a1;
            __syncthreads();
            if (F.tid < 128) { const int c = F.tid & 63, s = F.tid >> 6; float sum = inp(a, 5)[l * 6144 + jb * 64 + c];
                for (int g = 0; g < 8; ++g) sum += part[(g * 64 + c) * 2 + s];
                MOD[(size_t)(l * 2 + s) * 6144 + jb * 64 + c] = sum; }
            __syncthreads();
        }
    }
    for (int i = F.bid * 512 + F.tid; i < 256 * 16; i += F.G * 512) { const float inv = exp2f(-(float)(i & 15) * (13.287712379549449f / 16.0f)); float sn, cs; sincosf((float)(i >> 4) * inv, &sn, &cs);
        float* rp = (float*)(F.ws + WS_ROPE) + (size_t)i * 2; rp[0] = cs; rp[1] = sn; }
    __syncthreads();
    for (int i = F.bid * 512 + F.tid; i < NL * 32 * 1024; i += F.G * 512) { const int l = i >> 15, e = (i >> 10) & 31, c = i & 1023; const float w = inp(a, 23)[(size_t)l * 32768 + c * 32 + e];
        const unsigned hi = cvt_pk_bf16(w, 0.f) & 0xffffu; const float lo = w - __uint_as_float(hi << 16);
        bf16* wr = (bf16*)(F.ws + WS_WRT) + (size_t)l * 65536 + e * 1024 + c; wr[0] = (bf16)hi; wr[32768] = (bf16)(cvt_pk_bf16(lo, 0.f) & 0xffffu); }
    LAS float* scr = (LAS float*)(F.lds + F.wave * 16384);
    const int gw = F.bid * 8 + F.wave, NGW = F.G * 8;
    bf16* WIN = (bf16*)(F.ws + WS_WIN); bf16* WBR = (bf16*)(F.ws + WS_WBR); bf16* WO = (bf16*)(F.ws + WS_WO); bf16* WGU = (bf16*)(F.ws + WS_WGU); bf16* WDN = (bf16*)(F.ws + WS_WDN);
    constexpr int I_IN = 16 * 234, I_BR = 8 * 32, I_WO = 16 * 32, I_GU = 16 * 64, I_DN = 16 * 32;
    constexpr int N_IN = NL * I_IN, N_BR = NL * 3 * I_BR, N_WO = NL * I_WO, N_GU = NL * NE * I_GU, N_DN = NL * NE * I_DN;
    if (F.G >= 160) { for (int it = gw; it < I_IN_L; it += NGW) convert_small_item(F, a, 0, it, scr); }
    else for (int it = gw; it < N_IN + N_BR + N_WO + N_GU + N_DN; it += NGW) {
        int r = it;
        if (r < N_IN) { const int l = r / I_IN; r %= I_IN; const int kb = r / 234, nb = r % 234; int src, dst, nv = 32;
            if (nb < 64) { src = 32 * nb; dst = 32 * nb; }
            else if (nb < 80) { src = 2064 + 32 * (nb - 64); dst = 2048 + 32 * (nb - 64); }
            else if (nb < 112) { src = 2576 + 32 * (nb - 80); dst = 2560 + 32 * (nb - 80); }
            else if (nb < 136) { src = 3632 + 32 * (nb - 112); dst = 3584 + 32 * (nb - 112); }
            else if (nb < 232) { src = 4400 + 32 * (nb - 136); dst = 4352 + 32 * (nb - 136); }
            else if (nb == 232) { src = 2048; dst = 7424; nv = 16; }
            else { src = 3600; dst = 7440; }
            transpose_item(inp(a, 8) + (size_t)l * 1024 * IN_COLS, IN_COLS, 1024, WIN + (size_t)l * NIN * 1024, kb * 64, src, dst, nv, scr, F.lane); continue; }
        r -= N_IN;
        if (r < N_BR) { const int lz = r / I_BR; r %= I_BR; const int l = lz / 3, z = lz % 3, kb = r / 32, nb = r % 32;
            transpose_item(inp(a, 19 + z) + (size_t)l * 512 * 1024, 1024, 512, WBR + (size_t)lz * 1024 * 512, kb * 64, 32 * nb, 32 * nb, 32, scr, F.lane); continue; }
        r -= N_BR;
        if (r < N_WO) { const int l = r / I_WO; r %= I_WO; const int kb = r / 32, nb = r % 32;
            transpose_item(inp(a, 22) + (size_t)l * 1024 * 1024, 1024, 1024, WO + (size_t)l * 1024 * 1024, kb * 64, 32 * nb, 32 * nb, 32, scr, F.lane); continue; }
        r -= N_WO;
        if (r < N_GU) { const int le = r / I_GU; r %= I_GU; const int kb = r / 64, nb = r % 64;
            const int dst = (nb < 32) ? 256 * (nb >> 2) + 32 * (nb & 3) : 256 * ((nb - 32) >> 2) + 128 + 32 * ((nb - 32) & 3);
            transpose_item(inp(a, 25) + (size_t)le * 1024 * 2048, 2048, 1024, WGU + (size_t)le * 2048 * 1024, kb * 64, 32 * nb, dst, 32, scr, F.lane); continue; }
        r -= N_GU;
        { const int le = r / I_DN; r %= I_DN; const int kb = r / 32, nb = r % 32;
            transpose_item(inp(a, 27) + (size_t)le * 1024 * 1024, 1024, 1024, WDN + (size_t)le * 1024 * 1024, kb * 64, 32 * nb, 32 * nb, 32, scr, F.lane); }
    }
    for (int i = F.bid * 512 + F.tid; i < NL * 208 * 128; i += F.G * 512) { const int l = i / (208 * 128), r = i % (208 * 128);
        *(v4u*)(WIN + (size_t)l * NIN * 1024 + (size_t)7472 * 1024 + (size_t)r * 8) = (v4u){0u, 0u, 0u, 0u}; }
}

__device__ __forceinline__ void norm_mod_store(const f32x4 (&x)[4], const float* gain, const float* shift, const float* scale, bf16* hrow, int lane, f32x4 (&h)[4]) {
    float ss = 0.f;
#pragma unroll
    for (int j = 0; j < 4; ++j) ss += (x[j][0] * x[j][0] + x[j][1] * x[j][1]) + (x[j][2] * x[j][2] + x[j][3] * x[j][3]);
    const float rstd = rsqrtf(wave_sum(ss) * (1.0f / 1024.0f) + EPS);
#pragma unroll
    for (int j = 0; j < 4; ++j) { const int c = 4 * lane + 256 * j; const f32x4 g = *(const f32x4*)(gain + c), sh = *(const f32x4*)(shift + c), sc = *(const f32x4*)(scale + c);
        h[j] = (x[j] * rstd * g) * (sc + 1.0f) + sh;
        v2u o; o.x = cvt_pk_bf16(h[j][0], h[j][1]); o.y = cvt_pk_bf16(h[j][2], h[j][3]); *(v2u*)(hrow + c) = o; }
}
__device__ __forceinline__ void load_mod(const float* gain, const float* shift, const float* scale, int lane, f32x4 (&gs)[4], f32x4 (&sh)[4]) {
#pragma unroll
    for (int j = 0; j < 4; ++j) { const int c = 4 * lane + 256 * j; gs[j] = *(const f32x4*)(gain + c) * (*(const f32x4*)(scale + c) + 1.0f); sh[j] = *(const f32x4*)(shift + c); }
}
__device__ __forceinline__ void norm_mod_store2(const f32x4 (&x)[4], const f32x4 (&gs)[4], const f32x4 (&sh)[4], bf16* hrow, int lane, f32x4 (&h)[4]) {
    float ss = 0.f;
#pragma unroll
    for (int j = 0; j < 4; ++j) ss += (x[j][0] * x[j][0] + x[j][1] * x[j][1]) + (x[j][2] * x[j][2] + x[j][3] * x[j][3]);
    const float rstd = rsqrtf(wave_sum(ss) * (1.0f / 1024.0f) + EPS);
#pragma unroll
    for (int j = 0; j < 4; ++j) { h[j] = (x[j] * rstd) * gs[j] + sh[j];
        v2u o; o.x = cvt_pk_bf16(h[j][0], h[j][1]); o.y = cvt_pk_bf16(h[j][2], h[j][3]); *(v2u*)(hrow + 4 * lane + 256 * j) = o; }
}
__device__ __forceinline__ void phase_norm0(Frame& F, ArgsP a) {
    float* XS = (float*)(F.ws + WS_XS); bf16* H = (bf16*)(F.ws + WS_H); const float* MOD = (const float*)(F.ws + WS_MOD);
    for (int t = F.bid * 8 + F.wave; t < T; t += F.G * 8) {
        const float* src = (t < CTX) ? inp(a, 2) + (size_t)t * 1024 : inp(a, 0) + (size_t)(t - CTX) * 1024;
        f32x4 x[4], h[4];
#pragma unroll
        for (int j = 0; j < 4; ++j) { x[j] = *(const f32x4*)(src + 4 * F.lane + 256 * j); *(f32x4*)(XS + (size_t)t * 1024 + 4 * F.lane + 256 * j) = x[j]; }
        const float* mv = MOD + (size_t)((t < CTX) ? 1 : 0) * 6144;
        norm_mod_store(x, inp(a, 6), mv, mv + 1024, H + (size_t)t * 1024, F.lane, h);
    }
}

__device__ __forceinline__ void phase_prep(Frame& F, ArgsP a, int l) {
    const bf16* P = (const bf16*)(F.ws + WS_P);
    const int lane = F.lane;
    for (int t = F.bid * 8 + F.wave; t < T; t += F.G * 8) {
#pragma unroll
        for (int qk = 0; qk < 2; ++qk) {
            const bf16* ptr = P + (size_t)t * NIN + (qk == 0 ? PC_CQ : PC_CK) + 8 * lane;
            bf16* optr = (qk == 0) ? (bf16*)(F.ws + WS_QN) + (size_t)t * 512 + 8 * lane : (bf16*)(F.ws + WS_KN) + (size_t)t * 128 + 8 * lane;
            const bool act = (qk == 0) || (lane < 16);
            const v4u xv = act ? *(const v4u*)ptr : (v4u){0u, 0u, 0u, 0u};
            float y[8] = {bf_lo(xv.x), bf_hi(xv.x), bf_lo(xv.y), bf_hi(xv.y), bf_lo(xv.z), bf_hi(xv.z), bf_lo(xv.w), bf_hi(xv.w)};
            float ss = 0.f;
#pragma unroll
            for (int i = 0; i < 8; ++i) ss += y[i] * y[i];
            ss = row_sum8(ss);
            const float r = rsqrtf(ss * (1.0f / 64.0f) + EPS); const float* gn = inp(a, qk == 0 ? 16 : 17) + l * 64 + 8 * (lane & 7);
#pragma unroll
            for (int i = 0; i < 8; ++i) y[i] = y[i] * r * gn[i];
            if (t >= CTX) { const int p = t - CTX, hl = lane & 7; const int pos = (hl < 4) ? (p >> 6) : (p & 63); const int i0 = 8 * (hl & 1); const bool first = (hl & 2) == 0;
                const float* rp = (const float*)(F.ws + WS_ROPE) + ((size_t)pos * 16 + i0) * 2;
#pragma unroll
                for (int i2 = 0; i2 < 4; ++i2) { const f32x4 cs = *(const f32x4*)(rp + 4 * i2);
#pragma unroll
                    for (int u = 0; u < 2; ++u) { const int i = 2 * i2 + u; const float other = dppf<0x4E>(y[i]); const float c_ = cs[2 * u], s_ = cs[2 * u + 1];
                        y[i] = first ? (y[i] * c_ - other * s_) : (y[i] * c_ + other * s_); } } }
            if (act) { v4u o; o.x = cvt_pk_bf16(y[0], y[1]); o.y = cvt_pk_bf16(y[2], y[3]); o.z = cvt_pk_bf16(y[4], y[5]); o.w = cvt_pk_bf16(y[6], y[7]); *(v4u*)optr = o; }
        }
    }
}

__device__ __forceinline__ int scan_tok(int d, int n, int i) {
    if (n < 4) { const int p = 64 * n + i; return d ? (CTX - 1 - p) : p; }
    const int p = 64 * (n - 4) + i; return CTX + (d ? (SEQ - 1 - p) : p);
}
#define LSYNC() do { asm volatile("s_waitcnt lgkmcnt(0)" ::: "memory"); __builtin_amdgcn_s_barrier(); asm volatile("" ::: "memory"); } while (0)
__device__ __forceinline__ int chunk_tok0(int n) { return (n < 4) ? 64 * n : CTX + 64 * (n - 4); }
__device__ __forceinline__ int scan_chunk(int d, int s) { return d ? ((s < 4) ? 3 - s : 263 - s) : s; }
template <class Emit> __device__ __forceinline__ void tri_solve_blocked(const LAS float* L, const LAS bf16* Lbf, LAS bf16* TT  , LAS float* Y  , int lane, const Emit& emit) {
    const int fr = lane & 15, fq = lane >> 4;
#pragma unroll
    for (int k = 0; k < 8; ++k) *(LAS v4u*)(TT + lane * 64 + 8 * k) = (v4u){0u, 0u, 0u, 0u};
#pragma unroll
    for (int i = 0; i < 4; ++i) {
        float y[16];
#pragma unroll
        for (int r = 0; r < 16; ++r) y[r] = 0.f;
        if (i > 0) {
#pragma unroll
            for (int nt = 0; nt < i; ++nt) { f32x4 acc = (f32x4){0.f, 0.f, 0.f, 0.f};
#pragma unroll
                for (int ks = 0; ks < (i + 1) / 2; ++ks) { bf16x8 af = *(const LAS bf16x8*)(Lbf + (16 * i + fr) * 72 + 32 * ks + 8 * fq); if (32 * ks + 8 * fq >= 16 * i) af = (bf16x8){0, 0, 0, 0, 0, 0, 0, 0};
                    acc = __builtin_amdgcn_mfma_f32_16x16x32_bf16(af, *(const LAS bf16x8*)(TT + (16 * nt + fr) * 64 + 32 * ks + 8 * fq), acc, 0, 0, 0); }
#pragma unroll
                for (int jj = 0; jj < 4; ++jj) Y[(4 * fq + jj) * 64 + 16 * nt + fr] = acc[jj]; }
            asm volatile("s_waitcnt lgkmcnt(0)" ::: "memory");
#pragma unroll
            for (int r = 0; r < 16; ++r) { const float v = Y[r * 64 + lane]; y[r] = (lane < 16 * i) ? v : 0.f; }
        }
        float X[16];
#pragma unroll
        for (int r = 0; r < 16; ++r) { float acc = ((lane == 16 * i + r) ? 1.0f : 0.0f) - y[r];
#pragma unroll
            for (int s4 = 0; s4 < (r + 3) / 4; ++s4) { const f32x4 lv = *(const LAS f32x4*)(L + (16 * i + r) * 64 + 16 * i + 4 * s4);
#pragma unroll
                for (int u = 0; u < 4; ++u) if (4 * s4 + u < r) acc -= lv[u] * X[4 * s4 + u]; }
            X[r] = acc; emit(16 * i + r, acc); }
        { v4u w0, w1; w0.x = cvt_pk_bf16(X[0], X[1]); w0.y = cvt_pk_bf16(X[2], X[3]); w0.z = cvt_pk_bf16(X[4], X[5]); w0.w = cvt_pk_bf16(X[6], X[7]); w1.x = cvt_pk_bf16(X[8], X[9]); w1.y = cvt_pk_bf16(X[10], X[11]); w1.z = cvt_pk_bf16(X[12], X[13]); w1.w = cvt_pk_bf16(X[14], X[15]);
          *(LAS v4u*)(TT + lane * 64 + 16 * i) = w0; *(LAS v4u*)(TT + lane * 64 + 16 * i + 8) = w1; }
        asm volatile("s_waitcnt lgkmcnt(0)" ::: "memory");
    }
}
__device__ __forceinline__ void dn_prep_item(Frame& F, ArgsP a, int l, int item) {
    int tid_ = F.tid; asm volatile("" : "+v"(tid_));
    const int n = item % 260, h = item / 260, t0 = chunk_tok0(n), s0 = (n < 4) ? 0 : CTX, s1 = (n < 4) ? CTX : T, tid = tid_, lane = tid & 63, wv = __builtin_amdgcn_readfirstlane(tid >> 6), fr = lane & 15, fq = lane >> 4;
    LAS bf16* RAW = (LAS bf16*)F.lds;
    LAS float* Lm = (LAS float*)F.lds;
    LAS bf16* Lb = (LAS bf16*)(F.lds + 32768);
    LAS bf16* Qs = (LAS bf16*)(F.lds + 52224); LAS bf16* Ks = Qs + 64 * 136;
    LAS bf16* TPb = Qs;
    LAS bf16* KT = (LAS bf16*)(F.lds + 87040); LAS bf16* VT = KT + 128 * 72;
    LAS float* gc = (LAS float*)(F.lds + 123904); LAS float* be = gc + 128; LAS float* SS = be + 128;
    const bf16* P = (const bf16*)(F.ws + WS_P); const float* SM = (const float*)(F.ws + WS_SM);
    unsigned char* DF0 = F.ws + WS_DF + (size_t)(h * 260 + n) * DF_BYTES; unsigned char* DF1 = DF0 + (size_t)4 * 260 * DF_BYTES;
    bf16* DU0 = (bf16*)(F.ws + WS_DU) + (size_t)(h * 260 + n) * 8192; bf16* DU1 = DU0 + (size_t)4 * 260 * 8192;
    __syncthreads();
    LAS float* CW = (LAS float*)(F.lds + MISC_OFF + 2560);
    for (int idx = tid; idx < 68 * 48; idx += 512) { const int rr = idx / 48, ch = idx % 48, p = ch >> 4, c8 = (ch & 15) * 8, tok = t0 - 2 + rr;
        v4u x = (v4u){0u, 0u, 0u, 0u}; if (tok >= s0 && tok < s1) x = *(const v4u*)(P + (size_t)tok * NIN + PC_AQ + p * 512 + h * 128 + c8);
        *(LAS v4u*)(RAW + rr * 384 + p * 128 + c8) = x; }
    for (int idx = tid; idx < 5 * 384; idx += 512) { const int j = idx / 384, c = idx % 384; CW[idx] = inp(a, 9)[(size_t)(l * 5 + j) * 1536 + (c >> 7) * 512 + h * 128 + (c & 127)]; }
    if (wv < 2) { const int d = wv; const float aa = SM[(size_t)(t0 + lane) * 64 + d * 4 + h], ab = SM[(size_t)(t0 + lane) * 64 + 8 + d * 4 + h];
        float v = -fexp(inp(a, 10)[l * 8 + d * 4 + h]) * softplus_f(aa + inp(a, 11)[l * 8 + d * 4 + h]);
#pragma unroll
        for (int o = 1; o < 64; o <<= 1) { const float u = d ? __shfl_down(v, o) : __shfl_up(v, o); if (d ? (lane + o < 64) : (lane >= o)) v += u; }
        gc[d * 64 + lane] = v; be[d * 64 + lane] = sigmoid_f(ab); }
    __syncthreads();
    if (tid < 384) { const int co = tid % 48, pg = tid / 48, p = co >> 4, c0 = 8 * (co & 15), cr = p * 128 + c0;
        float w[5][8];
#pragma unroll
        for (int j = 0; j < 5; ++j) { const f32x4 wa = *(const LAS f32x4*)(CW + j * 384 + cr), wb = *(const LAS f32x4*)(CW + j * 384 + cr + 4);
            w[j][0] = wa[0]; w[j][1] = wa[1]; w[j][2] = wa[2]; w[j][3] = wa[3]; w[j][4] = wb[0]; w[j][5] = wb[1]; w[j][6] = wb[2]; w[j][7] = wb[3]; }
        float val[8][8];
#pragma unroll
        for (int i = 0; i < 8; ++i)
#pragma unroll
            for (int c = 0; c < 8; ++c) val[i][c] = 0.f;
#pragma unroll
        for (int rr = 0; rr < 12; ++rr) { const v4u xv = *(const LAS v4u*)(RAW + (8 * pg + rr) * 384 + cr);
            const float x[8] = {bf_lo(xv.x), bf_hi(xv.x), bf_lo(xv.y), bf_hi(xv.y), bf_lo(xv.z), bf_hi(xv.z), bf_lo(xv.w), bf_hi(xv.w)};
#pragma unroll
            for (int j = 0; j < 5; ++j) { const int i = rr - j; if (i >= 0 && i < 8) {
#pragma unroll
                for (int c = 0; c < 8; ++c) val[i][c] += x[c] * w[j][c]; } } }
        unsigned pk[8][4];
#pragma unroll
        for (int i = 0; i < 8; ++i) { float ss = 0.f;
#pragma unroll
            for (int c = 0; c < 8; ++c) { val[i][c] = val[i][c] * sigmoid_f(val[i][c]); ss += val[i][c] * val[i][c]; }
            ss = row_sum16(ss);
            const float rn = (p == 2) ? 1.0f : rsqrtf(ss + EPS) * ((p == 0) ? 0.08838834764831845f : 1.0f);
#pragma unroll
            for (int c2 = 0; c2 < 4; ++c2) pk[i][c2] = cvt_pk_bf16(val[i][2 * c2] * rn, val[i][2 * c2 + 1] * rn);
            if (p < 2) *(LAS v4u*)(((p == 0) ? Qs : Ks) + (8 * pg + i) * 136 + c0) = (v4u){pk[i][0], pk[i][1], pk[i][2], pk[i][3]}; }
        if (p >= 1) { LAS bf16* TT = (p == 1) ? KT : VT;
#pragma unroll
            for (int c2 = 0; c2 < 4; ++c2) { v4u lo_, hi_;
                lo_.x = (pk[0][c2] & 0xffffu) | (pk[1][c2] << 16); lo_.y = (pk[2][c2] & 0xffffu) | (pk[3][c2] << 16); lo_.z = (pk[4][c2] & 0xffffu) | (pk[5][c2] << 16); lo_.w = (pk[6][c2] & 0xffffu) | (pk[7][c2] << 16);
                hi_.x = (pk[0][c2] >> 16) | (pk[1][c2] & 0xffff0000u); hi_.y = (pk[2][c2] >> 16) | (pk[3][c2] & 0xffff0000u); hi_.z = (pk[4][c2] >> 16) | (pk[5][c2] & 0xffff0000u); hi_.w = (pk[6][c2] >> 16) | (pk[7][c2] & 0xffff0000u);
                *(LAS v4u*)(TT + (c0 + 2 * c2) * 72 + 8 * pg) = lo_; *(LAS v4u*)(TT + (c0 + 2 * c2 + 1) * 72 + 8 * pg) = hi_; } } }
    __syncthreads();
    for (int r33_ = 0; r33_ < PROBE_REPS(33); ++r33_)
    { const int which = wv >> 2, it = wv & 3; const LAS bf16* Bsrc = which ? Qs : Ks;
      f32x4 gt4[4];
#pragma unroll
      for (int jt = 0; jt < 4; ++jt) { f32x4 acc = (f32x4){0.f, 0.f, 0.f, 0.f};
#pragma unroll
          for (int ks = 0; ks < 4; ++ks) acc = __builtin_amdgcn_mfma_f32_16x16x32_bf16(*(const LAS bf16x8*)(Ks + (16 * jt + fr) * 136 + 32 * ks + 8 * fq), *(const LAS bf16x8*)(Bsrc + (16 * it + fr) * 136 + 32 * ks + 8 * fq), acc, 0, 0, 0);
          gt4[jt] = acc; }
      const int i = 16 * it + fr;
#pragma unroll
      for (int d = 0; d < 2; ++d) { const float gi = gc[d * 64 + i], bi = be[d * 64 + i];
          if (which == 0) {
#pragma unroll
              for (int jt = 0; jt < 4; ++jt) { const int j0 = 16 * jt + 4 * fq; const f32x4 gj = *(const LAS f32x4*)(gc + d * 64 + j0); f32x4 lv;
#pragma unroll
                  for (int jj = 0; jj < 4; ++jj) { const int j = j0 + jj; const bool keep = d ? (i < j) : (i > j); lv[jj] = keep ? bi * gt4[jt][jj] * fexp(gi - gj[jj]) : 0.f; }
                  if (d == 0) { *(LAS f32x4*)(Lm + i * 64 + j0) = lv; v2u b; b.x = cvt_pk_bf16(lv[0], lv[1]); b.y = cvt_pk_bf16(lv[2], lv[3]); *(LAS v2u*)(Lb + i * 72 + j0) = b; }
                  else { *(LAS f32x4*)(Lm + 4096 + (63 - i) * 64 + (60 - j0)) = (f32x4){lv[3], lv[2], lv[1], lv[0]}; v2u b; b.x = cvt_pk_bf16(lv[3], lv[2]); b.y = cvt_pk_bf16(lv[1], lv[0]); *(LAS v2u*)(Lb + 4608 + (63 - i) * 72 + (60 - j0)) = b; } } }
          else { unsigned char* DF = d ? DF1 : DF0;
#pragma unroll
              for (int ks = 0; ks < 2; ++ks) { float f[8];
#pragma unroll
                  for (int t2 = 0; t2 < 2; ++t2) { const int jt = 2 * ks + t2, j0 = 16 * jt + 4 * fq; const f32x4 gj = *(const LAS f32x4*)(gc + d * 64 + j0);
#pragma unroll
                      for (int jj = 0; jj < 4; ++jj) { const int j = j0 + jj; const bool keep = d ? (i <= j) : (i >= j); f[4 * t2 + jj] = keep ? gt4[jt][jj] * fexp(gi - gj[jj]) : 0.f; } }
                  v4u w; w.x = cvt_pk_bf16(f[0], f[1]); w.y = cvt_pk_bf16(f[2], f[3]); w.z = cvt_pk_bf16(f[4], f[5]); w.w = cvt_pk_bf16(f[6], f[7]);
                  *(v4u*)(DF + DF_QK + (size_t)((it * 2 + ks) * 64 + lane) * 16) = w; } } }
      { const int mt = wv & 3, pos = 16 * mt + fr;
#pragma unroll
        for (int kk = 0; kk < 2; ++kk) { const int ks = (wv >> 2) * 2 + kk; const v2u qa = *(const LAS v2u*)(Qs + pos * 136 + 32 * ks + 4 * fq), qb = *(const LAS v2u*)(Qs + pos * 136 + 32 * ks + 16 + 4 * fq);
#pragma unroll
            for (int d = 0; d < 2; ++d) { const float e = fexp(gc[d * 64 + pos]); v4u w; w.x = cvt_pk_bf16(bf_lo(qa.x) * e, bf_hi(qa.x) * e); w.y = cvt_pk_bf16(bf_lo(qa.y) * e, bf_hi(qa.y) * e); w.z = cvt_pk_bf16(bf_lo(qb.x) * e, bf_hi(qb.x) * e); w.w = cvt_pk_bf16(bf_lo(qb.y) * e, bf_hi(qb.y) * e);
                *(v4u*)((d ? DF1 : DF0) + DF_QD + (size_t)((mt * 4 + ks) * 64 + lane) * 16) = w; } } }
      { const int d = wv >> 2; const float ge = gc[d * 64 + (d ? 0 : 63)];
#pragma unroll
        for (int q2 = 0; q2 < 2; ++q2) { const int dt = 2 * (wv & 3) + q2, dk = 16 * dt + fr;
#pragma unroll
            for (int ks = 0; ks < 2; ++ks) { const int p0 = 32 * ks + 4 * fq; const v2u ka = *(const LAS v2u*)(KT + dk * 72 + p0), kb = *(const LAS v2u*)(KT + dk * 72 + p0 + 16);
                const f32x4 ga = *(const LAS f32x4*)(gc + d * 64 + p0), gb = *(const LAS f32x4*)(gc + d * 64 + p0 + 16);
                v4u w; w.x = cvt_pk_bf16(bf_lo(ka.x) * fexp(ge - ga[0]), bf_hi(ka.x) * fexp(ge - ga[1])); w.y = cvt_pk_bf16(bf_lo(ka.y) * fexp(ge - ga[2]), bf_hi(ka.y) * fexp(ge - ga[3]));
                w.z = cvt_pk_bf16(bf_lo(kb.x) * fexp(ge - gb[0]), bf_hi(kb.x) * fexp(ge - gb[1])); w.w = cvt_pk_bf16(bf_lo(kb.y) * fexp(ge - gb[2]), bf_hi(kb.y) * fexp(ge - gb[3]));
                *(v4u*)((d ? DF1 : DF0) + DF_KDT + (size_t)((dt * 2 + ks) * 64 + lane) * 16) = w; } } }
      if (tid < 2) ((float*)(F.ws + WS_DGT))[(size_t)(tid * 4 + h) * 260 + n] = fexp(gc[tid * 64 + (tid ? 0 : 63)]);
    }
    __syncthreads();
    if (wv < 2) { const int d = wv; const int j = d ? 63 - lane : lane; const float bj = be[d * 64 + j], ej = bj * fexp(gc[d * 64 + j]);
        LAS bf16* TP = TPb + (2 * d) * 4096; LAS bf16* TPP = TP + 4096;
        LAS bf16* TT = (LAS bf16*)(F.lds + MISC_OFF + 2560) + d * 4096; LAS float* Yb = (LAS float*)(F.lds + MISC_OFF + 2560 + 16384) + d * 1024;
        tri_solve_blocked(Lm + d * 4096, Lb + d * 4608, TT, Yb, lane, [&](int r, float x) { const int i = d ? 63 - r : r; const unsigned w = cvt_pk_bf16(x * ej, x * bj); TP[i * 64 + j] = (bf16)(w & 0xffffu); TPP[i * 64 + j] = (bf16)(w >> 16); }); }
    __syncthreads();
    for (int r34_ = 0; r34_ < PROBE_REPS(34); ++r34_)
    { const int d = wv >> 2, w4 = wv & 3; const LAS bf16* TP = TPb + (2 * d) * 4096; const LAS bf16* TPP = TP + 4096; unsigned char* DF = d ? DF1 : DF0; bf16* DU = d ? DU1 : DU0;
#pragma unroll
      for (int it = 0; it < 4; ++it) { f32x4 acc[2];
#pragma unroll
          for (int q2 = 0; q2 < 2; ++q2) { acc[q2] = (f32x4){0.f, 0.f, 0.f, 0.f};
#pragma unroll
              for (int ks = 0; ks < 2; ++ks) acc[q2] = __builtin_amdgcn_mfma_f32_16x16x32_bf16(*(const LAS bf16x8*)(KT + (16 * (2 * w4 + q2) + fr) * 72 + 32 * ks + 8 * fq), *(const LAS bf16x8*)(TP + (16 * it + fr) * 64 + 32 * ks + 8 * fq), acc[q2], 0, 0, 0); }
          v4u w; w.x = cvt_pk_bf16(-acc[0][0], -acc[0][1]); w.y = cvt_pk_bf16(-acc[0][2], -acc[0][3]); w.z = cvt_pk_bf16(-acc[1][0], -acc[1][1]); w.w = cvt_pk_bf16(-acc[1][2], -acc[1][3]);
          *(v4u*)(DF + DF_NW + (size_t)((it * 4 + w4) * 64 + lane) * 16) = w; }
#pragma unroll
      for (int q2 = 0; q2 < 2; ++q2) { const int dvt = 2 * w4 + q2;
#pragma unroll
          for (int it = 0; it < 4; ++it) { f32x4 acc = (f32x4){0.f, 0.f, 0.f, 0.f};
#pragma unroll
              for (int ks = 0; ks < 2; ++ks) acc = __builtin_amdgcn_mfma_f32_16x16x32_bf16(*(const LAS bf16x8*)(TPP + (16 * it + fr) * 64 + 32 * ks + 8 * fq), *(const LAS bf16x8*)(VT + (16 * dvt + fr) * 72 + 32 * ks + 8 * fq), acc, 0, 0, 0);
              { v2u w; w.x = cvt_pk_bf16(acc[0], acc[1]); w.y = cvt_pk_bf16(acc[2], acc[3]); *(v2u*)(DU + (size_t)((dvt * 4 + it) * 64 + lane) * 4) = w; } } } }
}
__device__ __forceinline__ void dn_scan_item(Frame& F, int item) {
    int tid_ = F.tid; asm volatile("" : "+v"(tid_));
    const int dh = item >> 3, d = dh >> 2, tid = tid_, lane = tid & 63, wv = __builtin_amdgcn_readfirstlane(tid >> 6);
    const unsigned char* DF = F.ws + WS_DF; const unsigned char* DU = F.ws + WS_DU; unsigned char* SN = F.ws + WS_DSN;
    LAS float* gts = (LAS float*)(F.lds + MISC_OFF + 1024);
    LAS unsigned char* uring = F.lds + MISC_OFF + 2560;
    const int dvl = 0, dvt = item & 7;
    const bool comp = wv < 1, stg = wv >= 4;
    f32x4 S[8]; bf16x8 Sb[4]; bf16x8 fw[4][4];
#pragma unroll
    for (int i = 0; i < 8; ++i) S[i] = (f32x4){0.f, 0.f, 0.f, 0.f};
#pragma unroll
    for (int i = 0; i < 4; ++i) Sb[i] = (bf16x8){0, 0, 0, 0, 0, 0, 0, 0};
    auto issue_nk = [&](int s) { const int sc = s < 260 ? s : 259; const unsigned char* src = DF + (size_t)(dh * 260 + scan_chunk(d, sc)) * DF_BYTES; const int slot = s & 3;
#pragma unroll
        for (int k = 0; k < 8; ++k) { const int p = (wv - 4) + 4 * k; const int off = (p < 16) ? DF_NW + p * 1024 : DF_KDT + (p - 16) * 1024;
            __builtin_amdgcn_global_load_lds((const unsigned*)(src + off + lane * 16), (LAS unsigned*)(F.lds + slot * 32768 + p * 1024), 16, 0, 0); } };
    auto issue_u = [&](int s, int uslot) { const int sc = s < 260 ? s : 259; const unsigned char* src = DU + (size_t)(dh * 260 + scan_chunk(d, sc)) * 16384 + dvt * 2048;
        if (wv < 6) { const int p = wv - 4; __builtin_amdgcn_global_load_lds((const unsigned*)(src + p * 1024 + lane * 16), (LAS unsigned*)(uring + uslot * 4096 + p * 1024), 16, 0, 0); } };
    __syncthreads();
    if (tid < 260) gts[tid] = ((const float*)(F.ws + WS_DGT))[dh * 260 + tid];
    if (stg) { issue_nk(0); issue_nk(1); issue_u(0, 0); issue_nk(2); issue_u(1, 1); }
    auto step = [&](int s, int uslot, int uslot2) {
        if (stg) { if (wv < 6) asm volatile("s_waitcnt vmcnt(9)" ::: "memory"); else asm volatile("s_waitcnt vmcnt(8)" ::: "memory"); }
        asm volatile("s_waitcnt lgkmcnt(0)" ::: "memory"); __builtin_amdgcn_s_barrier(); asm volatile("" ::: "memory");
        if (stg) { issue_nk(s + 3); issue_u(s + 2, uslot2); }
        if (comp) {
            const int n = scan_chunk(d, s);
            const LAS unsigned char* buf = F.lds + (s & 3) * 32768;
            const float gt = gts[n];
            unsigned char* sn = SN + (size_t)(dh * 260 + n) * DSN_BYTES;
            v2u uw[4];
#pragma unroll
            for (int mt = 0; mt < 4; ++mt) uw[mt] = *(const LAS v2u*)(uring + uslot * 4096 + ((dvl * 4 + mt) * 64 + lane) * 8);
            bf16x8 fk[2][8];
            if (s == 0) {
#pragma unroll
                for (int ks = 0; ks < 4; ++ks)
#pragma unroll
                    for (int mt = 0; mt < 4; ++mt) fw[ks][mt] = *(const LAS bf16x8*)(buf + ((mt * 4 + ks) * 64 + lane) * 16); }
            __builtin_amdgcn_sched_barrier(0);
#pragma unroll
            for (int ks = 0; ks < 4; ++ks) *(bf16x8*)(sn + (size_t)((dvt * 4 + ks) * 64 + lane) * 16) = Sb[ks];
            f32x4 vn[4];
#pragma unroll
            for (int mt = 0; mt < 4; ++mt) vn[mt] = (f32x4){bf_lo(uw[mt].x), bf_hi(uw[mt].x), bf_lo(uw[mt].y), bf_hi(uw[mt].y)};
#pragma unroll
            for (int mt = 0; mt < 4; ++mt) vn[mt] = __builtin_amdgcn_mfma_f32_16x16x32_bf16(fw[0][mt], Sb[0], vn[mt], 0, 0, 0);
            __builtin_amdgcn_sched_barrier(0);
#pragma unroll
            for (int dt = 0; dt < 8; ++dt) fk[0][dt] = *(const LAS bf16x8*)(buf + 16384 + ((dt * 2 + 0) * 64 + lane) * 16);
            __builtin_amdgcn_sched_barrier(0);
#pragma unroll
            for (int mt = 0; mt < 4; ++mt) vn[mt] = __builtin_amdgcn_mfma_f32_16x16x32_bf16(fw[1][mt], Sb[1], vn[mt], 0, 0, 0);
            __builtin_amdgcn_sched_barrier(0);
#pragma unroll
            for (int dt = 0; dt < 8; ++dt) fk[1][dt] = *(const LAS bf16x8*)(buf + 16384 + ((dt * 2 + 1) * 64 + lane) * 16);
            __builtin_amdgcn_sched_barrier(0);
#pragma unroll
            for (int ks = 2; ks < 4; ++ks)
#pragma unroll
                for (int mt = 0; mt < 4; ++mt) vn[mt] = __builtin_amdgcn_mfma_f32_16x16x32_bf16(fw[ks][mt], Sb[ks], vn[mt], 0, 0, 0);
            bf16x8 vb[2];
#pragma unroll
            for (int ks = 0; ks < 2; ++ks) { v4u w; w.x = cvt_pk_bf16(vn[2 * ks][0], vn[2 * ks][1]); w.y = cvt_pk_bf16(vn[2 * ks][2], vn[2 * ks][3]); w.z = cvt_pk_bf16(vn[2 * ks + 1][0], vn[2 * ks + 1][1]); w.w = cvt_pk_bf16(vn[2 * ks + 1][2], vn[2 * ks + 1][3]); vb[ks] = __builtin_bit_cast(bf16x8, w);
                *(bf16x8*)(sn + DSN_V + (size_t)((dvt * 2 + ks) * 64 + lane) * 16) = vb[ks]; }
#pragma unroll
            for (int dt = 0; dt < 8; ++dt) S[dt] = S[dt] * gt;
#pragma unroll
            for (int ks = 0; ks < 2; ++ks)
#pragma unroll
                for (int dt = 0; dt < 8; ++dt) S[dt] = __builtin_amdgcn_mfma_f32_16x16x32_bf16(fk[ks][dt], vb[ks], S[dt], 0, 0, 0);
            __builtin_amdgcn_sched_barrier(0);
            { const LAS unsigned char* nb = F.lds + ((s + 1) & 3) * 32768;
#pragma unroll
              for (int ks = 0; ks < 4; ++ks)
#pragma unroll
                  for (int mt = 0; mt < 4; ++mt) fw[ks][mt] = *(const LAS bf16x8*)(nb + ((mt * 4 + ks) * 64 + lane) * 16); }
            __builtin_amdgcn_sched_barrier(0);
#pragma unroll
            for (int ks = 0; ks < 4; ++ks) { v4u w; w.x = cvt_pk_bf16(S[2 * ks][0], S[2 * ks][1]); w.y = cvt_pk_bf16(S[2 * ks][2], S[2 * ks][3]); w.z = cvt_pk_bf16(S[2 * ks + 1][0], S[2 * ks + 1][1]); w.w = cvt_pk_bf16(S[2 * ks + 1][2], S[2 * ks + 1][3]); Sb[ks] = __builtin_bit_cast(bf16x8, w); }
        }
    };
    asm volatile("s_waitcnt lgkmcnt(0)" ::: "memory");
    for (int s = 0; s < 258; s += 3) { step(s, 0, 2); step(s + 1, 1, 0); step(s + 2, 2, 1); }
    step(258, 0, 2); step(259, 1, 0);
    asm volatile("s_waitcnt vmcnt(0)" ::: "memory");
    __syncthreads();
}
__device__ __forceinline__ void dn_post_witem(Frame& F, ArgsP a, int l, int wi) {
    const int item = wi >> 2, mt = wi & 3, n = item % 260, h = item / 260, t0 = chunk_tok0(n), lane = F.lane, fr = lane & 15, fq = lane >> 4;
    const bf16* P = (const bf16*)(F.ws + WS_P); bf16* YA = (bf16*)(F.ws + WS_YABC);
    f32x4 o[8];
#pragma unroll
    for (int dvt = 0; dvt < 8; ++dvt) o[dvt] = (f32x4){0.f, 0.f, 0.f, 0.f};
#pragma unroll
    for (int d = 0; d < 2; ++d) { const size_t it = (size_t)(d * 4 + h) * 260 + n; const unsigned char* df = F.ws + WS_DF + it * DF_BYTES; const unsigned char* sn = F.ws + WS_DSN + it * DSN_BYTES;
        bf16x8 qd[4], qk[2];
#pragma unroll
        for (int ks = 0; ks < 4; ++ks) qd[ks] = *(const bf16x8*)(df + DF_QD + (unsigned)(((mt * 4 + ks) * 64 + lane) * 16));
#pragma unroll
        for (int ks = 0; ks < 2; ++ks) qk[ks] = *(const bf16x8*)(df + DF_QK + (unsigned)(((mt * 2 + ks) * 64 + lane) * 16));
#pragma unroll
        for (int g4 = 0; g4 < 2; ++g4) { bf16x8 sf[4][4], vf[4][2];
#pragma unroll
            for (int q = 0; q < 4; ++q) { const int dvt = 4 * g4 + q;
#pragma unroll
                for (int ks = 0; ks < 4; ++ks) sf[q][ks] = *(const bf16x8*)(sn + (unsigned)(((dvt * 4 + ks) * 64 + lane) * 16));
#pragma unroll
                for (int ks = 0; ks < 2; ++ks) vf[q][ks] = *(const bf16x8*)(sn + DSN_V + (unsigned)(((dvt * 2 + ks) * 64 + lane) * 16)); }
            __builtin_amdgcn_sched_barrier(0);
#pragma unroll
            for (int q = 0; q < 4; ++q) { const int dvt = 4 * g4 + q;
#pragma unroll
                for (int ks = 0; ks < 4; ++ks) o[dvt] = __builtin_amdgcn_mfma_f32_16x16x32_bf16(sf[q][ks], qd[ks], o[dvt], 0, 0, 0);
#pragma unroll
                for (int ks = 0; ks < 2; ++ks) o[dvt] = __builtin_amdgcn_mfma_f32_16x16x32_bf16(vf[q][ks], qk[ks], o[dvt], 0, 0, 0); }
            __builtin_amdgcn_sched_barrier(0); } }
    float ss = 0.f;
#pragma unroll
    for (int dvt = 0; dvt < 8; ++dvt) ss += (o[dvt][0] * o[dvt][0] + o[dvt][1] * o[dvt][1]) + (o[dvt][2] * o[dvt][2] + o[dvt][3] * o[dvt][3]);
    ss += __shfl_xor(ss, 16); ss += __shfl_xor(ss, 32);
    const float r = rsqrtf(ss * (1.0f / 128.0f) + EPS); const unsigned tok = (unsigned)(t0 + 16 * mt + fr);
#pragma unroll
    for (int dvt = 0; dvt < 8; ++dvt) { const f32x4 gv = *(const f32x4*)(inp(a, 12) + l * 128 + 16 * dvt + 4 * fq); const v2u zv = *(const v2u*)(P + (tok * (unsigned)NIN + PC_AZ + h * 128 + 16 * dvt + 4 * fq));
        v2u w; w.x = cvt_pk_bf16(o[dvt][0] * r * gv[0] * bf_lo(zv.x), o[dvt][1] * r * gv[1] * bf_hi(zv.x)); w.y = cvt_pk_bf16(o[dvt][2] * r * gv[2] * bf_lo(zv.y), o[dvt][3] * r * gv[3] * bf_hi(zv.y));
        *(v2u*)(YA + (tok * 512u + h * 128 + 16 * dvt + 4 * fq)) = w; }
}
__device__ __forceinline__ void gla_prep_item(Frame& F, ArgsP a, int l, int item) {
    int tid_ = F.tid; asm volatile("" : "+v"(tid_));
    const int n = item % 260, dh = item / 260, d = dh >> 2, h = dh & 3, t0 = chunk_tok0(n), tid = tid_, lane = tid & 63, wv = __builtin_amdgcn_readfirstlane(tid >> 6), fr = lane & 15, fq = lane >> 4;
    LAS float* Bc = (LAS float*)F.lds;
    LAS bf16* Qt = (LAS bf16*)(F.lds + 16640); LAS bf16* Kt = Qt + 64 * 72; LAS bf16* KHT = Kt + 64 * 72; LAS bf16* VT = KHT + 64 * 72;
    LAS float* W2s = (LAS float*)(F.lds + 62720); LAS float* bgs = W2s + 1024;
    const bf16* P = (const bf16*)(F.ws + WS_P); const float* SM = (const float*)(F.ws + WS_SM);
    bf16* QH = (bf16*)(F.ws + WS_QH) + (size_t)item * 4096; bf16* GG = (bf16*)(F.ws + WS_GG) + (size_t)item * 8192; float* GD = (float*)(F.ws + WS_GD) + (size_t)item * 64; bf16* GO = (bf16*)(F.ws + WS_GO);
    __syncthreads();
    for (int i = tid; i < 1024; i += 512) { W2s[i] = inp(a, 13)[(size_t)((l * 2 + d) * 16 + (i >> 6)) * 256 + h * 64 + (i & 63)]; bgs[i] = SM[(size_t)(t0 + (i >> 4)) * 64 + 16 + d * 16 + (i & 15)]; }
    __syncthreads();
    const int pos = tid >> 3, c8 = (tid & 7) * 8;
    { float x[8];
#pragma unroll
      for (int i = 0; i < 8; ++i) x[i] = inp(a, 14)[(l * 2 + d) * 256 + h * 64 + c8 + i];
#pragma unroll
      for (int r = 0; r < 16; ++r) { const float bg = bgs[pos * 16 + r];
#pragma unroll
          for (int i = 0; i < 8; ++i) x[i] += bg * W2s[r * 64 + c8 + i]; }
#pragma unroll
      for (int i = 0; i < 8; ++i) Bc[pos * 65 + c8 + i] = -softplus_f(-x[i]) * (1.0f / 16.0f); }
    __syncthreads();
    if (tid < 64) { float cv[64];
#pragma unroll
        for (int i = 0; i < 64; ++i) cv[i] = Bc[i * 65 + tid];
        if (d) {
#pragma unroll
            for (int i = 62; i >= 0; --i) cv[i] += cv[i + 1]; }
        else {
#pragma unroll
            for (int i = 1; i < 64; ++i) cv[i] += cv[i - 1]; }
#pragma unroll
        for (int i = 0; i < 64; ++i) Bc[i * 65 + tid] = cv[i]; }
    __syncthreads();
    { const bf16* pr = P + (size_t)(t0 + pos) * NIN; const v4u qx = *(const v4u*)(pr + PC_BQ + h * 64 + c8), kx = *(const v4u*)(pr + PC_BK + h * 64 + c8);
      const float qv[8] = {bf_lo(qx.x), bf_hi(qx.x), bf_lo(qx.y), bf_hi(qx.y), bf_lo(qx.z), bf_hi(qx.z), bf_lo(qx.w), bf_hi(qx.w)}, kv[8] = {bf_lo(kx.x), bf_hi(kx.x), bf_lo(kx.y), bf_hi(kx.y), bf_lo(kx.z), bf_hi(kx.z), bf_lo(kx.w), bf_hi(kx.w)};
      float qt[8], kt[8], qh[8];
#pragma unroll
      for (int i = 0; i < 8; ++i) { const float b = Bc[pos * 65 + c8 + i], br = Bc[32 * 65 + c8 + i], be = Bc[(d ? 0 : 63) * 65 + c8 + i];
          qt[i] = qv[i] * fexp(fminf(b - br, 60.f)); kt[i] = kv[i] * fexp(fminf(br - b, 60.f)); qh[i] = qv[i] * fexp(b);
          KHT[(c8 + i) * 72 + pos] = (bf16)(cvt_pk_bf16(kv[i] * fexp(be - b), 0.f) & 0xffffu); }
      v4u w; w.x = cvt_pk_bf16(qt[0], qt[1]); w.y = cvt_pk_bf16(qt[2], qt[3]); w.z = cvt_pk_bf16(qt[4], qt[5]); w.w = cvt_pk_bf16(qt[6], qt[7]); *(LAS v4u*)(Qt + pos * 72 + c8) = w;
      w.x = cvt_pk_bf16(kt[0], kt[1]); w.y = cvt_pk_bf16(kt[2], kt[3]); w.z = cvt_pk_bf16(kt[4], kt[5]); w.w = cvt_pk_bf16(kt[6], kt[7]); *(LAS v4u*)(Kt + pos * 72 + c8) = w;
      w.x = cvt_pk_bf16(qh[0], qh[1]); w.y = cvt_pk_bf16(qh[2], qh[3]); w.z = cvt_pk_bf16(qh[4], qh[5]); w.w = cvt_pk_bf16(qh[6], qh[7]); *(v4u*)(QH + pos * 64 + c8) = w;
#pragma unroll
      for (int hv = 0; hv < 2; ++hv) { const v4u vx = *(const v4u*)(pr + PC_BV + h * 128 + 16 * (tid & 7) + 8 * hv); const unsigned vw[4] = {vx.x, vx.y, vx.z, vx.w};
#pragma unroll
          for (int j = 0; j < 4; ++j) { VT[(16 * (tid & 7) + 8 * hv + 2 * j) * 72 + pos] = (bf16)(vw[j] & 0xffffu); VT[(16 * (tid & 7) + 8 * hv + 2 * j + 1) * 72 + pos] = (bf16)(vw[j] >> 16); } }
      if (tid < 64) GD[tid] = fexp(Bc[(d ? 0 : 63) * 65 + tid]); }
    __syncthreads();
    const int it = wv & 3, hf = wv >> 2;
    f32x4 at[4];
#pragma unroll
    for (int jt = 0; jt < 4; ++jt) { f32x4 acc = (f32x4){0.f, 0.f, 0.f, 0.f};
#pragma unroll
        for (int ks = 0; ks < 2; ++ks) acc = __builtin_amdgcn_mfma_f32_16x16x32_bf16(*(const LAS bf16x8*)(Kt + (16 * jt + fr) * 72 + 32 * ks + 8 * fq), *(const LAS bf16x8*)(Qt + (16 * it + fr) * 72 + 32 * ks + 8 * fq), acc, 0, 0, 0);
#pragma unroll
        for (int jj = 0; jj < 4; ++jj) { const int i = 16 * it + fr, j = 16 * jt + 4 * fq + jj; if (d ? (i > j) : (i < j)) acc[jj] = 0.f; }
        at[jt] = acc; }
    bf16x8 pb[2];
#pragma unroll
    for (int ks2 = 0; ks2 < 2; ++ks2) { v4u w; w.x = cvt_pk_bf16(at[2 * ks2][0], at[2 * ks2][1]); w.y = cvt_pk_bf16(at[2 * ks2][2], at[2 * ks2][3]); w.z = cvt_pk_bf16(at[2 * ks2 + 1][0], at[2 * ks2 + 1][1]); w.w = cvt_pk_bf16(at[2 * ks2 + 1][2], at[2 * ks2 + 1][3]); pb[ks2] = __builtin_bit_cast(bf16x8, w); }
#pragma unroll
    for (int dq = 0; dq < 4; ++dq) { const int dvt = 4 * hf + dq; f32x4 acc = (f32x4){0.f, 0.f, 0.f, 0.f};
#pragma unroll
        for (int ks2 = 0; ks2 < 2; ++ks2) { const LAS bf16* vp = VT + (16 * dvt + fr) * 72 + 32 * ks2 + 4 * fq; const v2u va = *(const LAS v2u*)vp, vb = *(const LAS v2u*)(vp + 16);
            acc = __builtin_amdgcn_mfma_f32_16x16x32_bf16(__builtin_bit_cast(bf16x8, ((v4u){va.x, va.y, vb.x, vb.y})), pb[ks2], acc, 0, 0, 0); }
        { v2u w; w.x = cvt_pk_bf16(acc[0], acc[1]); w.y = cvt_pk_bf16(acc[2], acc[3]); *(v2u*)(GO + ((size_t)d * T + t0 + 16 * it + fr) * 512 + h * 128 + 16 * dvt + 4 * fq) = w; } }
    const int dkt = wv & 3;
#pragma unroll
    for (int dq = 0; dq < 4; ++dq) { const int dvt = 4 * hf + dq; f32x4 acc = (f32x4){0.f, 0.f, 0.f, 0.f};
#pragma unroll
        for (int ks = 0; ks < 2; ++ks) acc = __builtin_amdgcn_mfma_f32_16x16x32_bf16(*(const LAS bf16x8*)(KHT + (16 * dkt + fr) * 72 + 32 * ks + 8 * fq), *(const LAS bf16x8*)(VT + (16 * dvt + fr) * 72 + 32 * ks + 8 * fq), acc, 0, 0, 0);
#pragma unroll
        for (int jj = 0; jj < 4; ++jj) GG[(16 * dkt + 4 * fq + jj) * 128 + 16 * dvt + fr] = (bf16)(cvt_pk_bf16(acc[jj], 0.f) & 0xffffu); }
}
__device__ __forceinline__ void gla_scan_item(Frame& F, int item) {
    const int dh = item >> 3, d = dh >> 2, dv = F.tid & 127, dk0 = 8 * (item & 7) + 2 * (F.tid >> 7);
    const bf16* GG = (const bf16*)(F.ws + WS_GG); const float* GD = (const float*)(F.ws + WS_GD); bf16* ST = (bf16*)(F.ws + WS_ST);
    float S0 = 0.f, S1 = 0.f;
    for (int s4 = 0; s4 < 260; s4 += 4) {
        float g0[4], g1[4], c0[4], c1[4]; size_t it[4];
#pragma unroll
        for (int u = 0; u < 4; ++u) { it[u] = (size_t)dh * 260 + scan_chunk(d, s4 + u); g0[u] = bf2f(GG[it[u] * 8192 + dk0 * 128 + dv]); g1[u] = bf2f(GG[it[u] * 8192 + (dk0 + 1) * 128 + dv]); c0[u] = GD[it[u] * 64 + dk0]; c1[u] = GD[it[u] * 64 + dk0 + 1]; }
#pragma unroll
        for (int u = 0; u < 4; ++u) { const unsigned w = cvt_pk_bf16(S0, S1); *(unsigned*)(ST + it[u] * 8192 + (size_t)((((dv >> 4) * 2 + (dk0 >> 5)) * 64 + (dv & 15) + 16 * ((dk0 & 31) >> 3)) * 8 + (dk0 & 7))) = w;
            S0 = c0[u] * S0 + g0[u]; S1 = c1[u] * S1 + g1[u]; }
    }
}
__device__ __forceinline__ void gla_post_witem(Frame& F, ArgsP a, int l, int wi) {
    const int item = wi >> 2, pt = wi & 3, n = item % 260, h = item / 260, t0 = chunk_tok0(n), lane = F.lane, fr = lane & 15, fq = lane >> 4;
    const bf16* P = (const bf16*)(F.ws + WS_P); const bf16* GO = (const bf16*)(F.ws + WS_GO); bf16* YB = (bf16*)(F.ws + WS_YABC + YSTRIDE);
    const unsigned tok = (unsigned)(t0 + 16 * pt + fr);
    f32x4 os[8];
#pragma unroll
    for (int dvt = 0; dvt < 8; ++dvt) os[dvt] = (f32x4){0.f, 0.f, 0.f, 0.f};
#pragma unroll
    for (int d = 0; d < 2; ++d) { const size_t it = (size_t)(d * 4 + h) * 260 + n; const bf16* ST = (const bf16*)(F.ws + WS_ST) + it * 8192; const bf16* QH = (const bf16*)(F.ws + WS_QH) + it * 4096;
        const bf16x8 q0 = *(const bf16x8*)(QH + (unsigned)((16 * pt + fr) * 64 + 8 * fq)), q1 = *(const bf16x8*)(QH + (unsigned)((16 * pt + fr) * 64 + 32 + 8 * fq));
        bf16x8 s0[8], s1[8]; f32x4 gi[8];
#pragma unroll
        for (int dvt = 0; dvt < 8; ++dvt) { { const v2u gw = *(const v2u*)(GO + ((size_t)d * T + tok) * 512 + h * 128 + 16 * dvt + 4 * fq); gi[dvt] = (f32x4){bf_lo(gw.x), bf_hi(gw.x), bf_lo(gw.y), bf_hi(gw.y)}; }
            s0[dvt] = *(const bf16x8*)(ST + (unsigned)(((dvt * 2 + 0) * 64 + lane) * 8)); s1[dvt] = *(const bf16x8*)(ST + (unsigned)(((dvt * 2 + 1) * 64 + lane) * 8)); }
        __builtin_amdgcn_sched_barrier(0);
#pragma unroll
        for (int dvt = 0; dvt < 8; ++dvt) { f32x4 acc = __builtin_amdgcn_mfma_f32_16x16x32_bf16(s0[dvt], q0, gi[dvt], 0, 0, 0); acc = __builtin_amdgcn_mfma_f32_16x16x32_bf16(s1[dvt], q1, acc, 0, 0, 0); os[dvt] += acc; }
        __builtin_amdgcn_sched_barrier(0); }
    float ss = 0.f;
#pragma unroll
    for (int dvt = 0; dvt < 8; ++dvt) ss += (os[dvt][0] * os[dvt][0] + os[dvt][1] * os[dvt][1]) + (os[dvt][2] * os[dvt][2] + os[dvt][3] * os[dvt][3]);
    ss += __shfl_xor(ss, 16); ss += __shfl_xor(ss, 32);
    const float r = rsqrtf(ss * (1.0f / 128.0f) + EPS);
#pragma unroll
    for (int dvt = 0; dvt < 8; ++dvt) { const f32x4 gv = *(const f32x4*)(inp(a, 15) + l * 128 + 16 * dvt + 4 * fq); const v2u zv = *(const v2u*)(P + (tok * (unsigned)NIN + PC_BZ + h * 128 + 16 * dvt + 4 * fq));
        v2u w; w.x = cvt_pk_bf16(os[dvt][0] * r * gv[0] * bf_lo(zv.x), os[dvt][1] * r * gv[1] * bf_hi(zv.x)); w.y = cvt_pk_bf16(os[dvt][2] * r * gv[2] * bf_lo(zv.y), os[dvt][3] * r * gv[3] * bf_hi(zv.y));
        *(v2u*)(YB + (tok * 512u + h * 128 + 16 * dvt + 4 * fq)) = w; }
}
constexpr int AT_KSTR = 72, AT_BUF = 2 * 64 * AT_KSTR * 2;
__device__ __forceinline__ void attn_unit(Frame& F, ArgsP a, int l, int unit) {
    int tid_ = F.tid; asm volatile("" : "+v"(tid_));
    const int qb = unit >> 1, g = unit & 1, tid = tid_, lane = tid & 63, wv = __builtin_amdgcn_readfirstlane(tid >> 6), r = wv >> 1, hf = wv & 1, hq = 4 * g + r, fr = lane & 15, fq = lane >> 4;
    const bool lat = qb >= 2; const int lb = qb - 2;
    const int qtok0 = (lat ? CTX + 128 * lb : 128 * qb) + 64 * hf;
    const bf16* P = (const bf16*)(F.ws + WS_P); bf16* YC = (bf16*)(F.ws + WS_YABC + 2 * YSTRIDE);
    const int kb_lo = lat ? max(lb - 1, 0) : 0, kb_hi = lat ? min(lb + 1, SEQ / 128 - 1) : -1;
    const int nloc = lat ? 2 * (kb_hi - kb_lo + 1) : 0, nt = nloc + 4;
    bf16x8 qf[4][2];
#pragma unroll
    for (int n = 0; n < 4; ++n)
#pragma unroll
        for (int ks = 0; ks < 2; ++ks) qf[n][ks] = *(const bf16x8*)((const bf16*)(F.ws + WS_QN) + (unsigned)((qtok0 + 16 * n + fr) * 512 + hq * 64 + 32 * ks + 8 * fq));
    const float LOG2E = 1.4426950408889634f, SC = 0.125f * LOG2E;
    const float sink2 = inp(a, 18)[l * 8 + hq] * LOG2E;
    float mrun[4], lrun[4];
    f32x4 o[4][4];
#pragma unroll
    for (int n = 0; n < 4; ++n) { mrun[n] = sink2; lrun[n] = (fq == 0) ? 1.0f : 0.0f;
#pragma unroll
        for (int dt = 0; dt < 4; ++dt) o[dt][n] = (f32x4){0.f, 0.f, 0.f, 0.f}; }
    LAS bf16* lds = (LAS bf16*)F.lds;
    const int skey = tid >> 3, sch = tid & 7;
    v4u kreg, vreg;
    auto tile_tok0 = [&](int t) -> int { return (t < nloc) ? (CTX + 128 * kb_lo + 64 * t) : 64 * (t - nloc); };
    auto g_load = [&](int t) { const unsigned tk = (unsigned)(tile_tok0(t) + skey); kreg = *(const v4u*)((const bf16*)(F.ws + WS_KN) + (tk * 128u + g * 64 + 8 * sch)); vreg = *(const v4u*)(P + (tk * (unsigned)NIN + PC_CV + g * 64 + 8 * sch)); };
    auto l_store = [&](int b) { LAS bf16* Kb = lds + b * (AT_BUF / 2); LAS bf16* Vb = Kb + 64 * AT_KSTR;
        *(LAS v4u*)(Kb + skey * AT_KSTR + 8 * sch) = kreg;
        const unsigned vw[4] = {vreg.x, vreg.y, vreg.z, vreg.w};
#pragma unroll
        for (int j = 0; j < 4; ++j) { Vb[(8 * sch + 2 * j) * AT_KSTR + skey] = (bf16)(vw[j] & 0xffffu); Vb[(8 * sch + 2 * j + 1) * AT_KSTR + skey] = (bf16)(vw[j] >> 16); } };
    __syncthreads();
    g_load(0); l_store(0);
    __syncthreads();
    for (int t = 0; t < nt; ++t) {
        if (t + 1 < nt) g_load(t + 1);
        const LAS bf16* Kb = lds + (t & 1) * (AT_BUF / 2); const LAS bf16* Vb = Kb + 64 * AT_KSTR;
        const bool local = t < nloc; const int kp0 = 128 * kb_lo + 64 * t;
        const bool need_mask = local && ((kp0 >> 7) != lb);
#pragma unroll
        for (int nh = 0; nh < 2; ++nh) {
            f32x4 s[4][2];
#pragma unroll
            for (int kt = 0; kt < 4; ++kt) {
                const bf16x8 ka0 = *(const LAS bf16x8*)(Kb + (16 * kt + fr) * AT_KSTR + 8 * fq), ka1 = *(const LAS bf16x8*)(Kb + (16 * kt + fr) * AT_KSTR + 32 + 8 * fq);
#pragma unroll
                for (int n2 = 0; n2 < 2; ++n2) { f32x4 acc = (f32x4){0.f, 0.f, 0.f, 0.f};
                    acc = __builtin_amdgcn_mfma_f32_16x16x32_bf16(ka0, qf[2 * nh + n2][0], acc, 0, 0, 0); acc = __builtin_amdgcn_mfma_f32_16x16x32_bf16(ka1, qf[2 * nh + n2][1], acc, 0, 0, 0); s[kt][n2] = acc; }
            }
#pragma unroll
            for (int n2 = 0; n2 < 2; ++n2) { const int n = 2 * nh + n2; const int qp = qtok0 - CTX + 16 * n + fr;
#pragma unroll
                for (int kt = 0; kt < 4; ++kt)
#pragma unroll
                    for (int i = 0; i < 4; ++i) { float v = s[kt][n2][i] * SC; if (need_mask) { const int d = qp - (kp0 + 16 * kt + 4 * fq + i); if (d > 128 || d < -128) v = -INFINITY; } s[kt][n2][i] = v; }
                float mx = s[0][n2][0];
#pragma unroll
                for (int kt = 0; kt < 4; ++kt)
#pragma unroll
                    for (int i = 0; i < 4; ++i) mx = fmaxf(mx, s[kt][n2][i]);
                mx = fmaxf(mx, __shfl_xor(mx, 16)); mx = fmaxf(mx, __shfl_xor(mx, 32));
                const float mnew = fmaxf(mrun[n], mx), alpha = fexp2(mrun[n] - mnew); mrun[n] = mnew; float ps = 0.f;
#pragma unroll
                for (int kt = 0; kt < 4; ++kt)
#pragma unroll
                    for (int i = 0; i < 4; ++i) { const float p = fexp2(s[kt][n2][i] - mnew); s[kt][n2][i] = p; ps += p; }
                lrun[n] = lrun[n] * alpha + ps;
#pragma unroll
                for (int dt = 0; dt < 4; ++dt) o[dt][n] = o[dt][n] * alpha; }
#pragma unroll
            for (int ks2 = 0; ks2 < 2; ++ks2) {
                bf16x8 pb[2];
#pragma unroll
                for (int n2 = 0; n2 < 2; ++n2) { v4u w; w.x = cvt_pk_bf16(s[2 * ks2][n2][0], s[2 * ks2][n2][1]); w.y = cvt_pk_bf16(s[2 * ks2][n2][2], s[2 * ks2][n2][3]); w.z = cvt_pk_bf16(s[2 * ks2 + 1][n2][0], s[2 * ks2 + 1][n2][1]); w.w = cvt_pk_bf16(s[2 * ks2 + 1][n2][2], s[2 * ks2 + 1][n2][3]); pb[n2] = __builtin_bit_cast(bf16x8, w); }
#pragma unroll
                for (int dt = 0; dt < 4; ++dt) { const LAS bf16* vp = Vb + (16 * dt + fr) * AT_KSTR + 32 * ks2 + 4 * fq;
                    const v2u va = *(const LAS v2u*)vp, vb2 = *(const LAS v2u*)(vp + 16); const v4u vv = (v4u){va.x, va.y, vb2.x, vb2.y}; const bf16x8 vf = __builtin_bit_cast(bf16x8, vv);
#pragma unroll
                    for (int n2 = 0; n2 < 2; ++n2) o[dt][2 * nh + n2] = __builtin_amdgcn_mfma_f32_16x16x32_bf16(vf, pb[n2], o[dt][2 * nh + n2], 0, 0, 0); }
            }
        }
        if (t + 1 < nt) l_store((t + 1) & 1);
        __syncthreads();
    }
#pragma unroll
    for (int n = 0; n < 4; ++n) { float lt = lrun[n]; lt += __shfl_xor(lt, 16); lt += __shfl_xor(lt, 32); const float inv = 1.0f / lt;
        bf16* yp = YC + (unsigned)((qtok0 + 16 * n + fr) * 512 + hq * 64 + 4 * fq);
#pragma unroll
        for (int dt = 0; dt < 4; ++dt) { v2u w; w.x = cvt_pk_bf16(o[dt][n][0] * inv, o[dt][n][1] * inv); w.y = cvt_pk_bf16(o[dt][n][2] * inv, o[dt][n][3] * inv); *(v2u*)(yp + 16 * dt) = w; } }
}
__device__ __forceinline__ void moe_convert_pool(Frame& F, ArgsP a, int l) {
    unsigned* qhead = F.ctl + CW_CNT + 512 + 64 * l;
    LAS float* scr = (LAS float*)(F.lds + F.wave * 16384); bf16* WGU = (bf16*)(F.ws + WS_WGU); bf16* WDN = (bf16*)(F.ws + WS_WDN);
    constexpr int NGU = NE * 1024, NDN = NE * 512, GRAB = 8;
    const int nsm = (I_BR_L + I_WO_L) + ((l + 1 < NL) ? I_IN_L : 0), ntot = NGU + NDN + ((nsm + GRAB - 1) / GRAB) * GRAB;
    LAS unsigned* bw = (LAS unsigned*)(F.lds + MISC_OFF + 2560);
    for (;;) { __syncthreads(); if (F.tid == 0) bw[0] = __hip_atomic_fetch_add(qhead, 8u, __ATOMIC_RELAXED, __HIP_MEMORY_SCOPE_AGENT); __syncthreads();
        const unsigned b0 = (unsigned)__builtin_amdgcn_readfirstlane((int)bw[0]); if (b0 >= (unsigned)(ntot / GRAB)) break;
        const unsigned g0 = b0 + (unsigned)F.wave; if (g0 >= (unsigned)(ntot / GRAB)) continue;
        for (int q = 0; q < GRAB; ++q) { int it = (int)g0 * GRAB + q;
            if (it >= NGU + NDN) { const int r = it - (NGU + NDN); if (r < I_BR_L + I_WO_L) convert_small_item(F, a, l, I_IN_L + r, scr); else if (r < nsm) convert_small_item(F, a, l + 1, r - (I_BR_L + I_WO_L), scr); }
            else if (it < NGU) { const int le = l * NE + it / 1024, r = it % 1024, kb = r / 64, nb = r % 64; const int dst = (nb < 32) ? 256 * (nb >> 2) + 32 * (nb & 3) : 256 * ((nb - 32) >> 2) + 128 + 32 * ((nb - 32) & 3);
                transpose_item(inp(a, 25) + (size_t)le * 1024 * 2048, 2048, 1024, WGU + (size_t)le * 2048 * 1024, kb * 64, 32 * nb, dst, 32, scr, F.lane); }
            else { it -= NGU; const int le = l * NE + it / 512, r = it % 512, kb = r / 32, nb = r % 32;
                transpose_item(inp(a, 27) + (size_t)le * 1024 * 1024, 1024, 1024, WDN + (size_t)le * 1024 * 1024, kb * 64, 32 * nb, 32 * nb, 32, scr, F.lane); } } }
}
__device__ __forceinline__ void phase_mixers(Frame& F, ArgsP a, int l) {
    const bool split = F.G >= 160;
    unsigned* gflag = F.ctl + CW_CNT + 256 + 64 * l;
    for (int item = F.bid; item < 128; item += F.G) {
        if (item < 64) { for (int r_ = 0; r_ < PROBE_REPS(21); ++r_) dn_scan_item(F, split ? ((item & 7) * 8 + (item >> 3)) : item); }
        else { for (int r_ = 0; r_ < PROBE_REPS(22); ++r_) gla_scan_item(F, item - 64);
            if (split) { asm volatile("s_waitcnt vmcnt(0)" ::: "memory"); __syncthreads();
                if (F.tid == 0) { __builtin_amdgcn_fence(__ATOMIC_RELEASE, "agent"); asm volatile("s_waitcnt vmcnt(0)" ::: "memory"); __hip_atomic_fetch_add(gflag, 1u, __ATOMIC_RELAXED, __HIP_MEMORY_SCOPE_AGENT); }
                __syncthreads(); moe_convert_pool(F, a, l); } }
        __syncthreads(); }
    const int ab = split ? F.bid - 128 : F.bid, nab = split ? F.G - 128 : F.G;
    if (ab >= 0) { for (int r_ = 0; r_ < PROBE_REPS(23); ++r_) for (int u = ab; u < 260; u += nab) attn_unit(F, a, l, u);
        if (split) {
            __syncthreads();
            if (F.tid == 0) { unsigned sp = 0; while (__hip_atomic_load(gflag, __ATOMIC_RELAXED, __HIP_MEMORY_SCOPE_AGENT) < 64u) { __builtin_amdgcn_s_sleep(8); if (++sp > (1u << 22)) break; }
                __builtin_amdgcn_fence(__ATOMIC_ACQUIRE, "agent"); asm volatile("s_waitcnt vmcnt(0)" ::: "memory"); }
            __syncthreads();
            for (int wi = ab * 8 + F.wave; wi < 4160; wi += nab * 8) gla_post_witem(F, a, l, wi);
            __syncthreads(); moe_convert_pool(F, a, l); } }
}
__device__ __forceinline__ void phase_post(Frame& F, ArgsP a, int l) {
    const int nwi = (F.G >= 160) ? 4160 : 8320;
    for (int wi = F.bid * 8 + F.wave; wi < nwi; wi += F.G * 8) { if (wi < 4160) dn_post_witem(F, a, l, wi); else gla_post_witem(F, a, l, wi - 4160); }
}

template <int KQ> __device__ __forceinline__ void ctx_tile_acc(const bf16* Arow0, const bf16* Wt, int K, int k0, int r0, int c0, int fr, int fq, f32x4 (&acc)[2]) {
    const bf16* ap = Arow0 + (unsigned)((r0 + fr) * K + k0 + 8 * fq); const bf16* b0 = Wt + (unsigned)((c0 + fr) * K + k0 + 8 * fq); const bf16* b1 = b0 + 16 * K;
    bf16x8 av[KQ / 32], w0[KQ / 32], w1[KQ / 32];
#pragma unroll
    for (int ks = 0; ks < KQ / 32; ++ks) { av[ks] = *(const bf16x8*)(ap + 32 * ks); w0[ks] = *(const bf16x8*)(b0 + 32 * ks); w1[ks] = *(const bf16x8*)(b1 + 32 * ks); }
#pragma unroll
    for (int ks = 0; ks < KQ / 32; ++ks) { acc[0] = __builtin_amdgcn_mfma_f32_16x16x32_bf16(w0[ks], av[ks], acc[0], 0, 0, 0); acc[1] = __builtin_amdgcn_mfma_f32_16x16x32_bf16(w1[ks], av[ks], acc[1], 0, 0, 0); }
}
__device__ __forceinline__ void ctx_branch_rows(Frame& F, int l) {
    const bf16* P = (const bf16*)(F.ws + WS_P); bf16* MG = (bf16*)(F.ws + WS_MG); const int fr = F.lane & 15, fq = F.lane >> 4;
    LAS f32x4* red = (LAS f32x4*)F.lds;
    for (int base = F.bid * 8; base < 2048; base += F.G * 8) { const int wi = base + F.wave, it = wi >> 2, kq = wi & 3, r0 = (it >> 5) * 16, c0 = (it & 31) * 32;
        f32x4 sum[2] = {(f32x4){0.f, 0.f, 0.f, 0.f}, (f32x4){0.f, 0.f, 0.f, 0.f}};
#pragma unroll
        for (int z = 0; z < 3; ++z) { f32x4 acc[2] = {(f32x4){0.f, 0.f, 0.f, 0.f}, (f32x4){0.f, 0.f, 0.f, 0.f}};
            ctx_tile_acc<128>((const bf16*)(F.ws + WS_YABC + z * YSTRIDE), (const bf16*)(F.ws + WS_WBR) + (size_t)(l * 3 + z) * 1024 * 512, 512, 128 * kq, r0, c0, fr, fq, acc);
#pragma unroll
            for (int t = 0; t < 2; ++t) { const v2u gw = *(const v2u*)(P + (unsigned)((r0 + fr) * NIN + PC_GL + z * 1024 + c0 + 16 * t + 4 * fq));
                sum[t][0] += acc[t][0] * bf_lo(gw.x); sum[t][1] += acc[t][1] * bf_hi(gw.x); sum[t][2] += acc[t][2] * bf_lo(gw.y); sum[t][3] += acc[t][3] * bf_hi(gw.y); } }
        __syncthreads();
        red[(F.wave * 2 + 0) * 64 + F.lane] = sum[0]; red[(F.wave * 2 + 1) * 64 + F.lane] = sum[1];
        __syncthreads();
        if (kq == 0) {
#pragma unroll
            for (int t = 0; t < 2; ++t) { f32x4 s = sum[t];
#pragma unroll
                for (int q = 1; q < 4; ++q) s += red[((F.wave + q) * 2 + t) * 64 + F.lane];
                v2u o; o.x = cvt_pk_bf16(s[0], s[1]); o.y = cvt_pk_bf16(s[2], s[3]); *(v2u*)(MG + (unsigned)((r0 + fr) * 1024 + c0 + 16 * t + 4 * fq)) = o; } } }
}
__device__ __forceinline__ void ctx_wo_rows(Frame& F, int l) {
    float* XS = (float*)(F.ws + WS_XS); const float* modc = (const float*)(F.ws + WS_MOD) + (size_t)l * 2 * 6144 + 6144 + 2 * 1024; const int fr = F.lane & 15, fq = F.lane >> 4;
    LAS f32x4* red = (LAS f32x4*)F.lds;
    for (int base = F.bid * 8; base < 2048; base += F.G * 8) { const int wi = base + F.wave, it = wi >> 2, kq = wi & 3, r0 = (it >> 5) * 16, c0 = (it & 31) * 32;
        f32x4 acc[2] = {(f32x4){0.f, 0.f, 0.f, 0.f}, (f32x4){0.f, 0.f, 0.f, 0.f}};
        ctx_tile_acc<256>((const bf16*)(F.ws + WS_MG), (const bf16*)(F.ws + WS_WO) + (size_t)l * 1024 * 1024, 1024, 256 * kq, r0, c0, fr, fq, acc);
        __syncthreads();
        red[(F.wave * 2 + 0) * 64 + F.lane] = acc[0]; red[(F.wave * 2 + 1) * 64 + F.lane] = acc[1];
        __syncthreads();
        if (kq == 0) {
#pragma unroll
            for (int t = 0; t < 2; ++t) { f32x4 s = acc[t];
#pragma unroll
                for (int q = 1; q < 4; ++q) s += red[((F.wave + q) * 2 + t) * 64 + F.lane];
                float* xp = XS + (unsigned)((r0 + fr) * 1024 + c0 + 16 * t + 4 * fq); *(f32x4*)xp = *(const f32x4*)xp + *(const f32x4*)(modc + c0 + 16 * t + 4 * fq) * s; } } }
}
__device__ __forceinline__ void phase_route(Frame& F, ArgsP a, int l, bool commit = true) {
    const float* XS = (const float*)(F.ws + WS_XS); bf16* H = (bf16*)(F.ws + WS_H); bf16* HLO = (bf16*)(F.ws + WS_HLO); const float* MOD = (const float*)(F.ws + WS_MOD) + (size_t)l * 2 * 6144;
    int* RT = (int*)(F.ws + WS_RT); unsigned* cnt = F.ctl + CW_CNT + 32 * l;
    const bf16* WH = (const bf16*)(F.ws + WS_WRT) + (size_t)l * 65536; const bf16* WL = WH + 32768;
    const int lane = F.lane, fr = lane & 15, fq = lane >> 4;
    const float rb0 = inp(a, 24)[l * 32 + fr], rb1 = inp(a, 24)[l * 32 + 16 + fr];
    LAS unsigned* lcnt = (LAS unsigned*)F.lds;
    __syncthreads();
    if (F.tid < 32) lcnt[F.tid] = 0u;
    __syncthreads();
    for (int it = F.bid * 8 + F.wave; it < T / 16; it += F.G * 8) {
        f32x4 gsv[4], shv[4]; { const float* mv = MOD + (size_t)((16 * it < CTX) ? 1 : 0) * 6144; load_mod(inp(a, 7) + l * 1024, mv + 3 * 1024, mv + 4 * 1024, lane, gsv, shv); }
        for (int r4 = 0; r4 < 16; r4 += 4) { f32x4 xr[4][4];
#pragma unroll
          for (int rr = 0; rr < 4; ++rr)
#pragma unroll
            for (int j = 0; j < 4; ++j) xr[rr][j] = *(const f32x4*)(XS + (size_t)(16 * it + r4 + rr) * 1024 + 4 * lane + 256 * j);
          __builtin_amdgcn_sched_barrier(0);
#pragma unroll
          for (int rr = 0; rr < 4; ++rr) { const int t = 16 * it + r4 + rr; f32x4 x[4], h[4];
#pragma unroll
            for (int j = 0; j < 4; ++j) x[j] = xr[rr][j];
            norm_mod_store2(x, gsv, shv, H + (size_t)t * 1024, lane, h);
#pragma unroll
            for (int j = 0; j < 4; ++j) { const unsigned h01 = cvt_pk_bf16(h[j][0], h[j][1]), h23 = cvt_pk_bf16(h[j][2], h[j][3]);
                v2u o; o.x = cvt_pk_bf16(h[j][0] - bf_lo(h01), h[j][1] - bf_hi(h01)); o.y = cvt_pk_bf16(h[j][2] - bf_lo(h23), h[j][3] - bf_hi(h23)); *(v2u*)(HLO + (size_t)t * 1024 + 4 * lane + 256 * j) = o; } } }
        asm volatile("s_waitcnt vmcnt(0)" ::: "memory");
        f32x4 acc0 = (f32x4){0.f, 0.f, 0.f, 0.f}, acc1 = acc0;
        const bf16* ah = H + (size_t)(16 * it + fr) * 1024 + 8 * fq; const bf16* al = HLO + (size_t)(16 * it + fr) * 1024 + 8 * fq;
        const bf16* b0h = WH + (size_t)fr * 1024 + 8 * fq; const bf16* b1h = b0h + 16 * 1024; const bf16* b0l = WL + (size_t)fr * 1024 + 8 * fq; const bf16* b1l = b0l + 16 * 1024;
#pragma unroll 4
        for (int ks = 0; ks < 32; ++ks) { const bf16x8 xh = *(const bf16x8*)(ah + 32 * ks), xl = *(const bf16x8*)(al + 32 * ks), w0h = *(const bf16x8*)(b0h + 32 * ks), w1h = *(const bf16x8*)(b1h + 32 * ks), w0l = *(const bf16x8*)(b0l + 32 * ks), w1l = *(const bf16x8*)(b1l + 32 * ks);
            acc0 = __builtin_amdgcn_mfma_f32_16x16x32_bf16(xh, w0l, acc0, 0, 0, 0); acc1 = __builtin_amdgcn_mfma_f32_16x16x32_bf16(xh, w1l, acc1, 0, 0, 0);
            acc0 = __builtin_amdgcn_mfma_f32_16x16x32_bf16(xl, w0h, acc0, 0, 0, 0); acc1 = __builtin_amdgcn_mfma_f32_16x16x32_bf16(xl, w1h, acc1, 0, 0, 0);
            acc0 = __builtin_amdgcn_mfma_f32_16x16x32_bf16(xh, w0h, acc0, 0, 0, 0); acc1 = __builtin_amdgcn_mfma_f32_16x16x32_bf16(xh, w1h, acc1, 0, 0, 0); }
#pragma unroll
        for (int i = 0; i < 4; ++i) { float v0 = acc0[i] + rb0, v1 = acc1[i] + rb1; float tv[4]; int te[4];
#pragma unroll
            for (int k = 0; k < 4; ++k) { const float m = row_max16(fmaxf(v0, v1));
                const int sel = row_min16((v0 == m) ? fr : ((v1 == m) ? 16 + fr : 64));
                tv[k] = m; te[k] = sel; if (sel == fr) v0 = -INFINITY; if (sel == 16 + fr) v1 = -INFINITY; }
            const float e1 = fexp(tv[1] - tv[0]), e2 = fexp(tv[2] - tv[0]), e3 = fexp(tv[3] - tv[0]), inv = 1.0f / (1.0f + e1 + e2 + e3);
            if (fr < 4 && commit) { const int t = 16 * it + 4 * fq + i; const int ek = (fr == 0) ? te[0] : (fr == 1) ? te[1] : (fr == 2) ? te[2] : te[3]; const float gk = ((fr == 0) ? 1.0f : (fr == 1) ? e1 : (fr == 2) ? e2 : e3) * inv;
                const unsigned pos = __hip_atomic_fetch_add(lcnt + ek, 1u, __ATOMIC_RELAXED, __HIP_MEMORY_SCOPE_WORKGROUP);
                RT[(size_t)t * 4 + fr] = ek; RT[(size_t)T * 4 + (size_t)t * 4 + fr] = (int)pos; ((float*)RT)[(size_t)2 * T * 4 + (size_t)t * 4 + fr] = gk; } }
    }
    __syncthreads();
    if (F.tid < 32 && commit) ((unsigned*)(F.ws + WS_RT + 1536 * 1024))[F.bid * 32 + F.tid] = atomicAdd(cnt + F.tid, lcnt[F.tid]);
}
__device__ __forceinline__ int moe_tables(Frame& F, int l) {
    LAS int* off = (LAS int*)(F.lds + MISC_OFF + 64); LAS unsigned char* tile_e = (LAS unsigned char*)(F.lds + MISC_OFF + 256);
    __syncthreads();
    if (F.tid < 64) { const unsigned* cnt = F.ctl + CW_CNT + 32 * l; const int e = F.lane & 31;
        const int c = (int)__hip_atomic_load(cnt + e, __ATOMIC_RELAXED, __HIP_MEMORY_SCOPE_AGENT); const int nt = (F.lane < 32) ? ((c + 255) >> 8) : 0;
        int incl = nt;
#pragma unroll
        for (int o = 1; o < 32; o <<= 1) { const int up = __shfl_up(incl, o); if ((F.lane & 31) >= o) incl += up; }
        const int rt0 = incl - nt;
        if (F.lane < 32) { off[e] = rt0 * 256; if (e == 31) off[NE] = incl;
#pragma nounroll
            for (int i = 0; i < nt; ++i) tile_e[rt0 + i] = (unsigned char)e; } }
    __syncthreads();
    return __builtin_amdgcn_readfirstlane(off[NE]);
}
__device__ __forceinline__ void phase_gather(Frame& F, int l) {
    moe_tables(F, l);
    const LAS int* off = (const LAS int*)(F.lds + MISC_OFF + 64);
    int* RT = (int*)(F.ws + WS_RT); int* SRC = (int*)(F.ws + WS_XG) + (size_t)l * (MAXRT * 256);
    for (int i = F.bid * 512 + F.tid; i < T * 4; i += F.G * 512) { const int t = i >> 2;
        const int ek = RT[i], pos = RT[(size_t)T * 4 + i]; const int slot = off[ek] + (int)((const unsigned*)(F.ws + WS_RT + 1536 * 1024))[((t >> 7) % F.G) * 32 + ek] + pos;
        RT[(size_t)3 * T * 4 + i] = slot; SRC[slot] = t; }
}
template <class Sched> __device__ __forceinline__ void moe_gather_table(Frame& F, const Sched& S, int l, LAS int* gidx) {
    const int* SRC = (const int*)(F.ws + WS_XG) + (size_t)l * (MAXRT * 256);
    int nu = 0; { Unit u; while (nu < 24 && S.next(nu, u)) ++nu; }
    for (int idx = F.tid; idx < nu * 256; idx += 512) { Unit u; S.next(idx >> 8, u); gidx[idx] = SRC[u.pm * 256 + (idx & 255)]; }
    __syncthreads();
}
__device__ __forceinline__ void phase_combine(Frame& F, ArgsP a, int l, bool commit = true) {
    float* XS = (float*)(F.ws + WS_XS); bf16* H = (bf16*)(F.ws + WS_H); const bf16* Y = (const bf16*)(F.ws + WS_Y); const int* RT = (const int*)(F.ws + WS_RT);
    const float* MOD = (const float*)(F.ws + WS_MOD) + (size_t)l * 2 * 6144; const int lane = F.lane;
    for (int t0 = F.bid * 8 + F.wave; t0 < T; t0 += 2 * F.G * 8) {
        int tt[2]; tt[0] = t0; tt[1] = (t0 + F.G * 8 < T) ? t0 + F.G * 8 : t0;
        int slot[2][4]; float gk[2][4];
#pragma unroll
        for (int q = 0; q < 2; ++q)
#pragma unroll
            for (int k = 0; k < 4; ++k) { slot[q][k] = RT[(size_t)3 * T * 4 + (size_t)tt[q] * 4 + k]; gk[q][k] = ((const float*)RT)[(size_t)2 * T * 4 + (size_t)tt[q] * 4 + k]; }
        v2u yv[2][4][4]; f32x4 xv[2][4];
#pragma unroll
        for (int q = 0; q < 2; ++q) {
#pragma unroll
            for (int k = 0; k < 4; ++k)
#pragma unroll
                for (int j = 0; j < 4; ++j) yv[q][k][j] = *(const v2u*)(Y + (size_t)slot[q][k] * 1024 + 4 * lane + 256 * j);
#pragma unroll
            for (int j = 0; j < 4; ++j) xv[q][j] = *(const f32x4*)(XS + (size_t)tt[q] * 1024 + 4 * lane + 256 * j); }
        __builtin_amdgcn_sched_barrier(0);
#pragma unroll
        for (int q = 0; q < 2; ++q) { const int t = tt[q]; if (q == 1 && t == t0) break;
            const float* mv = MOD + (size_t)((t < CTX) ? 1 : 0) * 6144 + 5 * 1024;
            f32x4 x[4], h[4];
#pragma unroll
            for (int j = 0; j < 4; ++j) { f32x4 acc = (f32x4){0.f, 0.f, 0.f, 0.f};
#pragma unroll
                for (int k = 0; k < 4; ++k) acc += (f32x4){bf_lo(yv[q][k][j].x), bf_hi(yv[q][k][j].x), bf_lo(yv[q][k][j].y), bf_hi(yv[q][k][j].y)} * gk[q][k];
                x[j] = xv[q][j] + *(const f32x4*)(mv + 4 * lane + 256 * j) * acc; }
            if (!commit) { if (x[0][0] == 1.2345e30f) XS[0] = 0.f; }
            else if (l + 1 < NL) {
#pragma unroll
                for (int j = 0; j < 4; ++j) *(f32x4*)(XS + (size_t)t * 1024 + 4 * lane + 256 * j) = x[j];
                const float* mn = MOD + (size_t)2 * 6144 + (size_t)((t < CTX) ? 1 : 0) * 6144;
                norm_mod_store(x, inp(a, 6) + (l + 1) * 1024, mn, mn + 1024, H + (size_t)t * 1024, lane, h);
            } else if (t >= CTX) {
#pragma unroll
                for (int j = 0; j < 4; ++j) *(f32x4*)(outp(a) + (size_t)(t - CTX) * 1024 + 4 * lane + 256 * j) = x[j];
            } }
    }
}

__device__ __forceinline__ int opq_s(int v) { asm volatile("" : "+s"(v)); return __builtin_amdgcn_readfirstlane(v); }
__device__ __forceinline__ unsigned long long opq_u64(unsigned long long p) { unsigned lo_ = (unsigned)p, hi_ = (unsigned)(p >> 32); asm volatile("" : "+s"(lo_), "+s"(hi_));
    return ((unsigned long long)(unsigned)__builtin_amdgcn_readfirstlane((int)hi_) << 32) | (unsigned)__builtin_amdgcn_readfirstlane((int)lo_); }
#define TID_NOW() (opq_s(wave0) * 64 + (int)__builtin_amdgcn_mbcnt_hi(~0u, __builtin_amdgcn_mbcnt_lo(~0u, 0u)))
#define PHASE_BEGIN(LV) Frame F; ArgsP A; int l; { int t_ = TID_NOW(); asm volatile("" : "+v"(t_)); \
    F.ws = (unsigned char*)(GAS unsigned char*)opq_u64((unsigned long long)args.ws); F.ctl = (unsigned*)(F.ws + WS_CTL); F.lds = (LAS unsigned char*)lds_raw + opq_s(0); F.tid = t_; F.lane = t_ & 63; F.wave = __builtin_amdgcn_readfirstlane(t_ >> 6); \
    F.G = opq_s((int)gridDim.x); F.bid = opq_s((int)blockIdx.x); A = (ArgsP)opq_u64((unsigned long long)__builtin_amdgcn_kernarg_segment_ptr()); l = opq_s(LV); } \
    unsigned char* const ws = F.ws; (void)ws; (void)A; (void)l
__global__ void __launch_bounds__(512, 2) mk_fwd(Args args) {
    extern __shared__ __attribute__((aligned(16))) unsigned char lds_raw[];
    const int lo = args.ph_lo, hi = args.ph_hi;
    const int wave0 = __builtin_amdgcn_readfirstlane((int)(threadIdx.x >> 6));
    if (threadIdx.x < 4) ((LAS unsigned*)((LAS unsigned char*)lds_raw + MISC_OFF))[threadIdx.x] = 0u;
    __syncthreads();
    XcdBarrier bar; bar.lead = false; bar.bar = (unsigned*)(args.ws + WS_CTL) + CW_BAR; bar.x = 0; bar.st = (volatile LAS unsigned*)((LAS unsigned char*)lds_raw + MISC_OFF);
    if (hi - lo > 1) bar = xcd_barrier_post((unsigned*)(args.ws + WS_CTL) + CW_BAR, (volatile LAS unsigned*)((LAS unsigned char*)lds_raw + MISC_OFF), threadIdx.x == 0);
#define IN(k) (lo <= (k) && (k) < hi)
#define SEAM(k) do { if (IN(k) && IN((k) + 1)) { XcdBarrier b2_; b2_.lead = (TID_NOW() == 0); b2_.bar = (unsigned*)(GAS unsigned*)opq_u64((unsigned long long)bar.bar); b2_.x = (unsigned)opq_s((int)bar.x); b2_.st = (volatile LAS unsigned*)((LAS unsigned char*)lds_raw + opq_s(MISC_OFF)); xcd_barrier(b2_); } } while (0)
#define GRIDBAR() do { XcdBarrier b2_; b2_.lead = (TID_NOW() == 0); b2_.bar = (unsigned*)(GAS unsigned*)opq_u64((unsigned long long)bar.bar); b2_.x = (unsigned)opq_s((int)bar.x); b2_.st = (volatile LAS unsigned*)((LAS unsigned char*)lds_raw + opq_s(MISC_OFF)); xcd_barrier(b2_); } while (0)
#define PH_OUTER(k) (((k) == 5 || (k) == 6 || (k) == 10) ? 1 : PROBE_REPS(k))
#define PH(k, ...) for (int rep_ = 0; rep_ < PH_OUTER(k); ++rep_) { if (IN(pb + (k))) { __VA_ARGS__ } } SEAM(pb + (k));
    for (int rep_ = 0; rep_ < PROBE_REPS(100); ++rep_) { if (IN(0)) { PHASE_BEGIN(0); phase_prologue(F, A); } if (rep_ + 1 < PROBE_REPS(100)) { if (hi - lo > 1) GRIDBAR(); } } SEAM(0);
    if (IN(1)) { PHASE_BEGIN(0); phase_norm0(F, A); } SEAM(1);
#define LAYER_BODY(LIDX) { const int layer = (LIDX); \
        const int pb = NPH_PRO + layer * NPH_LAYER; \
        PH(0,  \
            PHASE_BEGIN(layer); \
            TileOrder S; S.init(T / 256, NIN / 256, F.G, F.bid, ws + WS_H, ws + WS_WIN + (size_t)l * NIN * 1024 * 2, 1024); \
            EpiIn E{(bf16*)(ws + WS_P), (float*)(ws + WS_SM)}; \
            for (int r_ = 0; r_ < PROBE_REPS(1000); ++r_) pg8::gemm_phase<EpiIn, TileOrder, true, true>(F.lds, F.tid, 1024, S, E); \
        ) \
        PH(1,  PHASE_BEGIN(layer); for (int r_ = 0; r_ < PROBE_REPS(11); ++r_) phase_prep(F, A, l); for (int r_ = 0; r_ < PROBE_REPS(12); ++r_) { for (int item = F.bid; item < 1040; item += F.G) dn_prep_item(F, A, l, item); \
              \
            if (F.G == 256) { for (int j = (F.bid < 16) ? 4 : 0; ; ++j) { const int item = (j < 4) ? j * 240 + (F.bid - 16) : 960 + (j - 4) * 256 + F.bid; if (item >= 2080) break; gla_prep_item(F, A, l, item); } } \
            else { for (int item = F.bid; item < 2080; item += F.G) gla_prep_item(F, A, l, item); } } ) \
        PH(2,  PHASE_BEGIN(layer); phase_mixers(F, A, l); ) \
        PH(3,  PHASE_BEGIN(layer); phase_post(F, A, l); ) \
        PH(4,  \
            PHASE_BEGIN(layer); \
            BranchOrder S; S.init(T / 256 - 1, 4, F.G, F.bid, ws + WS_YABC, ws + WS_WBR + (size_t)l * 3 * 1024 * 512 * 2, 512, 1); S.zA = YSTRIDE; S.zB = (size_t)1024 * 512 * 2; \
            EpiBranch E{(const bf16*)(ws + WS_P), (bf16*)(ws + WS_MG)}; \
            for (int r_ = 0; r_ < PROBE_REPS(41); ++r_) pg8::gemm_phase<EpiBranch, BranchOrder, true, true>(F.lds, F.tid, 512, S, E); for (int r_ = 0; r_ < PROBE_REPS(42); ++r_) ctx_branch_rows(F, l); \
        ) \
        PH(5,  \
            PHASE_BEGIN(layer); \
            const float* MOD = (const float*)(ws + WS_MOD) + (size_t)l * 2 * 6144; \
            TileOrder S; S.init(T / 256 - 1, 4, F.G, F.bid, ws + WS_MG, ws + WS_WO + (size_t)l * 1024 * 1024 * 2, 1024, 1); \
            EpiWo E{(float*)(ws + WS_XS), MOD + 2 * 1024, MOD + 6144 + 2 * 1024, true}; \
            for (int r_ = 0; r_ < PROBE_REPS(5); ++r_) { E.commit = opq_s(r_ + 1 == PROBE_REPS(5)) != 0; pg8::gemm_phase<EpiWo, TileOrder, true, true>(F.lds, F.tid, 1024, S, E); } ctx_wo_rows(F, l); \
        ) \
        PH(6,  PHASE_BEGIN(layer); for (int r_ = 0; r_ < PROBE_REPS(6); ++r_) phase_route(F, A, l, opq_s(r_ + 1 == PROBE_REPS(6)) != 0); ) \
        PH(7,  PHASE_BEGIN(layer); phase_gather(F, l); ) \
        PH(8,  \
            PHASE_BEGIN(layer); \
            const int rt = moe_tables(F, l); \
            MoeGatherOrder S; S.rt = rt; S.nN = 8; S.G = F.G; S.c = F.bid; S.tile_e = (const LAS unsigned char*)(F.lds + MISC_OFF + 256); S.gidx = (const LAS int*)(F.lds + MISC_OFF + 2560); S.rowbytes = 2048u; \
            S.A = (const char*)(ws + WS_H); S.B = (const char*)(ws + WS_WGU + (size_t)l * NE * 2048 * 1024 * 2); S.tstepA = S.tstepB = (size_t)256 * 1024 * 2; S.zB = (size_t)2048 * 1024 * 2; \
            EpiMoe1 E{(bf16*)(ws + WS_ACT), inp(A, 26) + (size_t)l * NE * 2048}; \
            moe_gather_table(F, S, l, (LAS int*)(F.lds + MISC_OFF + 2560)); for (int r_ = 0; r_ < PROBE_REPS(81); ++r_) pg8::gemm_phase<EpiMoe1, MoeGatherOrder, true, true>(F.lds, F.tid, 1024, S, E); \
        ) \
        PH(9,  \
            PHASE_BEGIN(layer); \
            const int rt = moe_tables(F, l); \
            MoeOrder S; S.rt = rt; S.nN = 4; S.G = F.G; S.c = F.bid; S.tile_e = (const LAS unsigned char*)(F.lds + MISC_OFF + 256); \
            S.A = (const char*)(ws + WS_ACT); S.B = (const char*)(ws + WS_WDN + (size_t)l * NE * 1024 * 1024 * 2); S.tstepA = S.tstepB = (size_t)256 * 1024 * 2; S.zB = (size_t)1024 * 1024 * 2; \
            EpiMoe2 E{(bf16*)(ws + WS_Y), inp(A, 28) + (size_t)l * NE * 1024}; \
            for (int r_ = 0; r_ < PROBE_REPS(91); ++r_) pg8::gemm_phase<EpiMoe2, MoeOrder, true, true>(F.lds, F.tid, 1024, S, E); \
        ) \
        PH(10,  PHASE_BEGIN(layer); for (int r_ = 0; r_ < PROBE_REPS(10); ++r_) phase_combine(F, A, l, opq_s(r_ + 1 == PROBE_REPS(10)) != 0); ) \
    }
    LAYER_BODY(0) LAYER_BODY(1) LAYER_BODY(2) LAYER_BODY(3)
#undef LAYER_BODY
#undef IN
#undef SEAM
}

extern "C" void kernel_launch(void* const* d_in, const int* in_sizes, int n_in, void* d_out, int out_size, void* d_ws, size_t ws_size, hipStream_t stream) {
    static int grid = 0;
    if (grid == 0) {
        if (n_in != 29 || out_size != SEQ * D || ws_size < WS_END) { fprintf(stderr, "kernel_launch: unexpected shapes (n_in %d, out %d, ws %zu); nothing launched\n", n_in, out_size, ws_size); grid = -1; return; }
        int dev = 0, cus = 0;
        if (hipGetDevice(&dev) != hipSuccess || hipDeviceGetAttribute(&cus, hipDeviceAttributeMultiprocessorCount, dev) != hipSuccess) { grid = -1; return; }
        if (hipFuncSetAttribute((const void*)mk_fwd, hipFuncAttributeMaxDynamicSharedMemorySize, LDS_BYTES) != hipSuccess) { fprintf(stderr, "kernel_launch: hipFuncSetAttribute failed\n"); grid = -1; return; }
        int per_cu = 0;
        if (hipOccupancyMaxActiveBlocksPerMultiprocessor(&per_cu, (const void*)mk_fwd, 512, LDS_BYTES) != hipSuccess || per_cu < 1) fprintf(stderr, "kernel_launch: occupancy query reports %d\n", per_cu);
        (void)hipGetLastError();
        grid = cus;
    }
    if (grid < 0) return;
    if (hipMemsetAsync((char*)d_ws + WS_CTL, 0, CTL_ZERO_BYTES, stream) != hipSuccess) return;
    if (hipMemsetAsync((char*)d_ws + WS_XG, 0, (size_t)NL * MAXRT * 256 * 4, stream) != hipSuccess) return;
    Args a{};
    for (int i = 0; i < 29; ++i) a.in[i] = (const float*)d_in[i];
    a.out = (float*)d_out; a.ws = (unsigned char*)d_ws;
#if MK_MULTI
    for (int ph = 0; ph < NPH; ++ph) { a.ph_lo = ph; a.ph_hi = ph + 1; hipLaunchKernelGGL(mk_fwd, dim3(grid), dim3(512), LDS_BYTES, stream, a); }
#else
    a.ph_lo = 0; a.ph_hi = NPH; hipLaunchKernelGGL(mk_fwd, dim3(grid), dim3(512), LDS_BYTES, stream, a);
#endif
}
```

```cpp
#include <hip/hip_runtime.h>
#include <cstdio>
#include <cstdint>
#ifndef MK_MULTI
#define MK_MULTI 0
#endif
namespace pg8 {
#define PG8_LAS __attribute__((address_space(3)))
typedef unsigned short bf16_t;
typedef short bf16x8 __attribute__((ext_vector_type(8)));
typedef float f32x4 __attribute__((ext_vector_type(4)));
typedef unsigned u32x4 __attribute__((ext_vector_type(4)));
constexpr int BM = 256, BK = 64, HALF = 128, HTB = HALF * BK * 2  , STAGE_BYTES = 8 * HTB, NXCD = 8, WGM = 8;

__host__ __device__ __forceinline__ int lds_byte(int r, int c) { const int st = (r >> 4) * 2 + (c >> 5), rr = r & 15, cc = c & 31, ob = rr * 64 + cc * 2; return st * 1024 + (ob ^ (((ob >> 9) & 1) << 5)); }
__host__ __device__ __forceinline__ void stage_rc(int b, int& R, int& C) { const int st = b / 1024, sb = b % 1024, swz = sb ^ (((sb >> 9) & 1) << 5); R = (st >> 1) * 16 + swz / 64; C = (st & 1) * 32 + (swz % 64) / 2; }
__host__ __device__ __forceinline__ int perm32(int rho) { const int n = rho >> 4, i = rho & 15; return 8 * (i >> 2) + 4 * n + (i & 3); }


struct Unit { int pm, pn, z; };
typedef float f32x2_t __attribute__((ext_vector_type(2)));
typedef __bf16 bf16x2_t __attribute__((ext_vector_type(2)));
__device__ __forceinline__ unsigned cvt_pk_bf16(float lo, float hi) { const f32x2_t v = {lo, hi}; return __builtin_bit_cast(unsigned, __builtin_convertvector(v, bf16x2_t)); }
template <class Epi, class Sched, bool ALIGN_EPI = false, bool SP2 = false>
__device__ __forceinline__ void gemm_phase(PG8_LAS unsigned char* lds, const int tid, const int K, const Sched& S, const Epi& E) {
    const int wid = __builtin_amdgcn_readfirstlane(tid >> 6), lane = tid & 63, wr = wid >> 2, wc = wid & 3, fr = lane & 15, fq = lane >> 4;
    const int nt = K / BK;
    unsigned voffA[2], voffB[2];
#pragma unroll
    for (int i = 0; i < 2; ++i) { int R, C; stage_rc(tid * 16 + i * 8192, R, C); const int Rb = Epi::PERM ? ((R & ~31) + perm32(R & 31)) : R;
        voffA[i] = (unsigned)(R * K + C) * 2u; voffB[i] = (unsigned)(Rb * K + C) * 2u; }
    unsigned gcu[2][2] = {{0u, 0u}, {0u, 0u}}; int gR[2] = {0, 0}, gC[2] = {0, 0};
    if constexpr (Sched::GATHER) {
#pragma unroll
        for (int i = 0; i < 2; ++i) stage_rc(tid * 16 + i * 8192, gR[i], gC[i]); }
    const size_t kstep = (size_t)(BK * 2);
    const size_t hstep = (size_t)HALF * K * 2;
    const size_t tstep = 2 * hstep;
    const unsigned ldsw = (unsigned)wid * 1024u;
    const int aoff = lds_byte(wr * 64 + fr, fq * 8), boff = lds_byte(wc * 32 + fr, fq * 8);
#define PG8_SA(b, h) (((b) * 2 + (h)) * HTB)
#define PG8_SB(b, h) ((4 + (b) * 2 + (h)) * HTB)
#define PG8_STAGE(bufoff, gbase, voff) do { _Pragma("unroll") for (int _i = 0; _i < 2; ++_i) \
        __builtin_amdgcn_global_load_lds((const unsigned*)((const char*)(gbase) + (voff)[_i]), (PG8_LAS unsigned*)(lds + (bufoff) + ldsw + _i * 8192), 16, 0, 0); } while (0)
#define PG8_STAGE_A(b, h, base, nx) do { if constexpr (Sched::GATHER) { if (nx) { unsigned gn_[2]; _Pragma("unroll") for (int i_ = 0; i_ < 2; ++i_) gn_[i_] = S.a_off(ui + 1, (h) * HALF + gR[i_]) + (unsigned)gC[i_] * 2u; PG8_STAGE(PG8_SA(b, h), base, gn_); } else PG8_STAGE(PG8_SA(b, h), base, gcu[h]); } else PG8_STAGE(PG8_SA(b, h), (base) + (h) * hstep, voffA); } while (0)
#define PG8_LDA(dst, b, h) do { _Pragma("unroll") for (int m = 0; m < 4; ++m) _Pragma("unroll") for (int k = 0; k < 2; ++k) dst[m][k] = *(const PG8_LAS bf16x8*)(lds + PG8_SA(b, h) + aoff + m * 2048 + k * 1024); } while (0)
#define PG8_LDB(dst, b, h) do { _Pragma("unroll") for (int n = 0; n < 2; ++n) _Pragma("unroll") for (int k = 0; k < 2; ++k) dst[n][k] = *(const PG8_LAS bf16x8*)(lds + PG8_SB(b, h) + boff + n * 2048 + k * 1024); } while (0)
#define PG8_MMA(ai, bj, At, Bt) do { __builtin_amdgcn_s_setprio(1); _Pragma("unroll") for (int m = 0; m < 4; ++m) _Pragma("unroll") for (int n = 0; n < 2; ++n) _Pragma("unroll") for (int k = 0; k < 2; ++k) \
        acc[ai][bj][m][n] = __builtin_amdgcn_mfma_f32_16x16x32_bf16(Bt[n][k], At[m][k], acc[ai][bj][m][n], 0, 0, 0); __builtin_amdgcn_s_setprio(0); } while (0)
#define PG8_WAIT_V(n) asm volatile("s_waitcnt vmcnt(" #n ")" ::: "memory")
#define PG8_WAIT_L(n) asm volatile("s_waitcnt lgkmcnt(" #n ")" ::: "memory")
#define PG8_BAR __builtin_amdgcn_s_barrier()
#define PG8_SCHED __builtin_amdgcn_sched_barrier(0)
    Unit cur, nxt; int ui = 0;
    if (!S.next(0, cur)) return;
    f32x4 acc[2][2][4][2];
#pragma unroll
    for (int a = 0; a < 2; ++a)
#pragma unroll
        for (int b = 0; b < 2; ++b)
#pragma unroll
            for (int m = 0; m < 4; ++m)
#pragma unroll
                for (int n = 0; n < 2; ++n) acc[a][b][m][n] = (f32x4){0.f, 0.f, 0.f, 0.f};
    bf16x8 At[4][2], B0[2][2], B1[2][2];
    const char* cA = S.a_ptr(cur); const char* cB = S.b_ptr(cur);
    if constexpr (Sched::GATHER) {
#pragma unroll
        for (int h = 0; h < 2; ++h)
#pragma unroll
            for (int i = 0; i < 2; ++i) gcu[h][i] = S.a_off(0, h * HALF + gR[i]) + (unsigned)gC[i] * 2u; }
    S.a_ready(cur);
    if constexpr (SP2) {
        PG8_STAGE(PG8_SB(0, 0), cB, voffB); PG8_STAGE(PG8_SB(0, 1), cB + hstep, voffB); PG8_STAGE_A(0, 0, cA, false); PG8_STAGE_A(0, 1, cA, false);
        if (wr == 1) PG8_BAR;
        PG8_WAIT_V(2); PG8_BAR;
        PG8_STAGE(PG8_SB(1, 0), cB + kstep, voffB); PG8_STAGE_A(1, 0, cA + kstep, false); PG8_STAGE(PG8_SB(1, 1), cB + hstep + kstep, voffB);
        PG8_WAIT_V(6); PG8_BAR;
    } else {
        PG8_STAGE(PG8_SB(0, 0), cB, voffB); PG8_STAGE_A(0, 0, cA, false); PG8_STAGE(PG8_SB(0, 1), cB + hstep, voffB); PG8_STAGE_A(0, 1, cA, false);
        if (wr == 1) PG8_BAR;
        PG8_WAIT_V(4); PG8_BAR;
        PG8_STAGE(PG8_SB(1, 0), cB + kstep, voffB); PG8_STAGE_A(1, 0, cA + kstep, false); PG8_STAGE(PG8_SB(1, 1), cB + hstep + kstep, voffB);
        PG8_WAIT_V(6); PG8_BAR;
    }
    for (;;) {
        const bool has_next = S.next(ui + 1, nxt);
        const char* nA = has_next ? S.a_ptr(nxt) : cA; const char* nB = has_next ? S.b_ptr(nxt) : cB;

        for (int t = 0; t < nt; t += 2) {
            const bool last = (t == nt - 2);
            const char* a1 = cA + (size_t)(t + 1) * kstep;
            const char* a2 = last ? nA : cA + (size_t)(t + 2) * kstep; const char* b2 = last ? nB : cB + (size_t)(t + 2) * kstep;
            const char* a3 = a2 + kstep; const char* b3 = b2 + kstep;
            if (last && has_next) S.a_ready(nxt);
            if constexpr (SP2) {
            PG8_LDB(B0, 0, 0); PG8_LDB(B1, 0, 1); PG8_SCHED; PG8_LDA(At, 0, 0); PG8_STAGE_A(1, 1, a1, false);
            PG8_WAIT_V(8); PG8_WAIT_L(0); PG8_BAR; PG8_MMA(0, 0, At, B0); PG8_MMA(0, 1, At, B1); PG8_BAR; PG8_SCHED;
            PG8_LDA(At, 0, 1); PG8_STAGE(PG8_SB(0, 0), b2, voffB); PG8_STAGE(PG8_SB(0, 1), b2 + hstep, voffB); PG8_STAGE_A(0, 0, a2, (last && has_next));
            PG8_WAIT_V(8); PG8_WAIT_L(0); PG8_BAR; PG8_MMA(1, 0, At, B0); PG8_MMA(1, 1, At, B1); PG8_BAR; PG8_SCHED;
            PG8_LDB(B0, 1, 0); PG8_LDB(B1, 1, 1); PG8_SCHED; PG8_LDA(At, 1, 0); PG8_STAGE_A(0, 1, a2, (last && has_next));
            PG8_WAIT_V(8); PG8_WAIT_L(0); PG8_BAR; PG8_MMA(0, 0, At, B0); PG8_MMA(0, 1, At, B1); PG8_BAR; PG8_SCHED;
            PG8_LDA(At, 1, 1); PG8_STAGE(PG8_SB(1, 0), b3, voffB); PG8_STAGE(PG8_SB(1, 1), b3 + hstep, voffB); PG8_STAGE_A(1, 0, a3, (last && has_next));
            PG8_WAIT_V(8); PG8_WAIT_L(0); PG8_BAR; PG8_MMA(1, 0, At, B0); PG8_MMA(1, 1, At, B1); PG8_BAR; PG8_SCHED;
            } else {
            PG8_LDB(B0, 0, 0); PG8_SCHED; PG8_LDA(At, 0, 0); PG8_STAGE_A(1, 1, a1, false);
            PG8_WAIT_L(8); PG8_BAR; PG8_WAIT_L(0); PG8_MMA(0, 0, At, B0); PG8_BAR; PG8_SCHED;
            PG8_LDB(B1, 0, 1); PG8_STAGE(PG8_SB(0, 0), b2, voffB);
            PG8_BAR; PG8_WAIT_L(0); PG8_MMA(0, 1, At, B1); PG8_BAR;
            PG8_LDA(At, 0, 1); PG8_STAGE_A(0, 0, a2, (last && has_next));
            PG8_BAR; PG8_WAIT_L(0); PG8_MMA(1, 0, At, B0); PG8_BAR; PG8_SCHED;
            PG8_STAGE(PG8_SB(0, 1), b2 + hstep, voffB);
            PG8_WAIT_V(6); PG8_BAR; PG8_MMA(1, 1, At, B1); PG8_BAR;
            PG8_LDB(B0, 1, 0); PG8_SCHED; PG8_LDA(At, 1, 0); PG8_STAGE_A(0, 1, a2, (last && has_next));
            PG8_WAIT_L(8); PG8_BAR; PG8_WAIT_L(0); PG8_MMA(0, 0, At, B0); PG8_BAR; PG8_SCHED;
            PG8_LDB(B1, 1, 1); PG8_STAGE(PG8_SB(1, 0), b3, voffB);
            PG8_BAR; PG8_WAIT_L(0); PG8_MMA(0, 1, At, B1); PG8_BAR;
            PG8_LDA(At, 1, 1); PG8_STAGE_A(1, 0, a3, (last && has_next));
            PG8_BAR; PG8_WAIT_L(0); PG8_MMA(1, 0, At, B0); PG8_BAR; PG8_SCHED;
            PG8_STAGE(PG8_SB(1, 1), b3 + hstep, voffB);
            PG8_WAIT_V(6); PG8_BAR; PG8_MMA(1, 1, At, B1); PG8_BAR;
            }
        }
        if constexpr (ALIGN_EPI) { if (wr == 0) PG8_BAR; }
        bool keep_acc = false;
        if constexpr (Epi::CHAIN) { keep_acc = E.chain(acc, cur, wr, wc, fr, fq); S.done(cur); }
        else if constexpr (!Epi::AFTER_DRAIN) { E(acc, cur, wr, wc, fr, fq); S.done(cur); }
        if (!has_next) break;
        if (!keep_acc) {
#pragma unroll
        for (int a = 0; a < 2; ++a)
#pragma unroll
            for (int b = 0; b < 2; ++b)
#pragma unroll
                for (int m = 0; m < 4; ++m)
#pragma unroll
                    for (int n = 0; n < 2; ++n) acc[a][b][m][n] = (f32x4){0.f, 0.f, 0.f, 0.f};
        }
        cur = nxt; cA = nA; cB = nB; ++ui;
        if constexpr (Sched::GATHER) {
#pragma unroll
            for (int h = 0; h < 2; ++h)
#pragma unroll
                for (int i = 0; i < 2; ++i) gcu[h][i] = S.a_off(ui, h * HALF + gR[i]) + (unsigned)gC[i] * 2u; }
        if constexpr (ALIGN_EPI) { if (wr == 1) PG8_BAR; }
    }
    PG8_WAIT_V(0);
    if constexpr (!ALIGN_EPI) { if (wr == 0) PG8_BAR; }
    PG8_BAR;
    if constexpr (Epi::AFTER_DRAIN) { E.fused(acc, cur, wr, wc, fr, fq, lds, wid, lane); S.done(cur); }
#undef PG8_SA
#undef PG8_SB
#undef PG8_STAGE
#undef PG8_STAGE_A
#undef PG8_LDA
#undef PG8_LDB
#undef PG8_MMA
#undef PG8_WAIT_V
#undef PG8_WAIT_L
#undef PG8_BAR
#undef PG8_SCHED
}
}

constexpr int NL = 4, D = 1024, SEQ = 16384, CTX = 256, T = SEQ + CTX;
constexpr int IN_COLS = 7472, NIN = 7680;
constexpr int PC_AQ = 0, PC_AK = 512, PC_AV = 1024, PC_AZ = 1536, PC_BQ = 2048, PC_BK = 2304, PC_BV = 2560, PC_BZ = 3072, PC_CQ = 3584, PC_CK = 4096, PC_CV = 4224, PC_GL = 4352, PC_SM = 7424;
constexpr int NE = 32, TOPK = 4, DFF = 1024, MAXRT = 292;
constexpr float EPS = 1e-6f;
constexpr int NPH_PRO = 2, NPH_LAYER = 11, NPH = NPH_PRO + NL * NPH_LAYER;

constexpr size_t MiB = 1u << 20;
constexpr size_t WS_CTL = 0, CTL_ZERO_BYTES = 1 * MiB;
constexpr size_t WS_MOD = 1 * MiB;
constexpr size_t WS_ROPE = 1 * MiB + 512 * 1024;
constexpr size_t WS_WIN = 2 * MiB;
constexpr size_t WS_WBR = 62 * MiB;
constexpr size_t WS_WO = 74 * MiB;
constexpr size_t WS_WGU = 82 * MiB;
constexpr size_t WS_WDN = 594 * MiB;
constexpr size_t WS_XS = 850 * MiB;
constexpr size_t WS_H = 915 * MiB;
constexpr size_t WS_P = 948 * MiB;
constexpr size_t WS_SM = 1192 * MiB;
constexpr size_t WS_DQ = 1197 * MiB, WS_DK = 1230 * MiB, WS_DV = 1263 * MiB;
constexpr size_t WS_DG = 1296 * MiB, WS_DB = 1297 * MiB;
constexpr size_t WS_GK = 1298 * MiB;
constexpr size_t WS_DO = 1331 * MiB, WS_GO = 1396 * MiB;
constexpr size_t WS_YABC = 1461 * MiB, YSTRIDE = (size_t)T * 512 * 2;
constexpr size_t WS_MF = 1510 * MiB;
constexpr size_t WS_MG = 1575 * MiB;
constexpr size_t WS_RT = 1608 * MiB;
constexpr size_t WS_XG = 1610 * MiB, WS_ACT = 1756 * MiB, WS_Y = 1902 * MiB;
constexpr size_t WS_QH = 2048 * MiB;
constexpr size_t WS_GG = 2066 * MiB;
constexpr size_t WS_GD = 2131 * MiB;
constexpr size_t WS_ST = 2132 * MiB;
constexpr size_t WS_DF = 2165 * MiB;
constexpr size_t WS_DU = 2280 * MiB;
constexpr size_t WS_DGT = 2345 * MiB;
constexpr size_t WS_DSN = 1298 * MiB;
constexpr int DSN_BYTES = 49152, DSN_V = 32768;
constexpr size_t WS_WRT = 2346 * MiB;
constexpr size_t WS_HLO = 2347 * MiB;
constexpr size_t WS_QN = WS_DQ, WS_KN = WS_DK;
constexpr size_t WS_END = 2400 * MiB;
constexpr int DF_NW = 0, DF_QD = 16384, DF_QK = 32768, DF_KDT = 40960, DF_BYTES = 57344;
constexpr int CW_BAR = 4096, CW_CNT = 16384;

constexpr int RING_BYTES = 131072, MISC_OFF = RING_BYTES, LDS_BYTES = 163840;

#define GAS __attribute__((address_space(1)))
#define LAS __attribute__((address_space(3)))
typedef unsigned short bf16;
typedef unsigned v4u __attribute__((ext_vector_type(4)));
typedef unsigned v2u __attribute__((ext_vector_type(2)));
typedef float f32x4 __attribute__((ext_vector_type(4)));
typedef short bf16x8 __attribute__((ext_vector_type(8)));
#define LDS_WAIT() asm volatile("s_waitcnt lgkmcnt(0)" ::: "memory")
using pg8::cvt_pk_bf16; using pg8::Unit;
__device__ __forceinline__ float bf_lo(unsigned u) { return __uint_as_float(u << 16); }
__device__ __forceinline__ float bf_hi(unsigned u) { return __uint_as_float(u & 0xffff0000u); }
__device__ __forceinline__ float bf2f(bf16 b) { return __uint_as_float((unsigned)b << 16); }
template <int CTRL> __device__ __forceinline__ float dppf(float v) { return __builtin_bit_cast(float, __builtin_amdgcn_update_dpp(0, __builtin_bit_cast(int, v), CTRL, 0xf, 0xf, true)); }
template <int CTRL> __device__ __forceinline__ int dppi(int v) { return __builtin_amdgcn_update_dpp(0, v, CTRL, 0xf, 0xf, true); }
__device__ __forceinline__ float row_sum4(float v) { v += dppf<0xB1>(v); v += dppf<0x4E>(v); return v; }
__device__ __forceinline__ float row_sum8(float v) { v = row_sum4(v); v += dppf<0x141>(v); return v; }
__device__ __forceinline__ float row_sum16(float v) { v = row_sum8(v); v += dppf<0x140>(v); return v; }
__device__ __forceinline__ float row_max16(float v) { v = fmaxf(v, dppf<0xB1>(v)); v = fmaxf(v, dppf<0x4E>(v)); v = fmaxf(v, dppf<0x141>(v)); v = fmaxf(v, dppf<0x140>(v)); return v; }
__device__ __forceinline__ int row_min16(int v) { v = min(v, dppi<0xB1>(v)); v = min(v, dppi<0x4E>(v)); v = min(v, dppi<0x141>(v)); v = min(v, dppi<0x140>(v)); return v; }
__device__ __forceinline__ float wave_sum(float v) { v = row_sum16(v);
    return (__builtin_bit_cast(float, __builtin_amdgcn_readlane(__builtin_bit_cast(int, v), 0)) + __builtin_bit_cast(float, __builtin_amdgcn_readlane(__builtin_bit_cast(int, v), 16))) + (__builtin_bit_cast(float, __builtin_amdgcn_readlane(__builtin_bit_cast(int, v), 32)) + __builtin_bit_cast(float, __builtin_amdgcn_readlane(__builtin_bit_cast(int, v), 48))); }
__device__ __forceinline__ float wave_max(float v) { v = row_max16(v);
    return fmaxf(fmaxf(__builtin_bit_cast(float, __builtin_amdgcn_readlane(__builtin_bit_cast(int, v), 0)), __builtin_bit_cast(float, __builtin_amdgcn_readlane(__builtin_bit_cast(int, v), 16))), fmaxf(__builtin_bit_cast(float, __builtin_amdgcn_readlane(__builtin_bit_cast(int, v), 32)), __builtin_bit_cast(float, __builtin_amdgcn_readlane(__builtin_bit_cast(int, v), 48)))); }
__device__ __forceinline__ float fexp2(float x) { return __builtin_amdgcn_exp2f(x); }
__device__ __forceinline__ float fexp(float x) { return __builtin_amdgcn_exp2f(x * 1.4426950408889634f); }
__device__ __forceinline__ float flog(float x) { return __builtin_amdgcn_logf(x) * 0.6931471805599453f; }
__device__ __forceinline__ float sigmoid_f(float x) { return __builtin_amdgcn_rcpf(1.0f + fexp(-x)); }
__device__ __forceinline__ float softplus_f(float x) { return fmaxf(x, 0.f) + flog(1.0f + fexp(-fabsf(x))); }


#ifndef PROBE_KIND
#define PROBE_KIND -1
#endif
#ifndef PROBE_N
#define PROBE_N 0
#endif
__device__ __forceinline__ int opq_s(int v);
#define PROBE_REPS(k) (((k) == PROBE_KIND) ? opq_s(PROBE_N + 1) : 1)
#define XB_TMO      128
#define XB_XCNT(j)  (256  + 64 * (j))
#define XB_XSUB(j)  (1280 + 64 * (j))
#define XB_XGEN(j)  (2304 + 64 * (j))
#define XB_TOP      3328
#define XB_TOPGEN   3392
#define XCD_BAR_WORDS 3456
#define XB_SPIN_CAP (1u << 18)

__device__ __forceinline__ unsigned xb_ld(unsigned* p)              { return __hip_atomic_load(p, __ATOMIC_RELAXED, __HIP_MEMORY_SCOPE_AGENT); }
__device__ __forceinline__ unsigned xb_add(unsigned* p, unsigned v) { return __hip_atomic_fetch_add(p, v, __ATOMIC_RELAXED, __HIP_MEMORY_SCOPE_AGENT); }
__device__ __forceinline__ unsigned xb_xcc_id() { return (unsigned)__builtin_amdgcn_s_getreg((3 << 11) | 20) & 0xFu; }
#define XB_SPIN(cond, bar) do { unsigned _sp = 0; while (cond) { __builtin_amdgcn_s_sleep(1); \
    if ((++_sp & 255u) == 0u) { if (xb_ld(&(bar)[XB_TMO])) break; if (_sp > XB_SPIN_CAP) { atomicAdd(&(bar)[XB_TMO], 1u); break; } } } } while (0)

struct XcdBarrier {
    bool lead;
    unsigned* bar; unsigned x;
    volatile LAS unsigned* st;
};

__device__ __forceinline__ XcdBarrier xcd_barrier_post(unsigned* bar, volatile LAS unsigned* st, bool lead) {
    XcdBarrier b; b.lead = lead; b.bar = bar; b.x = xb_xcc_id(); b.st = st;
    if (lead) (void)xb_add(&bar[XB_XCNT(b.x)], 1u);
    return b;
}
__device__ __forceinline__ void xcd_barrier_complete(unsigned* bar, unsigned x, unsigned& nloc, unsigned& nx) {
    const unsigned G = gridDim.x * gridDim.y * gridDim.z;
    unsigned sum, cnt, mine, sp = 0u;
    for (;;) {
        sum = 0u; cnt = 0u; mine = 0u;
#pragma unroll
        for (unsigned j = 0; j < 16; ++j) { const unsigned c = xb_ld(&bar[XB_XCNT(j)]); sum += c; cnt += (c > 0u) ? 1u : 0u; mine = (j == x) ? c : mine; }
        if (sum == G) break;
        __builtin_amdgcn_s_sleep(1);
        if ((++sp & 255u) == 0u) { if (xb_ld(&bar[XB_TMO])) break; if (sp > XB_SPIN_CAP) { atomicAdd(&bar[XB_TMO], 1u); break; } }
    }
    nloc = mine > 0u ? mine : 1u; nx = cnt > 0u ? cnt : 1u;
}

__device__ __forceinline__ void xcd_barrier(const XcdBarrier& b) {
    asm volatile("s_waitcnt vmcnt(0)" ::: "memory");
    __syncthreads();
    if (b.lead) {
        unsigned* bar = b.bar;
        __builtin_amdgcn_s_waitcnt(0);
        unsigned nloc = b.st[0], nx = b.st[1];
        if (nloc == 0u) { xcd_barrier_complete(bar, b.x, nloc, nx); b.st[0] = nloc; b.st[1] = nx; }
        const unsigned old = xb_add(&bar[XB_XSUB(b.x)], 1u);
        const unsigned gen = old / nloc;
        if (old + 1u == (gen + 1u) * nloc) {
            __builtin_amdgcn_fence(__ATOMIC_RELEASE, "agent");
            asm volatile("s_waitcnt vmcnt(0)" ::: "memory");
            const unsigned og = xb_add(&bar[XB_TOP], 1u);
            const unsigned tg = og / nx;
            if (og + 1u == (tg + 1u) * nx) xb_add(&bar[XB_TOPGEN], 1u);
            else XB_SPIN(xb_ld(&bar[XB_TOPGEN]) == tg, bar);
            __builtin_amdgcn_fence(__ATOMIC_ACQUIRE, "agent");
            xb_add(&bar[XB_XGEN(b.x)], 1u);
            asm volatile("s_waitcnt vmcnt(0)" ::: "memory");
        } else {
            XB_SPIN(xb_ld(&bar[XB_XGEN(b.x)]) == gen, bar);
            __builtin_amdgcn_fence(__ATOMIC_ACQUIRE, "agent");
            asm volatile("s_waitcnt vmcnt(0)" ::: "memory");
        }
    }
    __syncthreads();
}

struct Args { const float* in[29]; float* out; unsigned char* ws; int ph_lo, ph_hi; };
typedef const __attribute__((address_space(4))) Args* ArgsP;
__device__ __forceinline__ const float* inp(ArgsP a, int k) { return (const float*)(const GAS float*)a->in[k]; }
__device__ __forceinline__ float* outp(ArgsP a) { return (float*)(GAS float*)a->out; }
struct Frame {
    LAS unsigned char* lds;
    unsigned* ctl;
    int tid, lane, wave, G, bid;
    unsigned char* ws;
};

struct TileOrder {
    static constexpr bool GATHER = false; __device__ __forceinline__ unsigned a_off(int, int) const { return 0u; }
    int nM, nN, nwg, G, c, pm0; const char* A; const char* B; size_t tstepA, tstepB;
    __device__ __forceinline__ void init(int nM_, int nN_, int G_, int c_, const void* A_, const void* B_, int K, int pm0_ = 0) { nM = nM_; nN = nN_; nwg = nM * nN; G = G_; c = c_; pm0 = pm0_; A = (const char*)A_; B = (const char*)B_; tstepA = tstepB = (size_t)256 * K * 2; }
    __device__ __forceinline__ void map(int wgid, Unit& u) const {
        { const int q = nwg / pg8::NXCD, r = nwg % pg8::NXCD, xcd = wgid % pg8::NXCD, off = wgid / pg8::NXCD; wgid = (xcd < r ? xcd * (q + 1) : r * (q + 1) + (xcd - r) * q) + off; }
        const int nig = pg8::WGM * nN, gid = wgid / nig, fm = gid * pg8::WGM, gsz = (nM - fm) < pg8::WGM ? (nM - fm) : pg8::WGM;
        u.pm = pm0 + fm + ((wgid % nig) % gsz); u.pn = (wgid % nig) / gsz;
    }
    __device__ __forceinline__ bool next(int i, Unit& u) const { const long L = (long)i * G + c; if (L >= nwg) return false; map((int)L, u); u.z = 0; return true; }
    __device__ __forceinline__ const char* a_ptr(const Unit& u) const { return A + (size_t)u.pm * tstepA; }
    __device__ __forceinline__ const char* b_ptr(const Unit& u) const { return B + (size_t)u.pn * tstepB; }
    __device__ __forceinline__ void a_ready(const Unit&) const {}
    __device__ __forceinline__ void done(const Unit&) const {}
};
struct BranchOrder : TileOrder {
    size_t zA, zB;
    __device__ __forceinline__ bool next(int i, Unit& u) const { const long L = (long)(i / 3) * G + c; if (L >= nwg) return false; map((int)L, u); u.z = i % 3; return true; }
    __device__ __forceinline__ const char* a_ptr(const Unit& u) const { return A + (size_t)u.z * zA + (size_t)u.pm * tstepA; }
    __device__ __forceinline__ const char* b_ptr(const Unit& u) const { return B + (size_t)u.z * zB + (size_t)u.pn * tstepB; }
};
template <bool GATHER_> struct MoeOrderT {
    static constexpr bool GATHER = GATHER_;
    const LAS int* gidx; unsigned rowbytes;
    __device__ __forceinline__ unsigned a_off(int ui, int row) const { return (unsigned)gidx[ui * 256 + row] * rowbytes; }
    int rt, nN, G, c; const LAS unsigned char* tile_e; const char* A; const char* B; size_t tstepA, tstepB, zB;
    __device__ __forceinline__ bool next(int i, Unit& u) const {
        if ((G & 7) != 0) { const long L = (long)i * G + c; if (L >= (long)rt * nN) return false; u.pm = (int)(L / nN); u.pn = (int)(L % nN); }
        else { const int x = c & 7, cx = c >> 3, gx = G >> 3, lo = (rt * x) >> 3, hi = (rt * (x + 1)) >> 3; const int Lx = i * gx + cx; if (Lx >= (hi - lo) * nN) return false; u.pm = lo + Lx / nN; u.pn = Lx % nN; }
        u.z = __builtin_amdgcn_readfirstlane((int)tile_e[u.pm]); return true; }
    __device__ __forceinline__ const char* a_ptr(const Unit& u) const { return GATHER_ ? A : A + (size_t)u.pm * tstepA; }
    __device__ __forceinline__ const char* b_ptr(const Unit& u) const { return B + (size_t)u.z * zB + (size_t)u.pn * tstepB; }
    __device__ __forceinline__ void a_ready(const Unit&) const {}
    __device__ __forceinline__ void done(const Unit&) const {}
};
typedef MoeOrderT<false> MoeOrder; typedef MoeOrderT<true> MoeGatherOrder;

typedef const pg8::f32x4 (&AccRef)[2][2][4][2];
struct EpiIn {
    static constexpr bool PERM = true, AFTER_DRAIN = false, CHAIN = false;
    bf16* P; float* SM;
    __device__ __forceinline__ void operator()(AccRef acc, const Unit& u, int wr, int wc, int fr, int fq) const {
        const int row0 = u.pm * 256 + wr * 64 + fr, pn = u.pn;
        if (pn == 29) {
            if (wc == 0 || (wc == 1 && fq < 2)) {
#pragma unroll
                for (int ai = 0; ai < 2; ++ai)
#pragma unroll
                    for (int m = 0; m < 4; ++m) { float* rp = SM + (size_t)(row0 + ai * 128 + m * 16) * 64 + wc * 32 + 8 * fq;
                        *(f32x4*)(rp) = acc[ai][0][m][0]; *(f32x4*)(rp + 4) = acc[ai][0][m][1]; }
            }
            return;
        }
        const int kind = (pn <= 5) ? 0 : (pn <= 7) ? 1 : (pn == 8) ? 3 : (pn <= 11) ? 0 : (pn <= 13) ? 1 : (pn <= 16) ? 0 : 2;
#pragma unroll
        for (int ai = 0; ai < 2; ++ai)
#pragma unroll
            for (int m = 0; m < 4; ++m) { bf16* rowp = P + (size_t)(row0 + ai * 128 + m * 16) * NIN + pn * 256 + wc * 32 + 8 * fq;
#pragma unroll
                for (int bj = 0; bj < 2; ++bj) { f32x4 v0 = acc[ai][bj][m][0], v1 = acc[ai][bj][m][1];
                    if (kind == 1) {
#pragma unroll
                        for (int j = 0; j < 4; ++j) { v0[j] = v0[j] * sigmoid_f(v0[j]); v1[j] = v1[j] * sigmoid_f(v1[j]); } }
                    else if (kind == 2) {
#pragma unroll
                        for (int j = 0; j < 4; ++j) { v0[j] = sigmoid_f(v0[j]); v1[j] = sigmoid_f(v1[j]); } }
                    else if (kind == 3) { v0 = v0 * 0.125f; v1 = v1 * 0.125f; }
                    v4u w; w.x = cvt_pk_bf16(v0[0], v0[1]); w.y = cvt_pk_bf16(v0[2], v0[3]); w.z = cvt_pk_bf16(v1[0], v1[1]); w.w = cvt_pk_bf16(v1[2], v1[3]);
                    *(v4u*)(rowp + bj * 128) = w; } }
    }
};
struct EpiBranch {
    static constexpr bool PERM = false, AFTER_DRAIN = false, CHAIN = true;
    const bf16* P; bf16* MG;
    __device__ __forceinline__ bool chain(pg8::f32x4 (&acc)[2][2][4][2], const Unit& u, int wr, int wc, int fr, int fq) const {
        const int row0 = u.pm * 256 + wr * 64 + fr, col0 = u.pn * 256 + wc * 32 + 4 * fq, z = u.z;
#pragma unroll
        for (int ai = 0; ai < 2; ++ai)
#pragma unroll
            for (int m = 0; m < 4; ++m) { const unsigned row = (unsigned)(row0 + ai * 128 + m * 16);
#pragma unroll
                for (int bj = 0; bj < 2; ++bj)
#pragma unroll
                    for (int n = 0; n < 2; ++n) { const int col = col0 + bj * 128 + n * 16;
                        const v2u gw = *(const v2u*)(P + (row * (unsigned)NIN + PC_GL + z * 1024 + col));
                        f32x4 g = (f32x4){bf_lo(gw.x), bf_hi(gw.x), bf_lo(gw.y), bf_hi(gw.y)};
                        if (z < 2) { const v2u gn = *(const v2u*)(P + (row * (unsigned)NIN + PC_GL + (z + 1) * 1024 + col));
                            g[0] *= __builtin_amdgcn_rcpf(fmaxf(bf_lo(gn.x), 1e-30f)); g[1] *= __builtin_amdgcn_rcpf(fmaxf(bf_hi(gn.x), 1e-30f)); g[2] *= __builtin_amdgcn_rcpf(fmaxf(bf_lo(gn.y), 1e-30f)); g[3] *= __builtin_amdgcn_rcpf(fmaxf(bf_hi(gn.y), 1e-30f));
                            acc[ai][bj][m][n] = acc[ai][bj][m][n] * g; }
                        else { const f32x4 v = acc[ai][bj][m][n] * g; v2u o; o.x = cvt_pk_bf16(v[0], v[1]); o.y = cvt_pk_bf16(v[2], v[3]); *(v2u*)(MG + (row * 1024u + col)) = o; } } }
        return z < 2;
    }
    __device__ __forceinline__ void operator()(AccRef, const Unit&, int, int, int, int) const {}
};
struct EpiWo {
    static constexpr bool PERM = false, AFTER_DRAIN = false, CHAIN = false;
    float* XS; const float* modl; const float* modc; bool commit;
    __device__ __forceinline__ void operator()(AccRef acc, const Unit& u, int wr, int wc, int fr, int fq) const {
        const int row0 = u.pm * 256 + wr * 64 + fr, col0 = u.pn * 256 + wc * 32 + 4 * fq; const float* mv = (u.pm == 0) ? modc : modl;
#pragma unroll
        for (int bj = 0; bj < 2; ++bj)
#pragma unroll
            for (int n = 0; n < 2; ++n) { const int col = col0 + bj * 128 + n * 16; const f32x4 g = *(const f32x4*)(mv + col);
#pragma unroll
                for (int ai = 0; ai < 2; ++ai)
#pragma unroll
                    for (int m = 0; m < 4; ++m) { float* xp = XS + (size_t)(row0 + ai * 128 + m * 16) * 1024 + col; const f32x4 v = *(const f32x4*)xp + g * acc[ai][bj][m][n]; if (commit) *(f32x4*)xp = v; else if (v[0] == 1.2345e30f) *xp = 0.f; } }
    }
};
struct EpiMoe1 {
    static constexpr bool PERM = true, AFTER_DRAIN = false, CHAIN = false;
    bf16* ACT; const float* bgu;
    __device__ __forceinline__ void operator()(AccRef acc, const Unit& u, int wr, int wc, int fr, int fq) const {
        const int row0 = u.pm * 256 + wr * 64 + fr, c0 = u.pn * 128 + wc * 32 + 8 * fq; const float* be = bgu + (size_t)u.z * 2048;
        const f32x4 bg0 = *(const f32x4*)(be + c0), bg1 = *(const f32x4*)(be + c0 + 4), bu0 = *(const f32x4*)(be + 1024 + c0), bu1 = *(const f32x4*)(be + 1024 + c0 + 4);
#pragma unroll
        for (int ai = 0; ai < 2; ++ai)
#pragma unroll
            for (int m = 0; m < 4; ++m) { f32x4 g0 = acc[ai][0][m][0] + bg0, g1 = acc[ai][0][m][1] + bg1, u0 = acc[ai][1][m][0] + bu0, u1 = acc[ai][1][m][1] + bu1; f32x4 o0, o1;
#pragma unroll
                for (int j = 0; j < 4; ++j) { float g = fminf(g0[j], 7.0f), uu = fminf(fmaxf(u0[j], -7.0f), 7.0f); o0[j] = (uu + 1.0f) * (g * sigmoid_f(1.702f * g));
                    g = fminf(g1[j], 7.0f); uu = fminf(fmaxf(u1[j], -7.0f), 7.0f); o1[j] = (uu + 1.0f) * (g * sigmoid_f(1.702f * g)); }
                v4u w; w.x = cvt_pk_bf16(o0[0], o0[1]); w.y = cvt_pk_bf16(o0[2], o0[3]); w.z = cvt_pk_bf16(o1[0], o1[1]); w.w = cvt_pk_bf16(o1[2], o1[3]);
                *(v4u*)(ACT + (size_t)(row0 + ai * 128 + m * 16) * 1024 + c0) = w; }
    }
};
struct EpiMoe2 {
    static constexpr bool PERM = true, AFTER_DRAIN = false, CHAIN = false;
    bf16* Y; const float* bdn;
    __device__ __forceinline__ void operator()(AccRef acc, const Unit& u, int wr, int wc, int fr, int fq) const {
        const int row0 = u.pm * 256 + wr * 64 + fr, c0 = u.pn * 256 + wc * 32 + 8 * fq; const float* be = bdn + (size_t)u.z * 1024;
#pragma unroll
        for (int bj = 0; bj < 2; ++bj) { const f32x4 b0 = *(const f32x4*)(be + c0 + bj * 128), b1 = *(const f32x4*)(be + c0 + bj * 128 + 4);
#pragma unroll
            for (int ai = 0; ai < 2; ++ai)
#pragma unroll
                for (int m = 0; m < 4; ++m) { const f32x4 v0 = acc[ai][bj][m][0] + b0, v1 = acc[ai][bj][m][1] + b1;
                    v4u w; w.x = cvt_pk_bf16(v0[0], v0[1]); w.y = cvt_pk_bf16(v0[2], v0[3]); w.z = cvt_pk_bf16(v1[0], v1[1]); w.w = cvt_pk_bf16(v1[2], v1[3]);
                    *(v4u*)(Y + (size_t)(row0 + ai * 128 + m * 16) * 1024 + c0 + bj * 128) = w; } }
    }
};

__device__ __forceinline__ void transpose_item(const float* W, int N, int K, bf16* WT, int k0, int src0, int dst0, int nvalid, LAS float* scr, int lane) {
    const int n = lane & 31;
    float v[32];
#pragma unroll
    for (int i = 0; i < 32; ++i) { const int kk = 2 * i + (lane >> 5); v[i] = (n < nvalid) ? W[(size_t)(k0 + kk) * N + src0 + n] : 0.f; }
    __builtin_amdgcn_sched_barrier(0);
#pragma unroll
    for (int i = 0; i < 32; ++i) { const int kk = 2 * i + (lane >> 5); scr[kk * 33 + n] = v[i]; }
    LDS_WAIT(); asm volatile("" ::: "memory");
    const int c = lane & 7;
#pragma unroll
    for (int j = 0; j < 4; ++j) { const int nn = (lane >> 3) + 8 * j; const LAS float* s = scr + (8 * c) * 33 + nn;
        v4u o; o.x = cvt_pk_bf16(s[0 * 33], s[1 * 33]); o.y = cvt_pk_bf16(s[2 * 33], s[3 * 33]); o.z = cvt_pk_bf16(s[4 * 33], s[5 * 33]); o.w = cvt_pk_bf16(s[6 * 33], s[7 * 33]);
        if (nn < nvalid) *(v4u*)(WT + (size_t)(dst0 + nn) * K + k0 + 8 * c) = o; }
    LDS_WAIT(); asm volatile("" ::: "memory");
}
constexpr int I_IN_L = 16 * 234, I_BR_L = 3 * 8 * 32, I_WO_L = 16 * 32, I_SMALL_L = I_IN_L + I_BR_L + I_WO_L;
__device__ __forceinline__ void convert_small_item(Frame& F, ArgsP a, int l, int r, LAS float* scr) {
    bf16* WIN = (bf16*)(F.ws + WS_WIN); bf16* WBR = (bf16*)(F.ws + WS_WBR); bf16* WO = (bf16*)(F.ws + WS_WO);
    if (r < I_IN_L) { const int kb = r / 234, nb = r % 234; int src, dst, nv = 32;
        if (nb < 64) { src = 32 * nb; dst = 32 * nb; }
        else if (nb < 80) { src = 2064 + 32 * (nb - 64); dst = 2048 + 32 * (nb - 64); }
        else if (nb < 112) { src = 2576 + 32 * (nb - 80); dst = 2560 + 32 * (nb - 80); }
        else if (nb < 136) { src = 3632 + 32 * (nb - 112); dst = 3584 + 32 * (nb - 112); }
        else if (nb < 232) { src = 4400 + 32 * (nb - 136); dst = 4352 + 32 * (nb - 136); }
        else if (nb == 232) { src = 2048; dst = 7424; nv = 16; }
        else { src = 3600; dst = 7440; }
        transpose_item(inp(a, 8) + (size_t)l * 1024 * IN_COLS, IN_COLS, 1024, WIN + (size_t)l * NIN * 1024, kb * 64, src, dst, nv, scr, F.lane); return; }
    r -= I_IN_L;
    if (r < I_BR_L) { const int z = r / 256, q = r % 256, kb = q / 32, nb = q % 32;
        transpose_item(inp(a, 19 + z) + (size_t)l * 512 * 1024, 1024, 512, WBR + (size_t)(l * 3 + z) * 1024 * 512, kb * 64, 32 * nb, 32 * nb, 32, scr, F.lane); return; }
    r -= I_BR_L;
    { const int kb = r / 32, nb = r % 32;
        transpose_item(inp(a, 22) + (size_t)l * 1024 * 1024, 1024, 1024, WO + (size_t)l * 1024 * 1024, kb * 64, 32 * nb, 32 * nb, 32, scr, F.lane); }
}
__device__ __forceinline__ void phase_prologue(Frame& F, ArgsP a) {
    {
        LAS float* sc = (LAS float*)F.lds; LAS float* part = sc + 2048;
        for (int i = F.tid; i < 2048; i += 512) { const float v = (i < 1024) ? inp(a, 1)[i] : inp(a, 3)[i - 1024]; sc[i] = v * sigmoid_f(v); }
        __syncthreads();
        float* MOD = (float*)(F.ws + WS_MOD);
        for (int bi = F.bid; bi < NL * 96; bi += F.G) {
            const int l = bi / 96, jb = bi % 96, cl = F.tid & 63, seg = F.tid >> 6;
            const float* W = inp(a, 4) + (size_t)l * 1024 * 6144 + jb * 64 + cl;
            float a0 = 0.f, a1 = 0.f;
#pragma unroll 8
            for (int k = seg * 128; k < seg * 128 + 128; ++k) { const float w = W[(size_t)k * 6144]; a0 += sc[k] * w; a1 += sc[1024 + k] * w; }
            part[(seg * 64 + cl) * 2] = a0; part[(seg * 64 + cl) * 2 + 1] = a1;
            __syncthreads();
            if (F.tid < 128) { const int c = F.tid & 63, s = F.tid >> 6; float sum = inp(a, 5)[l * 6144 + jb * 64 + c];
                for (int g = 0; g < 8; ++g) sum += part[(g * 64 + c) * 2 + s];
                MOD[(size_t)(l * 2 + s) * 6144 + jb * 64 + c] = sum; }
            __syncthreads();
        }
    }
    for (int i = F.bid * 512 + F.tid; i < 256 * 16; i += F.G * 512) { const float inv = exp2f(-(float)(i & 15) * (13.287712379549449f / 16.0f)); float sn, cs; sincosf((float)(i >> 4) * inv, &sn, &cs);
        float* rp = (float*)(F.ws + WS_ROPE) + (size_t)i * 2; rp[0] = cs; rp[1] = sn; }
    __syncthreads();
    for (int i = F.bid * 512 + F.tid; i < NL * 32 * 1024; i += F.G * 512) { const int l = i >> 15, e = (i >> 10) & 31, c = i & 1023; const float w = inp(a, 23)[(size_t)l * 32768 + c * 32 + e];
        const unsigned hi = cvt_pk_bf16(w, 0.f) & 0xffffu; const float lo = w - __uint_as_float(hi << 16);
        bf16* wr = (bf16*)(F.ws + WS_WRT) + (size_t)l * 65536 + e * 1024 + c; wr[0] = (bf16)hi; wr[32768] = (bf16)(cvt_pk_bf16(lo, 0.f) & 0xffffu); }
    LAS float* scr = (LAS float*)(F.lds + F.wave * 16384);
    const int gw = F.bid * 8 + F.wave, NGW = F.G * 8;
    bf16* WIN = (bf16*)(F.ws + WS_WIN); bf16* WBR = (bf16*)(F.ws + WS_WBR); bf16* WO = (bf16*)(F.ws + WS_WO); bf16* WGU = (bf16*)(F.ws + WS_WGU); bf16* WDN = (bf16*)(F.ws + WS_WDN);
    constexpr int I_IN = 16 * 234, I_BR = 8 * 32, I_WO = 16 * 32, I_GU = 16 * 64, I_DN = 16 * 32;
    constexpr int N_IN = NL * I_IN, N_BR = NL * 3 * I_BR, N_WO = NL * I_WO, N_GU = NL * NE * I_GU, N_DN = NL * NE * I_DN;
    if (F.G >= 160) { for (int it = gw; it < I_IN_L; it += NGW) convert_small_item(F, a, 0, it, scr); }
    else for (int it = gw; it < N_IN + N_BR + N_WO + N_GU + N_DN; it += NGW) {
        int r = it;
        if (r < N_IN) { const int l = r / I_IN; r %= I_IN; const int kb = r / 234, nb = r % 234; int src, dst, nv = 32;
            if (nb < 64) { src = 32 * nb; dst = 32 * nb; }
            else if (nb < 80) { src = 2064 + 32 * (nb - 64); dst = 2048 + 32 * (nb - 64); }
            else if (nb < 112) { src = 2576 + 32 * (nb - 80); dst = 2560 + 32 * (nb - 80); }
            else if (nb < 136) { src = 3632 + 32 * (nb - 112); dst = 3584 + 32 * (nb - 112); }
            else if (nb < 232) { src = 4400 + 32 * (nb - 136); dst = 4352 + 32 * (nb - 136); }
            else if (nb == 232) { src = 2048; dst = 7424; nv = 16; }
            else { src = 3600; dst = 7440; }
            transpose_item(inp(a, 8) + (size_t)l * 1024 * IN_COLS, IN_COLS, 1024, WIN + (size_t)l * NIN * 1024, kb * 64, src, dst, nv, scr, F.lane); continue; }
        r -= N_IN;
        if (r < N_BR) { const int lz = r / I_BR; r %= I_BR; const int l = lz / 3, z = lz % 3, kb = r / 32, nb = r % 32;
            transpose_item(inp(a, 19 + z) + (size_t)l * 512 * 1024, 1024, 512, WBR + (size_t)lz * 1024 * 512, kb * 64, 32 * nb, 32 * nb, 32, scr, F.lane); continue; }
        r -= N_BR;
        if (r < N_WO) { const int l = r / I_WO; r %= I_WO; const int kb = r / 32, nb = r % 32;
            transpose_item(inp(a, 22) + (size_t)l * 1024 * 1024, 1024, 1024, WO + (size_t)l * 1024 * 1024, kb * 64, 32 * nb, 32 * nb, 32, scr, F.lane); continue; }
        r -= N_WO;
        if (r < N_GU) { const int le = r / I_GU; r %= I_GU; const int kb = r / 64, nb = r % 64;
            const int dst = (nb < 32) ? 256 * (nb >> 2) + 32 * (nb & 3) : 256 * ((nb - 32) >> 2) + 128 + 32 * ((nb - 32) & 3);
            transpose_item(inp(a, 25) + (size_t)le * 1024 * 2048, 2048, 1024, WGU + (size_t)le * 2048 * 1024, kb * 64, 32 * nb, dst, 32, scr, F.lane); continue; }
        r -= N_GU;
        { const int le = r / I_DN; r %= I_DN; const int kb = r / 32, nb = r % 32;
            transpose_item(inp(a, 27) + (size_t)le * 1024 * 1024, 1024, 1024, WDN + (size_t)le * 1024 * 1024, kb * 64, 32 * nb, 32 * nb, 32, scr, F.lane); }
    }
    for (int i = F.bid * 512 + F.tid; i < NL * 208 * 128; i += F.G * 512) { const int l = i / (208 * 128), r = i % (208 * 128);
        *(v4u*)(WIN + (size_t)l * NIN * 1024 + (size_t)7472 * 1024 + (size_t)r * 8) = (v4u){0u, 0u, 0u, 0u}; }
}

__device__ __forceinline__ void norm_mod_store(const f32x4 (&x)[4], const float* gain, const float* shift, const float* scale, bf16* hrow, int lane, f32x4 (&h)[4]) {
    float ss = 0.f;
#pragma unroll
    for (int j = 0; j < 4; ++j) ss += (x[j][0] * x[j][0] + x[j][1] * x[j][1]) + (x[j][2] * x[j][2] + x[j][3] * x[j][3]);
    const float rstd = rsqrtf(wave_sum(ss) * (1.0f / 1024.0f) + EPS);
#pragma unroll
    for (int j = 0; j < 4; ++j) { const int c = 4 * lane + 256 * j; const f32x4 g = *(const f32x4*)(gain + c), sh = *(const f32x4*)(shift + c), sc = *(const f32x4*)(scale + c);
        h[j] = (x[j] * rstd * g) * (sc + 1.0f) + sh;
        v2u o; o.x = cvt_pk_bf16(h[j][0], h[j][1]); o.y = cvt_pk_bf16(h[j][2], h[j][3]); *(v2u*)(hrow + c) = o; }
}
__device__ __forceinline__ void load_mod(const float* gain, const float* shift, const float* scale, int lane, f32x4 (&gs)[4], f32x4 (&sh)[4]) {
#pragma unroll
    for (int j = 0; j < 4; ++j) { const int c = 4 * lane + 256 * j; gs[j] = *(const f32x4*)(gain + c) * (*(const f32x4*)(scale + c) + 1.0f); sh[j] = *(const f32x4*)(shift + c); }
}
__device__ __forceinline__ void norm_mod_store2(const f32x4 (&x)[4], const f32x4 (&gs)[4], const f32x4 (&sh)[4], bf16* hrow, int lane, f32x4 (&h)[4]) {
    float ss = 0.f;
#pragma unroll
    for (int j = 0; j < 4; ++j) ss += (x[j][0] * x[j][0] + x[j][1] * x[j][1]) + (x[j][2] * x[j][2] + x[j][3] * x[j][3]);
    const float rstd = rsqrtf(wave_sum(ss) * (1.0f / 1024.0f) + EPS);
#pragma unroll
    for (int j = 0; j < 4; ++j) { h[j] = (x[j] * rstd) * gs[j] + sh[j];
        v2u o; o.x = cvt_pk_bf16(h[j][0], h[j][1]); o.y = cvt_pk_bf16(h[j][2], h[j][3]); *(v2u*)(hrow + 4 * lane + 256 * j) = o; }
}
__device__ __forceinline__ void phase_norm0(Frame& F, ArgsP a) {
    float* XS = (float*)(F.ws + WS_XS); bf16* H = (bf16*)(F.ws + WS_H); const float* MOD = (const float*)(F.ws + WS_MOD);
    for (int t = F.bid * 8 + F.wave; t < T; t += F.G * 8) {
        const float* src = (t < CTX) ? inp(a, 2) + (size_t)t * 1024 : inp(a, 0) + (size_t)(t - CTX) * 1024;
        f32x4 x[4], h[4];
#pragma unroll
        for (int j = 0; j < 4; ++j) { x[j] = *(const f32x4*)(src + 4 * F.lane + 256 * j); *(f32x4*)(XS + (size_t)t * 1024 + 4 * F.lane + 256 * j) = x[j]; }
        const float* mv = MOD + (size_t)((t < CTX) ? 1 : 0) * 6144;
        norm_mod_store(x, inp(a, 6), mv, mv + 1024, H + (size_t)t * 1024, F.lane, h);
    }
}

__device__ __forceinline__ void phase_prep(Frame& F, ArgsP a, int l) {
    const bf16* P = (const bf16*)(F.ws + WS_P);
    const int lane = F.lane;
    for (int t = F.bid * 8 + F.wave; t < T; t += F.G * 8) {
#pragma unroll
        for (int qk = 0; qk < 2; ++qk) {
            const bf16* ptr = P + (size_t)t * NIN + (qk == 0 ? PC_CQ : PC_CK) + 8 * lane;
            bf16* optr = (qk == 0) ? (bf16*)(F.ws + WS_QN) + (size_t)t * 512 + 8 * lane : (bf16*)(F.ws + WS_KN) + (size_t)t * 128 + 8 * lane;
            const bool act = (qk == 0) || (lane < 16);
            const v4u xv = act ? *(const v4u*)ptr : (v4u){0u, 0u, 0u, 0u};
            float y[8] = {bf_lo(xv.x), bf_hi(xv.x), bf_lo(xv.y), bf_hi(xv.y), bf_lo(xv.z), bf_hi(xv.z), bf_lo(xv.w), bf_hi(xv.w)};
            float ss = 0.f;
#pragma unroll
            for (int i = 0; i < 8; ++i) ss += y[i] * y[i];
            ss = row_sum8(ss);
            const float r = rsqrtf(ss * (1.0f / 64.0f) + EPS); const float* gn = inp(a, qk == 0 ? 16 : 17) + l * 64 + 8 * (lane & 7);
#pragma unroll
            for (int i = 0; i < 8; ++i) y[i] = y[i] * r * gn[i];
            if (t >= CTX) { const int p = t - CTX, hl = lane & 7; const int pos = (hl < 4) ? (p >> 6) : (p & 63); const int i0 = 8 * (hl & 1); const bool first = (hl & 2) == 0;
                const float* rp = (const float*)(F.ws + WS_ROPE) + ((size_t)pos * 16 + i0) * 2;
#pragma unroll
                for (int i2 = 0; i2 < 4; ++i2) { const f32x4 cs = *(const f32x4*)(rp + 4 * i2);
#pragma unroll
                    for (int u = 0; u < 2; ++u) { const int i = 2 * i2 + u; const float other = dppf<0x4E>(y[i]); const float c_ = cs[2 * u], s_ = cs[2 * u + 1];
                        y[i] = first ? (y[i] * c_ - other * s_) : (y[i] * c_ + other * s_); } } }
            if (act) { v4u o; o.x = cvt_pk_bf16(y[0], y[1]); o.y = cvt_pk_bf16(y[2], y[3]); o.z = cvt_pk_bf16(y[4], y[5]); o.w = cvt_pk_bf16(y[6], y[7]); *(v4u*)optr = o; }
        }
    }
}

__device__ __forceinline__ int scan_tok(int d, int n, int i) {
    if (n < 4) { const int p = 64 * n + i; return d ? (CTX - 1 - p) : p; }
    const int p = 64 * (n - 4) + i; return CTX + (d ? (SEQ - 1 - p) : p);
}
#define LSYNC() do { asm volatile("s_waitcnt lgkmcnt(0)" ::: "memory"); __builtin_amdgcn_s_barrier(); asm volatile("" ::: "memory"); } while (0)
__device__ __forceinline__ int chunk_tok0(int n) { return (n < 4) ? 64 * n : CTX + 64 * (n - 4); }
__device__ __forceinline__ int scan_chunk(int d, int s) { return d ? ((s < 4) ? 3 - s : 263 - s) : s; }
template <class Emit> __device__ __forceinline__ void tri_solve_blocked(const LAS float* L, const LAS bf16* Lbf, LAS bf16* TT  , LAS float* Y  , int lane, const Emit& emit) {
    const int fr = lane & 15, fq = lane >> 4;
#pragma unroll
    for (int k = 0; k < 8; ++k) *(LAS v4u*)(TT + lane * 64 + 8 * k) = (v4u){0u, 0u, 0u, 0u};
#pragma unroll
    for (int i = 0; i < 4; ++i) {
        float y[16];
#pragma unroll
        for (int r = 0; r < 16; ++r) y[r] = 0.f;
        if (i > 0) {
#pragma unroll
            for (int nt = 0; nt < i; ++nt) { f32x4 acc = (f32x4){0.f, 0.f, 0.f, 0.f};
#pragma unroll
                for (int ks = 0; ks < (i + 1) / 2; ++ks) { bf16x8 af = *(const LAS bf16x8*)(Lbf + (16 * i + fr) * 72 + 32 * ks + 8 * fq); if (32 * ks + 8 * fq >= 16 * i) af = (bf16x8){0, 0, 0, 0, 0, 0, 0, 0};
                    acc = __builtin_amdgcn_mfma_f32_16x16x32_bf16(af, *(const LAS bf16x8*)(TT + (16 * nt + fr) * 64 + 32 * ks + 8 * fq), acc, 0, 0, 0); }
#pragma unroll
                for (int jj = 0; jj < 4; ++jj) Y[(4 * fq + jj) * 64 + 16 * nt + fr] = acc[jj]; }
            asm volatile("s_waitcnt lgkmcnt(0)" ::: "memory");
#pragma unroll
            for (int r = 0; r < 16; ++r) { const float v = Y[r * 64 + lane]; y[r] = (lane < 16 * i) ? v : 0.f; }
        }
        float X[16];
#pragma unroll
        for (int r = 0; r < 16; ++r) { float acc = ((lane == 16 * i + r) ? 1.0f : 0.0f) - y[r];
#pragma unroll
            for (int s4 = 0; s4 < (r + 3) / 4; ++s4) { const f32x4 lv = *(const LAS f32x4*)(L + (16 * i + r) * 64 + 16 * i + 4 * s4);
#pragma unroll
                for (int u = 0; u < 4; ++u) if (4 * s4 + u < r) acc -= lv[u] * X[4 * s4 + u]; }
            X[r] = acc; emit(16 * i + r, acc); }
        { v4u w0, w1; w0.x = cvt_pk_bf16(X[0], X[1]); w0.y = cvt_pk_bf16(X[2], X[3]); w0.z = cvt_pk_bf16(X[4], X[5]); w0.w = cvt_pk_bf16(X[6], X[7]); w1.x = cvt_pk_bf16(X[8], X[9]); w1.y = cvt_pk_bf16(X[10], X[11]); w1.z = cvt_pk_bf16(X[12], X[13]); w1.w = cvt_pk_bf16(X[14], X[15]);
          *(LAS v4u*)(TT + lane * 64 + 16 * i) = w0; *(LAS v4u*)(TT + lane * 64 + 16 * i + 8) = w1; }
        asm volatile("s_waitcnt lgkmcnt(0)" ::: "memory");
    }
}
__device__ __forceinline__ void dn_prep_item(Frame& F, ArgsP a, int l, int item) {
    int tid_ = F.tid; asm volatile("" : "+v"(tid_));
    const int n = item % 260, h = item / 260, t0 = chunk_tok0(n), s0 = (n < 4) ? 0 : CTX, s1 = (n < 4) ? CTX : T, tid = tid_, lane = tid & 63, wv = __builtin_amdgcn_readfirstlane(tid >> 6), fr = lane & 15, fq = lane >> 4;
    LAS bf16* RAW = (LAS bf16*)F.lds;
    LAS float* Lm = (LAS float*)F.lds;
    LAS bf16* Lb = (LAS bf16*)(F.lds + 32768);
    LAS bf16* Qs = (LAS bf16*)(F.lds + 52224); LAS bf16* Ks = Qs + 64 * 136;
    LAS bf16* TPb = Qs;
    LAS bf16* KT = (LAS bf16*)(F.lds + 87040); LAS bf16* VT = KT + 128 * 72;
    LAS float* gc = (LAS float*)(F.lds + 123904); LAS float* be = gc + 128; LAS float* SS = be + 128;
    const bf16* P = (const bf16*)(F.ws + WS_P); const float* SM = (const float*)(F.ws + WS_SM);
    unsigned char* DF0 = F.ws + WS_DF + (size_t)(h * 260 + n) * DF_BYTES; unsigned char* DF1 = DF0 + (size_t)4 * 260 * DF_BYTES;
    bf16* DU0 = (bf16*)(F.ws + WS_DU) + (size_t)(h * 260 + n) * 8192; bf16* DU1 = DU0 + (size_t)4 * 260 * 8192;
    __syncthreads();
    LAS float* CW = (LAS float*)(F.lds + MISC_OFF + 2560);
    for (int idx = tid; idx < 68 * 48; idx += 512) { const int rr = idx / 48, ch = idx % 48, p = ch >> 4, c8 = (ch & 15) * 8, tok = t0 - 2 + rr;
        v4u x = (v4u){0u, 0u, 0u, 0u}; if (tok >= s0 && tok < s1) x = *(const v4u*)(P + (size_t)tok * NIN + PC_AQ + p * 512 + h * 128 + c8);
        *(LAS v4u*)(RAW + rr * 384 + p * 128 + c8) = x; }
    for (int idx = tid; idx < 5 * 384; idx += 512) { const int j = idx / 384, c = idx % 384; CW[idx] = inp(a, 9)[(size_t)(l * 5 + j) * 1536 + (c >> 7) * 512 + h * 128 + (c & 127)]; }
    if (wv < 2) { const int d = wv; const float aa = SM[(size_t)(t0 + lane) * 64 + d * 4 + h], ab = SM[(size_t)(t0 + lane) * 64 + 8 + d * 4 + h];
        float v = -fexp(inp(a, 10)[l * 8 + d * 4 + h]) * softplus_f(aa + inp(a, 11)[l * 8 + d * 4 + h]);
#pragma unroll
        for (int o = 1; o < 64; o <<= 1) { const float u = d ? __shfl_down(v, o) : __shfl_up(v, o); if (d ? (lane + o < 64) : (lane >= o)) v += u; }
        gc[d * 64 + lane] = v; be[d * 64 + lane] = sigmoid_f(ab); }
    __syncthreads();
    if (tid < 384) { const int co = tid % 48, pg = tid / 48, p = co >> 4, c0 = 8 * (co & 15), cr = p * 128 + c0;
        float w[5][8];
#pragma unroll
        for (int j = 0; j < 5; ++j) { const f32x4 wa = *(const LAS f32x4*)(CW + j * 384 + cr), wb = *(const LAS f32x4*)(CW + j * 384 + cr + 4);
            w[j][0] = wa[0]; w[j][1] = wa[1]; w[j][2] = wa[2]; w[j][3] = wa[3]; w[j][4] = wb[0]; w[j][5] = wb[1]; w[j][6] = wb[2]; w[j][7] = wb[3]; }
        float val[8][8];
#pragma unroll
        for (int i = 0; i < 8; ++i)
#pragma unroll
            for (int c = 0; c < 8; ++c) val[i][c] = 0.f;
#pragma unroll
        for (int rr = 0; rr < 12; ++rr) { const v4u xv = *(const LAS v4u*)(RAW + (8 * pg + rr) * 384 + cr);
            const float x[8] = {bf_lo(xv.x), bf_hi(xv.x), bf_lo(xv.y), bf_hi(xv.y), bf_lo(xv.z), bf_hi(xv.z), bf_lo(xv.w), bf_hi(xv.w)};
#pragma unroll
            for (int j = 0; j < 5; ++j) { const int i = rr - j; if (i >= 0 && i < 8) {
#pragma unroll
                for (int c = 0; c < 8; ++c) val[i][c] += x[c] * w[j][c]; } } }
        unsigned pk[8][4];
#pragma unroll
        for (int i = 0; i < 8; ++i) { float ss = 0.f;
#pragma unroll
            for (int c = 0; c < 8; ++c) { val[i][c] = val[i][c] * sigmoid_f(val[i][c]); ss += val[i][c] * val[i][c]; }
            ss = row_sum16(ss);
            const float rn = (p == 2) ? 1.0f : rsqrtf(ss + EPS) * ((p == 0) ? 0.08838834764831845f : 1.0f);
#pragma unroll
            for (int c2 = 0; c2 < 4; ++c2) pk[i][c2] = cvt_pk_bf16(val[i][2 * c2] * rn, val[i][2 * c2 + 1] * rn);
            if (p < 2) *(LAS v4u*)(((p == 0) ? Qs : Ks) + (8 * pg + i) * 136 + c0) = (v4u){pk[i][0], pk[i][1], pk[i][2], pk[i][3]}; }
        if (p >= 1) { LAS bf16* TT = (p == 1) ? KT : VT;
#pragma unroll
            for (int c2 = 0; c2 < 4; ++c2) { v4u lo_, hi_;
                lo_.x = (pk[0][c2] & 0xffffu) | (pk[1][c2] << 16); lo_.y = (pk[2][c2] & 0xffffu) | (pk[3][c2] << 16); lo_.z = (pk[4][c2] & 0xffffu) | (pk[5][c2] << 16); lo_.w = (pk[6][c2] & 0xffffu) | (pk[7][c2] << 16);
                hi_.x = (pk[0][c2] >> 16) | (pk[1][c2] & 0xffff0000u); hi_.y = (pk[2][c2] >> 16) | (pk[3][c2] & 0xffff0000u); hi_.z = (pk[4][c2] >> 16) | (pk[5][c2] & 0xffff0000u); hi_.w = (pk[6][c2] >> 16) | (pk[7][c2] & 0xffff0000u);
                *(LAS v4u*)(TT + (c0 + 2 * c2) * 72 + 8 * pg) = lo_; *(LAS v4u*)(TT + (c0 + 2 * c2 + 1) * 72 + 8 * pg) = hi_; } } }
    __syncthreads();
    for (int r33_ = 0; r33_ < PROBE_REPS(33); ++r33_)
    { const int which = wv >> 2, it = wv & 3; const LAS bf16* Bsrc = which ? Qs : Ks;
      f32x4 gt4[4];
#pragma unroll
      for (int jt = 0; jt < 4; ++jt) { f32x4 acc = (f32x4){0.f, 0.f, 0.f, 0.f};
#pragma unroll
          for (int ks = 0; ks < 4; ++ks) acc = __builtin_amdgcn_mfma_f32_16x16x32_bf16(*(const LAS bf16x8*)(Ks + (16 * jt + fr) * 136 + 32 * ks + 8 * fq), *(const LAS bf16x8*)(Bsrc + (16 * it + fr) * 136 + 32 * ks + 8 * fq), acc, 0, 0, 0);
          gt4[jt] = acc; }
      const int i = 16 * it + fr;
#pragma unroll
      for (int d = 0; d < 2; ++d) { const float gi = gc[d * 64 + i], bi = be[d * 64 + i];
          if (which == 0) {
#pragma unroll
              for (int jt = 0; jt < 4; ++jt) { const int j0 = 16 * jt + 4 * fq; const f32x4 gj = *(const LAS f32x4*)(gc + d * 64 + j0); f32x4 lv;
#pragma unroll
                  for (int jj = 0; jj < 4; ++jj) { const int j = j0 + jj; const bool keep = d ? (i < j) : (i > j); lv[jj] = keep ? bi * gt4[jt][jj] * fexp(gi - gj[jj]) : 0.f; }
                  if (d == 0) { *(LAS f32x4*)(Lm + i * 64 + j0) = lv; v2u b; b.x = cvt_pk_bf16(lv[0], lv[1]); b.y = cvt_pk_bf16(lv[2], lv[3]); *(LAS v2u*)(Lb + i * 72 + j0) = b; }
                  else { *(LAS f32x4*)(Lm + 4096 + (63 - i) * 64 + (60 - j0)) = (f32x4){lv[3], lv[2], lv[1], lv[0]}; v2u b; b.x = cvt_pk_bf16(lv[3], lv[2]); b.y = cvt_pk_bf16(lv[1], lv[0]); *(LAS v2u*)(Lb + 4608 + (63 - i) * 72 + (60 - j0)) = b; } } }
          else { unsigned char* DF = d ? DF1 : DF0;
#pragma unroll
              for (int ks = 0; ks < 2; ++ks) { float f[8];
#pragma unroll
                  for (int t2 = 0; t2 < 2; ++t2) { const int jt = 2 * ks + t2, j0 = 16 * jt + 4 * fq; const f32x4 gj = *(const LAS f32x4*)(gc + d * 64 + j0);
#pragma unroll
                      for (int jj = 0; jj < 4; ++jj) { const int j = j0 + jj; const bool keep = d ? (i <= j) : (i >= j); f[4 * t2 + jj] = keep ? gt4[jt][jj] * fexp(gi - gj[jj]) : 0.f; } }
                  v4u w; w.x = cvt_pk_bf16(f[0], f[1]); w.y = cvt_pk_bf16(f[2], f[3]); w.z = cvt_pk_bf16(f[4], f[5]); w.w = cvt_pk_bf16(f[6], f[7]);
                  *(v4u*)(DF + DF_QK + (size_t)((it * 2 + ks) * 64 + lane) * 16) = w; } } }
      { const int mt = wv & 3, pos = 16 * mt + fr;
#pragma unroll
        for (int kk = 0; kk < 2; ++kk) { const int ks = (wv >> 2) * 2 + kk; const v2u qa = *(const LAS v2u*)(Qs + pos * 136 + 32 * ks + 4 * fq), qb = *(const LAS v2u*)(Qs + pos * 136 + 32 * ks + 16 + 4 * fq);
#pragma unroll
            for (int d = 0; d < 2; ++d) { const float e = fexp(gc[d * 64 + pos]); v4u w; w.x = cvt_pk_bf16(bf_lo(qa.x) * e, bf_hi(qa.x) * e); w.y = cvt_pk_bf16(bf_lo(qa.y) * e, bf_hi(qa.y) * e); w.z = cvt_pk_bf16(bf_lo(qb.x) * e, bf_hi(qb.x) * e); w.w = cvt_pk_bf16(bf_lo(qb.y) * e, bf_hi(qb.y) * e);
                *(v4u*)((d ? DF1 : DF0) + DF_QD + (size_t)((mt * 4 + ks) * 64 + lane) * 16) = w; } } }
      { const int d = wv >> 2; const float ge = gc[d * 64 + (d ? 0 : 63)];
#pragma unroll
        for (int q2 = 0; q2 < 2; ++q2) { const int dt = 2 * (wv & 3) + q2, dk = 16 * dt + fr;
#pragma unroll
            for (int ks = 0; ks < 2; ++ks) { const int p0 = 32 * ks + 4 * fq; const v2u ka = *(const LAS v2u*)(KT + dk * 72 + p0), kb = *(const LAS v2u*)(KT + dk * 72 + p0 + 16);
                const f32x4 ga = *(const LAS f32x4*)(gc + d * 64 + p0), gb = *(const LAS f32x4*)(gc + d * 64 + p0 + 16);
                v4u w; w.x = cvt_pk_bf16(bf_lo(ka.x) * fexp(ge - ga[0]), bf_hi(ka.x) * fexp(ge - ga[1])); w.y = cvt_pk_bf16(bf_lo(ka.y) * fexp(ge - ga[2]), bf_hi(ka.y) * fexp(ge - ga[3]));
                w.z = cvt_pk_bf16(bf_lo(kb.x) * fexp(ge - gb[0]), bf_hi(kb.x) * fexp(ge - gb[1])); w.w = cvt_pk_bf16(bf_lo(kb.y) * fexp(ge - gb[2]), bf_hi(kb.y) * fexp(ge - gb[3]));
                *(v4u*)((d ? DF1 : DF0) + DF_KDT + (size_t)((dt * 2 + ks) * 64 + lane) * 16) = w; } } }
      if (tid < 2) ((float*)(F.ws + WS_DGT))[(size_t)(tid * 4 + h) * 260 + n] = fexp(gc[tid * 64 + (tid ? 0 : 63)]);
    }
    __syncthreads();
    if (wv < 2) { const int d = wv; const int j = d ? 63 - lane : lane; const float bj = be[d * 64 + j], ej = bj * fexp(gc[d * 64 + j]);
        LAS bf16* TP = TPb + (2 * d) * 4096; LAS bf16* TPP = TP + 4096;
        LAS bf16* TT = (LAS bf16*)(F.lds + MISC_OFF + 2560) + d * 4096; LAS float* Yb = (LAS float*)(F.lds + MISC_OFF + 2560 + 16384) + d * 1024;
        tri_solve_blocked(Lm + d * 4096, Lb + d * 4608, TT, Yb, lane, [&](int r, float x) { const int i = d ? 63 - r : r; const unsigned w = cvt_pk_bf16(x * ej, x * bj); TP[i * 64 + j] = (bf16)(w & 0xffffu); TPP[i * 64 + j] = (bf16)(w >> 16); }); }
    __syncthreads();
    for (int r34_ = 0; r34_ < PROBE_REPS(34); ++r34_)
    { const int d = wv >> 2, w4 = wv & 3; const LAS bf16* TP = TPb + (2 * d) * 4096; const LAS bf16* TPP = TP + 4096; unsigned char* DF = d ? DF1 : DF0; bf16* DU = d ? DU1 : DU0;
#pragma unroll
      for (int it = 0; it < 4; ++it) { f32x4 acc[2];
#pragma unroll
          for (int q2 = 0; q2 < 2; ++q2) { acc[q2] = (f32x4){0.f, 0.f, 0.f, 0.f};
#pragma unroll
              for (int ks = 0; ks < 2; ++ks) acc[q2] = __builtin_amdgcn_mfma_f32_16x16x32_bf16(*(const LAS bf16x8*)(KT + (16 * (2 * w4 + q2) + fr) * 72 + 32 * ks + 8 * fq), *(const LAS bf16x8*)(TP + (16 * it + fr) * 64 + 32 * ks + 8 * fq), acc[q2], 0, 0, 0); }
          v4u w; w.x = cvt_pk_bf16(-acc[0][0], -acc[0][1]); w.y = cvt_pk_bf16(-acc[0][2], -acc[0][3]); w.z = cvt_pk_bf16(-acc[1][0], -acc[1][1]); w.w = cvt_pk_bf16(-acc[1][2], -acc[1][3]);
          *(v4u*)(DF + DF_NW + (size_t)((it * 4 + w4) * 64 + lane) * 16) = w; }
#pragma unroll
      for (int q2 = 0; q2 < 2; ++q2) { const int dvt = 2 * w4 + q2;
#pragma unroll
          for (int it = 0; it < 4; ++it) { f32x4 acc = (f32x4){0.f, 0.f, 0.f, 0.f};
#pragma unroll
              for (int ks = 0; ks < 2; ++ks) acc = __builtin_amdgcn_mfma_f32_16x16x32_bf16(*(const LAS bf16x8*)(TPP + (16 * it + fr) * 64 + 32 * ks + 8 * fq), *(const LAS bf16x8*)(VT + (16 * dvt + fr) * 72 + 32 * ks + 8 * fq), acc, 0, 0, 0);
              { v2u w; w.x = cvt_pk_bf16(acc[0], acc[1]); w.y = cvt_pk_bf16(acc[2], acc[3]); *(v2u*)(DU + (size_t)((dvt * 4 + it) * 64 + lane) * 4) = w; } } } }
}
__device__ __forceinline__ void dn_scan_item(Frame& F, int item) {
    int tid_ = F.tid; asm volatile("" : "+v"(tid_));
    const int dh = item >> 3, d = dh >> 2, tid = tid_, lane = tid & 63, wv = __builtin_amdgcn_readfirstlane(tid >> 6);
    const unsigned char* DF = F.ws + WS_DF; const unsigned char* DU = F.ws + WS_DU; unsigned char* SN = F.ws + WS_DSN;
    LAS float* gts = (LAS float*)(F.lds + MISC_OFF + 1024);
    LAS unsigned char* uring = F.lds + MISC_OFF + 2560;
    const int dvl = 0, dvt = item & 7;
    const bool comp = wv < 1, stg = wv >= 4;
    f32x4 S[8]; bf16x8 Sb[4]; bf16x8 fw[4][4]; v2u uw[4]; float gtn = 0.f;
#pragma unroll
    for (int i = 0; i < 8; ++i) S[i] = (f32x4){0.f, 0.f, 0.f, 0.f};
#pragma unroll
    for (int i = 0; i < 4; ++i) Sb[i] = (bf16x8){0, 0, 0, 0, 0, 0, 0, 0};
    auto issue_nk = [&](int s) { const int sc = s < 260 ? s : 259; const unsigned char* src = DF + (size_t)(dh * 260 + scan_chunk(d, sc)) * DF_BYTES; const int slot = s & 3;
#pragma unroll
        for (int k = 0; k < 8; ++k) { const int p = (wv - 4) + 4 * k; const int off = (p < 16) ? DF_NW + p * 1024 : DF_KDT + (p - 16) * 1024;
            __builtin_amdgcn_global_load_lds((const unsigned*)(src + off + lane * 16), (LAS unsigned*)(F.lds + slot * 32768 + p * 1024), 16, 0, 0); } };
    auto issue_u = [&](int s, int uslot) { const int sc = s < 260 ? s : 259; const unsigned char* src = DU + (size_t)(dh * 260 + scan_chunk(d, sc)) * 16384 + dvt * 2048;
        if (wv < 6) { const int p = wv - 4; __builtin_amdgcn_global_load_lds((const unsigned*)(src + p * 1024 + lane * 16), (LAS unsigned*)(uring + uslot * 4096 + p * 1024), 16, 0, 0); } };
    __syncthreads();
    if (tid < 260) gts[tid] = ((const float*)(F.ws + WS_DGT))[dh * 260 + tid];
    if (stg) { issue_nk(0); issue_u(0, 0); issue_nk(1); issue_u(1, 1); issue_nk(2); issue_u(2, 2); }
    auto step = [&](int s, int uslot, int uslot2) {
        if (stg) { if (wv < 6) asm volatile("s_waitcnt vmcnt(9)" ::: "memory"); else asm volatile("s_waitcnt vmcnt(8)" ::: "memory"); }
        if (!comp) asm volatile("s_waitcnt lgkmcnt(0)" ::: "memory");
        __builtin_amdgcn_s_barrier(); asm volatile("" ::: "memory");
        if (stg) { issue_nk(s + 3); issue_u(s + 3, (s + 3) & 3); }
        if (comp) {
            const int n = scan_chunk(d, s);
            const LAS unsigned char* buf = F.lds + (s & 3) * 32768;
            const float gt = (s == 0) ? gts[n] : gtn;
            unsigned char* sn = SN + (size_t)(dh * 260 + n) * DSN_BYTES;
            bf16x8 fk[2][8];
            if (s == 0) {
#pragma unroll
                for (int mt = 0; mt < 4; ++mt) uw[mt] = *(const LAS v2u*)(uring + ((dvl * 4 + mt) * 64 + lane) * 8);
#pragma unroll
                for (int ks = 0; ks < 4; ++ks)
#pragma unroll
                    for (int mt = 0; mt < 4; ++mt) fw[ks][mt] = *(const LAS bf16x8*)(buf + ((mt * 4 + ks) * 64 + lane) * 16); }
            __builtin_amdgcn_sched_barrier(0);
#pragma unroll
            for (int ks = 0; ks < 4; ++ks) *(bf16x8*)(sn + (size_t)((dvt * 4 + ks) * 64 + lane) * 16) = Sb[ks];
            f32x4 vn[4];
#pragma unroll
            for (int mt = 0; mt < 4; ++mt) vn[mt] = (f32x4){bf_lo(uw[mt].x), bf_hi(uw[mt].x), bf_lo(uw[mt].y), bf_hi(uw[mt].y)};
#pragma unroll
            for (int mt = 0; mt < 4; ++mt) vn[mt] = __builtin_amdgcn_mfma_f32_16x16x32_bf16(fw[0][mt], Sb[0], vn[mt], 0, 0, 0);
            __builtin_amdgcn_sched_barrier(0);
#pragma unroll
            for (int dt = 0; dt < 8; ++dt) fk[0][dt] = *(const LAS bf16x8*)(buf + 16384 + ((dt * 2 + 0) * 64 + lane) * 16);
            __builtin_amdgcn_sched_barrier(0);
#pragma unroll
            for (int mt = 0; mt < 4; ++mt) vn[mt] = __builtin_amdgcn_mfma_f32_16x16x32_bf16(fw[1][mt], Sb[1], vn[mt], 0, 0, 0);
            __builtin_amdgcn_sched_barrier(0);
#pragma unroll
            for (int dt = 0; dt < 8; ++dt) fk[1][dt] = *(const LAS bf16x8*)(buf + 16384 + ((dt * 2 + 1) * 64 + lane) * 16);
            __builtin_amdgcn_sched_barrier(0);
#pragma unroll
            for (int ks = 2; ks < 4; ++ks)
#pragma unroll
                for (int mt = 0; mt < 4; ++mt) vn[mt] = __builtin_amdgcn_mfma_f32_16x16x32_bf16(fw[ks][mt], Sb[ks], vn[mt], 0, 0, 0);
            bf16x8 vb[2];
#pragma unroll
            for (int ks = 0; ks < 2; ++ks) { v4u w; w.x = cvt_pk_bf16(vn[2 * ks][0], vn[2 * ks][1]); w.y = cvt_pk_bf16(vn[2 * ks][2], vn[2 * ks][3]); w.z = cvt_pk_bf16(vn[2 * ks + 1][0], vn[2 * ks + 1][1]); w.w = cvt_pk_bf16(vn[2 * ks + 1][2], vn[2 * ks + 1][3]); vb[ks] = __builtin_bit_cast(bf16x8, w);
                *(bf16x8*)(sn + DSN_V + (size_t)((dvt * 2 + ks) * 64 + lane) * 16) = vb[ks]; }
#pragma unroll
            for (int dt = 0; dt < 8; ++dt) S[dt] = S[dt] * gt;
#pragma unroll
            for (int ks = 0; ks < 2; ++ks)
#pragma unroll
                for (int dt = 0; dt < 8; ++dt) S[dt] = __builtin_amdgcn_mfma_f32_16x16x32_bf16(fk[ks][dt], vb[ks], S[dt], 0, 0, 0);
            __builtin_amdgcn_sched_barrier(0);
            { const LAS unsigned char* nb = F.lds + ((s + 1) & 3) * 32768;
#pragma unroll
              for (int ks = 0; ks < 4; ++ks)
#pragma unroll
                  for (int mt = 0; mt < 4; ++mt) fw[ks][mt] = *(const LAS bf16x8*)(nb + ((mt * 4 + ks) * 64 + lane) * 16);
#pragma unroll
              for (int mt = 0; mt < 4; ++mt) uw[mt] = *(const LAS v2u*)(uring + ((s + 1) & 3) * 4096 + ((dvl * 4 + mt) * 64 + lane) * 8);
              gtn = gts[scan_chunk(d, s < 259 ? s + 1 : 259)]; }
            __builtin_amdgcn_sched_barrier(0);
#pragma unroll
            for (int ks = 0; ks < 4; ++ks) { v4u w; w.x = cvt_pk_bf16(S[2 * ks][0], S[2 * ks][1]); w.y = cvt_pk_bf16(S[2 * ks][2], S[2 * ks][3]); w.z = cvt_pk_bf16(S[2 * ks + 1][0], S[2 * ks + 1][1]); w.w = cvt_pk_bf16(S[2 * ks + 1][2], S[2 * ks + 1][3]); Sb[ks] = __builtin_bit_cast(bf16x8, w); }
        }
    };
    asm volatile("s_waitcnt lgkmcnt(0)" ::: "memory");
    for (int s = 0; s < 258; s += 3) { step(s, 0, 2); step(s + 1, 1, 0); step(s + 2, 2, 1); }
    step(258, 0, 2); step(259, 1, 0);
    asm volatile("s_waitcnt vmcnt(0)" ::: "memory");
    __syncthreads();
}
__device__ __forceinline__ void dn_post_witem(Frame& F, ArgsP a, int l, int wi) {
    const int item = wi >> 2, mt = wi & 3, n = item % 260, h = item / 260, t0 = chunk_tok0(n), lane = F.lane, fr = lane & 15, fq = lane >> 4;
    const bf16* P = (const bf16*)(F.ws + WS_P); bf16* YA = (bf16*)(F.ws + WS_YABC);
    f32x4 o[8];
#pragma unroll
    for (int dvt = 0; dvt < 8; ++dvt) o[dvt] = (f32x4){0.f, 0.f, 0.f, 0.f};
#pragma unroll
    for (int d = 0; d < 2; ++d) { const size_t it = (size_t)(d * 4 + h) * 260 + n; const unsigned char* df = F.ws + WS_DF + it * DF_BYTES; const unsigned char* sn = F.ws + WS_DSN + it * DSN_BYTES;
        bf16x8 qd[4], qk[2];
#pragma unroll
        for (int ks = 0; ks < 4; ++ks) qd[ks] = *(const bf16x8*)(df + DF_QD + (unsigned)(((mt * 4 + ks) * 64 + lane) * 16));
#pragma unroll
        for (int ks = 0; ks < 2; ++ks) qk[ks] = *(const bf16x8*)(df + DF_QK + (unsigned)(((mt * 2 + ks) * 64 + lane) * 16));
#pragma unroll
        for (int g4 = 0; g4 < 2; ++g4) { bf16x8 sf[4][4], vf[4][2];
#pragma unroll
            for (int q = 0; q < 4; ++q) { const int dvt = 4 * g4 + q;
#pragma unroll
                for (int ks = 0; ks < 4; ++ks) sf[q][ks] = *(const bf16x8*)(sn + (unsigned)(((dvt * 4 + ks) * 64 + lane) * 16));
#pragma unroll
                for (int ks = 0; ks < 2; ++ks) vf[q][ks] = *(const bf16x8*)(sn + DSN_V + (unsigned)(((dvt * 2 + ks) * 64 + lane) * 16)); }
            __builtin_amdgcn_sched_barrier(0);
#pragma unroll
            for (int q = 0; q < 4; ++q) { const int dvt = 4 * g4 + q;
#pragma unroll
                for (int ks = 0; ks < 4; ++ks) o[dvt] = __builtin_amdgcn_mfma_f32_16x16x32_bf16(sf[q][ks], qd[ks], o[dvt], 0, 0, 0);
#pragma unroll
                for (int ks = 0; ks < 2; ++ks) o[dvt] = __builtin_amdgcn_mfma_f32_16x16x32_bf16(vf[q][ks], qk[ks], o[dvt], 0, 0, 0); }
            __builtin_amdgcn_sched_barrier(0); } }
    float ss = 0.f;
#pragma unroll
    for (int dvt = 0; dvt < 8; ++dvt) ss += (o[dvt][0] * o[dvt][0] + o[dvt][1] * o[dvt][1]) + (o[dvt][2] * o[dvt][2] + o[dvt][3] * o[dvt][3]);
    ss += __shfl_xor(ss, 16); ss += __shfl_xor(ss, 32);
    const float r = rsqrtf(ss * (1.0f / 128.0f) + EPS); const unsigned tok = (unsigned)(t0 + 16 * mt + fr);
#pragma unroll
    for (int dvt = 0; dvt < 8; ++dvt) { const f32x4 gv = *(const f32x4*)(inp(a, 12) + l * 128 + 16 * dvt + 4 * fq); const v2u zv = *(const v2u*)(P + (tok * (unsigned)NIN + PC_AZ + h * 128 + 16 * dvt + 4 * fq));
        v2u w; w.x = cvt_pk_bf16(o[dvt][0] * r * gv[0] * bf_lo(zv.x), o[dvt][1] * r * gv[1] * bf_hi(zv.x)); w.y = cvt_pk_bf16(o[dvt][2] * r * gv[2] * bf_lo(zv.y), o[dvt][3] * r * gv[3] * bf_hi(zv.y));
        *(v2u*)(YA + (tok * 512u + h * 128 + 16 * dvt + 4 * fq)) = w; }
}
__device__ __forceinline__ void gla_prep_item(Frame& F, ArgsP a, int l, int item) {
    int tid_ = F.tid; asm volatile("" : "+v"(tid_));
    const int n = item % 260, dh = item / 260, d = dh >> 2, h = dh & 3, t0 = chunk_tok0(n), tid = tid_, lane = tid & 63, wv = __builtin_amdgcn_readfirstlane(tid >> 6), fr = lane & 15, fq = lane >> 4;
    LAS float* Bc = (LAS float*)F.lds;
    LAS bf16* Qt = (LAS bf16*)(F.lds + 16640); LAS bf16* Kt = Qt + 64 * 72; LAS bf16* KHT = Kt + 64 * 72; LAS bf16* VT = KHT + 64 * 72;
    LAS float* W2s = (LAS float*)(F.lds + 62720); LAS float* bgs = W2s + 1024;
    const bf16* P = (const bf16*)(F.ws + WS_P); const float* SM = (const float*)(F.ws + WS_SM);
    bf16* QH = (bf16*)(F.ws + WS_QH) + (size_t)item * 4096; bf16* GG = (bf16*)(F.ws + WS_GG) + (size_t)item * 8192; float* GD = (float*)(F.ws + WS_GD) + (size_t)item * 64; bf16* GO = (bf16*)(F.ws + WS_GO);
    __syncthreads();
    for (int i = tid; i < 1024; i += 512) { W2s[i] = inp(a, 13)[(size_t)((l * 2 + d) * 16 + (i >> 6)) * 256 + h * 64 + (i & 63)]; bgs[i] = SM[(size_t)(t0 + (i >> 4)) * 64 + 16 + d * 16 + (i & 15)]; }
    __syncthreads();
    const int pos = tid >> 3, c8 = (tid & 7) * 8;
    { float x[8];
#pragma unroll
      for (int i = 0; i < 8; ++i) x[i] = inp(a, 14)[(l * 2 + d) * 256 + h * 64 + c8 + i];
#pragma unroll
      for (int r = 0; r < 16; ++r) { const float bg = bgs[pos * 16 + r];
#pragma unroll
          for (int i = 0; i < 8; ++i) x[i] += bg * W2s[r * 64 + c8 + i]; }
#pragma unroll
      for (int i = 0; i < 8; ++i) Bc[pos * 65 + c8 + i] = -softplus_f(-x[i]) * (1.0f / 16.0f); }
    __syncthreads();
    if (tid < 64) { float cv[64];
#pragma unroll
        for (int i = 0; i < 64; ++i) cv[i] = Bc[i * 65 + tid];
        if (d) {
#pragma unroll
            for (int i = 62; i >= 0; --i) cv[i] += cv[i + 1]; }
        else {
#pragma unroll
            for (int i = 1; i < 64; ++i) cv[i] += cv[i - 1]; }
#pragma unroll
        for (int i = 0; i < 64; ++i) Bc[i * 65 + tid] = cv[i]; }
    __syncthreads();
    { const bf16* pr = P + (size_t)(t0 + pos) * NIN; const v4u qx = *(const v4u*)(pr + PC_BQ + h * 64 + c8), kx = *(const v4u*)(pr + PC_BK + h * 64 + c8);
      const float qv[8] = {bf_lo(qx.x), bf_hi(qx.x), bf_lo(qx.y), bf_hi(qx.y), bf_lo(qx.z), bf_hi(qx.z), bf_lo(qx.w), bf_hi(qx.w)}, kv[8] = {bf_lo(kx.x), bf_hi(kx.x), bf_lo(kx.y), bf_hi(kx.y), bf_lo(kx.z), bf_hi(kx.z), bf_lo(kx.w), bf_hi(kx.w)};
      float qt[8], kt[8], qh[8];
#pragma unroll
      for (int i = 0; i < 8; ++i) { const float b = Bc[pos * 65 + c8 + i], br = Bc[32 * 65 + c8 + i], be = Bc[(d ? 0 : 63) * 65 + c8 + i];
          qt[i] = qv[i] * fexp(fminf(b - br, 60.f)); kt[i] = kv[i] * fexp(fminf(br - b, 60.f)); qh[i] = qv[i] * fexp(b);
          KHT[(c8 + i) * 72 + pos] = (bf16)(cvt_pk_bf16(kv[i] * fexp(be - b), 0.f) & 0xffffu); }
      v4u w; w.x = cvt_pk_bf16(qt[0], qt[1]); w.y = cvt_pk_bf16(qt[2], qt[3]); w.z = cvt_pk_bf16(qt[4], qt[5]); w.w = cvt_pk_bf16(qt[6], qt[7]); *(LAS v4u*)(Qt + pos * 72 + c8) = w;
      w.x = cvt_pk_bf16(kt[0], kt[1]); w.y = cvt_pk_bf16(kt[2], kt[3]); w.z = cvt_pk_bf16(kt[4], kt[5]); w.w = cvt_pk_bf16(kt[6], kt[7]); *(LAS v4u*)(Kt + pos * 72 + c8) = w;
      w.x = cvt_pk_bf16(qh[0], qh[1]); w.y = cvt_pk_bf16(qh[2], qh[3]); w.z = cvt_pk_bf16(qh[4], qh[5]); w.w = cvt_pk_bf16(qh[6], qh[7]); *(v4u*)(QH + pos * 64 + c8) = w;
#pragma unroll
      for (int hv = 0; hv < 2; ++hv) { const v4u vx = *(const v4u*)(pr + PC_BV + h * 128 + 16 * (tid & 7) + 8 * hv); const unsigned vw[4] = {vx.x, vx.y, vx.z, vx.w};
#pragma unroll
          for (int j = 0; j < 4; ++j) { VT[(16 * (tid & 7) + 8 * hv + 2 * j) * 72 + pos] = (bf16)(vw[j] & 0xffffu); VT[(16 * (tid & 7) + 8 * hv + 2 * j + 1) * 72 + pos] = (bf16)(vw[j] >> 16); } }
      if (tid < 64) GD[tid] = fexp(Bc[(d ? 0 : 63) * 65 + tid]); }
    __syncthreads();
    const int it = wv & 3, hf = wv >> 2;
    f32x4 at[4];
#pragma unroll
    for (int jt = 0; jt < 4; ++jt) { f32x4 acc = (f32x4){0.f, 0.f, 0.f, 0.f};
#pragma unroll
        for (int ks = 0; ks < 2; ++ks) acc = __builtin_amdgcn_mfma_f32_16x16x32_bf16(*(const LAS bf16x8*)(Kt + (16 * jt + fr) * 72 + 32 * ks + 8 * fq), *(const LAS bf16x8*)(Qt + (16 * it + fr) * 72 + 32 * ks + 8 * fq), acc, 0, 0, 0);
#pragma unroll
        for (int jj = 0; jj < 4; ++jj) { const int i = 16 * it + fr, j = 16 * jt + 4 * fq + jj; if (d ? (i > j) : (i < j)) acc[jj] = 0.f; }
        at[jt] = acc; }
    bf16x8 pb[2];
#pragma unroll
    for (int ks2 = 0; ks2 < 2; ++ks2) { v4u w; w.x = cvt_pk_bf16(at[2 * ks2][0], at[2 * ks2][1]); w.y = cvt_pk_bf16(at[2 * ks2][2], at[2 * ks2][3]); w.z = cvt_pk_bf16(at[2 * ks2 + 1][0], at[2 * ks2 + 1][1]); w.w = cvt_pk_bf16(at[2 * ks2 + 1][2], at[2 * ks2 + 1][3]); pb[ks2] = __builtin_bit_cast(bf16x8, w); }
#pragma unroll
    for (int dq = 0; dq < 4; ++dq) { const int dvt = 4 * hf + dq; f32x4 acc = (f32x4){0.f, 0.f, 0.f, 0.f};
#pragma unroll
        for (int ks2 = 0; ks2 < 2; ++ks2) { const LAS bf16* vp = VT + (16 * dvt + fr) * 72 + 32 * ks2 + 4 * fq; const v2u va = *(const LAS v2u*)vp, vb = *(const LAS v2u*)(vp + 16);
            acc = __builtin_amdgcn_mfma_f32_16x16x32_bf16(__builtin_bit_cast(bf16x8, ((v4u){va.x, va.y, vb.x, vb.y})), pb[ks2], acc, 0, 0, 0); }
        { v2u w; w.x = cvt_pk_bf16(acc[0], acc[1]); w.y = cvt_pk_bf16(acc[2], acc[3]); *(v2u*)(GO + ((size_t)d * T + t0 + 16 * it + fr) * 512 + h * 128 + 16 * dvt + 4 * fq) = w; } }
    const int dkt = wv & 3;
#pragma unroll
    for (int dq = 0; dq < 4; ++dq) { const int dvt = 4 * hf + dq; f32x4 acc = (f32x4){0.f, 0.f, 0.f, 0.f};
#pragma unroll
        for (int ks = 0; ks < 2; ++ks) acc = __builtin_amdgcn_mfma_f32_16x16x32_bf16(*(const LAS bf16x8*)(KHT + (16 * dkt + fr) * 72 + 32 * ks + 8 * fq), *(const LAS bf16x8*)(VT + (16 * dvt + fr) * 72 + 32 * ks + 8 * fq), acc, 0, 0, 0);
#pragma unroll
        for (int jj = 0; jj < 4; ++jj) GG[(16 * dkt + 4 * fq + jj) * 128 + 16 * dvt + fr] = (bf16)(cvt_pk_bf16(acc[jj], 0.f) & 0xffffu); }
}
__device__ __forceinline__ void gla_scan_item(Frame& F, int item) {
    const int dh = item >> 3, d = dh >> 2, dv = F.tid & 127, dk0 = 8 * (item & 7) + 2 * (F.tid >> 7);
    const bf16* GG = (const bf16*)(F.ws + WS_GG); const float* GD = (const float*)(F.ws + WS_GD); bf16* ST = (bf16*)(F.ws + WS_ST);
    float S0 = 0.f, S1 = 0.f;
    for (int s4 = 0; s4 < 260; s4 += 4) {
        float g0[4], g1[4], c0[4], c1[4]; size_t it[4];
#pragma unroll
        for (int u = 0; u < 4; ++u) { it[u] = (size_t)dh * 260 + scan_chunk(d, s4 + u); g0[u] = bf2f(GG[it[u] * 8192 + dk0 * 128 + dv]); g1[u] = bf2f(GG[it[u] * 8192 + (dk0 + 1) * 128 + dv]); c0[u] = GD[it[u] * 64 + dk0]; c1[u] = GD[it[u] * 64 + dk0 + 1]; }
#pragma unroll
        for (int u = 0; u < 4; ++u) { const unsigned w = cvt_pk_bf16(S0, S1); *(unsigned*)(ST + it[u] * 8192 + (size_t)((((dv >> 4) * 2 + (dk0 >> 5)) * 64 + (dv & 15) + 16 * ((dk0 & 31) >> 3)) * 8 + (dk0 & 7))) = w;
            S0 = c0[u] * S0 + g0[u]; S1 = c1[u] * S1 + g1[u]; }
    }
}
__device__ __forceinline__ void gla_post_witem(Frame& F, ArgsP a, int l, int wi) {
    const int item = wi >> 2, pt = wi & 3, n = item % 260, h = item / 260, t0 = chunk_tok0(n), lane = F.lane, fr = lane & 15, fq = lane >> 4;
    const bf16* P = (const bf16*)(F.ws + WS_P); const bf16* GO = (const bf16*)(F.ws + WS_GO); bf16* YB = (bf16*)(F.ws + WS_YABC + YSTRIDE);
    const unsigned tok = (unsigned)(t0 + 16 * pt + fr);
    f32x4 os[8];
#pragma unroll
    for (int dvt = 0; dvt < 8; ++dvt) os[dvt] = (f32x4){0.f, 0.f, 0.f, 0.f};
#pragma unroll
    for (int d = 0; d < 2; ++d) { const size_t it = (size_t)(d * 4 + h) * 260 + n; const bf16* ST = (const bf16*)(F.ws + WS_ST) + it * 8192; const bf16* QH = (const bf16*)(F.ws + WS_QH) + it * 4096;
        const bf16x8 q0 = *(const bf16x8*)(QH + (unsigned)((16 * pt + fr) * 64 + 8 * fq)), q1 = *(const bf16x8*)(QH + (unsigned)((16 * pt + fr) * 64 + 32 + 8 * fq));
        bf16x8 s0[8], s1[8]; f32x4 gi[8];
#pragma unroll
        for (int dvt = 0; dvt < 8; ++dvt) { { const v2u gw = *(const v2u*)(GO + ((size_t)d * T + tok) * 512 + h * 128 + 16 * dvt + 4 * fq); gi[dvt] = (f32x4){bf_lo(gw.x), bf_hi(gw.x), bf_lo(gw.y), bf_hi(gw.y)}; }
            s0[dvt] = *(const bf16x8*)(ST + (unsigned)(((dvt * 2 + 0) * 64 + lane) * 8)); s1[dvt] = *(const bf16x8*)(ST + (unsigned)(((dvt * 2 + 1) * 64 + lane) * 8)); }
        __builtin_amdgcn_sched_barrier(0);
#pragma unroll
        for (int dvt = 0; dvt < 8; ++dvt) { f32x4 acc = __builtin_amdgcn_mfma_f32_16x16x32_bf16(s0[dvt], q0, gi[dvt], 0, 0, 0); acc = __builtin_amdgcn_mfma_f32_16x16x32_bf16(s1[dvt], q1, acc, 0, 0, 0); os[dvt] += acc; }
        __builtin_amdgcn_sched_barrier(0); }
    float ss = 0.f;
#pragma unroll
    for (int dvt = 0; dvt < 8; ++dvt) ss += (os[dvt][0] * os[dvt][0] + os[dvt][1] * os[dvt][1]) + (os[dvt][2] * os[dvt][2] + os[dvt][3] * os[dvt][3]);
    ss += __shfl_xor(ss, 16); ss += __shfl_xor(ss, 32);
    const float r = rsqrtf(ss * (1.0f / 128.0f) + EPS);
#pragma unroll
    for (int dvt = 0; dvt < 8; ++dvt) { const f32x4 gv = *(const f32x4*)(inp(a, 15) + l * 128 + 16 * dvt + 4 * fq); const v2u zv = *(const v2u*)(P + (tok * (unsigned)NIN + PC_BZ + h * 128 + 16 * dvt + 4 * fq));
        v2u w; w.x = cvt_pk_bf16(os[dvt][0] * r * gv[0] * bf_lo(zv.x), os[dvt][1] * r * gv[1] * bf_hi(zv.x)); w.y = cvt_pk_bf16(os[dvt][2] * r * gv[2] * bf_lo(zv.y), os[dvt][3] * r * gv[3] * bf_hi(zv.y));
        *(v2u*)(YB + (tok * 512u + h * 128 + 16 * dvt + 4 * fq)) = w; }
}
constexpr int AT_KSTR = 72, AT_BUF = 2 * 64 * AT_KSTR * 2;
__device__ __forceinline__ void attn_unit(Frame& F, ArgsP a, int l, int unit) {
    int tid_ = F.tid; asm volatile("" : "+v"(tid_));
    const int qb = unit >> 1, g = unit & 1, tid = tid_, lane = tid & 63, wv = __builtin_amdgcn_readfirstlane(tid >> 6), r = wv >> 1, hf = wv & 1, hq = 4 * g + r, fr = lane & 15, fq = lane >> 4;
    const bool lat = qb >= 2; const int lb = qb - 2;
    const int qtok0 = (lat ? CTX + 128 * lb : 128 * qb) + 64 * hf;
    const bf16* P = (const bf16*)(F.ws + WS_P); bf16* YC = (bf16*)(F.ws + WS_YABC + 2 * YSTRIDE);
    const int kb_lo = lat ? max(lb - 1, 0) : 0, kb_hi = lat ? min(lb + 1, SEQ / 128 - 1) : -1;
    const int nloc = lat ? 2 * (kb_hi - kb_lo + 1) : 0, nt = nloc + 4;
    bf16x8 qf[4][2];
#pragma unroll
    for (int n = 0; n < 4; ++n)
#pragma unroll
        for (int ks = 0; ks < 2; ++ks) qf[n][ks] = *(const bf16x8*)((const bf16*)(F.ws + WS_QN) + (unsigned)((qtok0 + 16 * n + fr) * 512 + hq * 64 + 32 * ks + 8 * fq));
    const float LOG2E = 1.4426950408889634f, SC = 0.125f * LOG2E;
    const float sink2 = inp(a, 18)[l * 8 + hq] * LOG2E;
    float mrun[4], lrun[4];
    f32x4 o[4][4];
#pragma unroll
    for (int n = 0; n < 4; ++n) { mrun[n] = sink2; lrun[n] = (fq == 0) ? 1.0f : 0.0f;
#pragma unroll
        for (int dt = 0; dt < 4; ++dt) o[dt][n] = (f32x4){0.f, 0.f, 0.f, 0.f}; }
    LAS bf16* lds = (LAS bf16*)F.lds;
    const int skey = tid >> 3, sch = tid & 7;
    v4u kreg, vreg;
    auto tile_tok0 = [&](int t) -> int { return (t < nloc) ? (CTX + 128 * kb_lo + 64 * t) : 64 * (t - nloc); };
    auto g_load = [&](int t) { const unsigned tk = (unsigned)(tile_tok0(t) + skey); kreg = *(const v4u*)((const bf16*)(F.ws + WS_KN) + (tk * 128u + g * 64 + 8 * sch)); vreg = *(const v4u*)(P + (tk * (unsigned)NIN + PC_CV + g * 64 + 8 * sch)); };
    auto l_store = [&](int b) { LAS bf16* Kb = lds + b * (AT_BUF / 2); LAS bf16* Vb = Kb + 64 * AT_KSTR;
        *(LAS v4u*)(Kb + skey * AT_KSTR + 8 * sch) = kreg;
        const unsigned vw[4] = {vreg.x, vreg.y, vreg.z, vreg.w};
#pragma unroll
        for (int j = 0; j < 4; ++j) { Vb[(8 * sch + 2 * j) * AT_KSTR + skey] = (bf16)(vw[j] & 0xffffu); Vb[(8 * sch + 2 * j + 1) * AT_KSTR + skey] = (bf16)(vw[j] >> 16); } };
    __syncthreads();
    g_load(0); l_store(0);
    __syncthreads();
    for (int t = 0; t < nt; ++t) {
        if (t + 1 < nt) g_load(t + 1);
        const LAS bf16* Kb = lds + (t & 1) * (AT_BUF / 2); const LAS bf16* Vb = Kb + 64 * AT_KSTR;
        const bool local = t < nloc; const int kp0 = 128 * kb_lo + 64 * t;
        const bool need_mask = local && ((kp0 >> 7) != lb);
#pragma unroll
        for (int nh = 0; nh < 2; ++nh) {
            f32x4 s[4][2];
#pragma unroll
            for (int kt = 0; kt < 4; ++kt) {
                const bf16x8 ka0 = *(const LAS bf16x8*)(Kb + (16 * kt + fr) * AT_KSTR + 8 * fq), ka1 = *(const LAS bf16x8*)(Kb + (16 * kt + fr) * AT_KSTR + 32 + 8 * fq);
#pragma unroll
                for (int n2 = 0; n2 < 2; ++n2) { f32x4 acc = (f32x4){0.f, 0.f, 0.f, 0.f};
                    acc = __builtin_amdgcn_mfma_f32_16x16x32_bf16(ka0, qf[2 * nh + n2][0], acc, 0, 0, 0); acc = __builtin_amdgcn_mfma_f32_16x16x32_bf16(ka1, qf[2 * nh + n2][1], acc, 0, 0, 0); s[kt][n2] = acc; }
            }
#pragma unroll
            for (int n2 = 0; n2 < 2; ++n2) { const int n = 2 * nh + n2; const int qp = qtok0 - CTX + 16 * n + fr;
#pragma unroll
                for (int kt = 0; kt < 4; ++kt)
#pragma unroll
                    for (int i = 0; i < 4; ++i) { float v = s[kt][n2][i] * SC; if (need_mask) { const int d = qp - (kp0 + 16 * kt + 4 * fq + i); if (d > 128 || d < -128) v = -INFINITY; } s[kt][n2][i] = v; }
                float mx = s[0][n2][0];
#pragma unroll
                for (int kt = 0; kt < 4; ++kt)
#pragma unroll
                    for (int i = 0; i < 4; ++i) mx = fmaxf(mx, s[kt][n2][i]);
                mx = fmaxf(mx, __shfl_xor(mx, 16)); mx = fmaxf(mx, __shfl_xor(mx, 32));
                const float mnew = fmaxf(mrun[n], mx), alpha = fexp2(mrun[n] - mnew); mrun[n] = mnew; float ps = 0.f;
#pragma unroll
                for (int kt = 0; kt < 4; ++kt)
#pragma unroll
                    for (int i = 0; i < 4; ++i) { const float p = fexp2(s[kt][n2][i] - mnew); s[kt][n2][i] = p; ps += p; }
                lrun[n] = lrun[n] * alpha + ps;
#pragma unroll
                for (int dt = 0; dt < 4; ++dt) o[dt][n] = o[dt][n] * alpha; }
#pragma unroll
            for (int ks2 = 0; ks2 < 2; ++ks2) {
                bf16x8 pb[2];
#pragma unroll
                for (int n2 = 0; n2 < 2; ++n2) { v4u w; w.x = cvt_pk_bf16(s[2 * ks2][n2][0], s[2 * ks2][n2][1]); w.y = cvt_pk_bf16(s[2 * ks2][n2][2], s[2 * ks2][n2][3]); w.z = cvt_pk_bf16(s[2 * ks2 + 1][n2][0], s[2 * ks2 + 1][n2][1]); w.w = cvt_pk_bf16(s[2 * ks2 + 1][n2][2], s[2 * ks2 + 1][n2][3]); pb[n2] = __builtin_bit_cast(bf16x8, w); }
#pragma unroll
                for (int dt = 0; dt < 4; ++dt) { const LAS bf16* vp = Vb + (16 * dt + fr) * AT_KSTR + 32 * ks2 + 4 * fq;
                    const v2u va = *(const LAS v2u*)vp, vb2 = *(const LAS v2u*)(vp + 16); const v4u vv = (v4u){va.x, va.y, vb2.x, vb2.y}; const bf16x8 vf = __builtin_bit_cast(bf16x8, vv);
#pragma unroll
                    for (int n2 = 0; n2 < 2; ++n2) o[dt][2 * nh + n2] = __builtin_amdgcn_mfma_f32_16x16x32_bf16(vf, pb[n2], o[dt][2 * nh + n2], 0, 0, 0); }
            }
        }
        if (t + 1 < nt) l_store((t + 1) & 1);
        __syncthreads();
    }
#pragma unroll
    for (int n = 0; n < 4; ++n) { float lt = lrun[n]; lt += __shfl_xor(lt, 16); lt += __shfl_xor(lt, 32); const float inv = 1.0f / lt;
        bf16* yp = YC + (unsigned)((qtok0 + 16 * n + fr) * 512 + hq * 64 + 4 * fq);
#pragma unroll
        for (int dt = 0; dt < 4; ++dt) { v2u w; w.x = cvt_pk_bf16(o[dt][n][0] * inv, o[dt][n][1] * inv); w.y = cvt_pk_bf16(o[dt][n][2] * inv, o[dt][n][3] * inv); *(v2u*)(yp + 16 * dt) = w; } }
}
__device__ __forceinline__ void moe_convert_pool(Frame& F, ArgsP a, int l) {
    unsigned* qhead = F.ctl + CW_CNT + 512 + 64 * l;
    LAS float* scr = (LAS float*)(F.lds + F.wave * 16384); bf16* WGU = (bf16*)(F.ws + WS_WGU); bf16* WDN = (bf16*)(F.ws + WS_WDN);
    constexpr int NGU = NE * 1024, NDN = NE * 512, GRAB = 8;
    const int nsm = (I_BR_L + I_WO_L) + ((l + 1 < NL) ? I_IN_L : 0), ntot = NGU + NDN + ((nsm + GRAB - 1) / GRAB) * GRAB;
    LAS unsigned* bw = (LAS unsigned*)(F.lds + MISC_OFF + 2560);
    for (;;) { __syncthreads(); if (F.tid == 0) bw[0] = __hip_atomic_fetch_add(qhead, 8u, __ATOMIC_RELAXED, __HIP_MEMORY_SCOPE_AGENT); __syncthreads();
        const unsigned b0 = (unsigned)__builtin_amdgcn_readfirstlane((int)bw[0]); if (b0 >= (unsigned)(ntot / GRAB)) break;
        const unsigned g0 = b0 + (unsigned)F.wave; if (g0 >= (unsigned)(ntot / GRAB)) continue;
        for (int q = 0; q < GRAB; ++q) { int it = (int)g0 * GRAB + q;
            if (it >= NGU + NDN) { const int r = it - (NGU + NDN); if (r < I_BR_L + I_WO_L) convert_small_item(F, a, l, I_IN_L + r, scr); else if (r < nsm) convert_small_item(F, a, l + 1, r - (I_BR_L + I_WO_L), scr); }
            else if (it < NGU) { const int le = l * NE + it / 1024, r = it % 1024, kb = r / 64, nb = r % 64; const int dst = (nb < 32) ? 256 * (nb >> 2) + 32 * (nb & 3) : 256 * ((nb - 32) >> 2) + 128 + 32 * ((nb - 32) & 3);
                transpose_item(inp(a, 25) + (size_t)le * 1024 * 2048, 2048, 1024, WGU + (size_t)le * 2048 * 1024, kb * 64, 32 * nb, dst, 32, scr, F.lane); }
            else { it -= NGU; const int le = l * NE + it / 512, r = it % 512, kb = r / 32, nb = r % 32;
                transpose_item(inp(a, 27) + (size_t)le * 1024 * 1024, 1024, 1024, WDN + (size_t)le * 1024 * 1024, kb * 64, 32 * nb, 32 * nb, 32, scr, F.lane); } } }
}
__device__ __forceinline__ void phase_mixers(Frame& F, ArgsP a, int l) {
    const bool split = F.G >= 160;
    unsigned* gflag = F.ctl + CW_CNT + 256 + 64 * l;
    for (int item = F.bid; item < 128; item += F.G) {
        if (item < 64) { for (int r_ = 0; r_ < PROBE_REPS(21); ++r_) dn_scan_item(F, split ? ((item & 7) * 8 + (item >> 3)) : item); }
        else { for (int r_ = 0; r_ < PROBE_REPS(22); ++r_) gla_scan_item(F, item - 64);
            if (split) { asm volatile("s_waitcnt vmcnt(0)" ::: "memory"); __syncthreads();
                if (F.tid == 0) { __builtin_amdgcn_fence(__ATOMIC_RELEASE, "agent"); asm volatile("s_waitcnt vmcnt(0)" ::: "memory"); __hip_atomic_fetch_add(gflag, 1u, __ATOMIC_RELAXED, __HIP_MEMORY_SCOPE_AGENT); }
                __syncthreads(); moe_convert_pool(F, a, l); } }
        __syncthreads(); }
    const int ab = split ? F.bid - 128 : F.bid, nab = split ? F.G - 128 : F.G;
    if (ab >= 0) { for (int r_ = 0; r_ < PROBE_REPS(23); ++r_) for (int u = ab; u < 260; u += nab) attn_unit(F, a, l, u);
        if (split) {
            __syncthreads();
            if (F.tid == 0) { unsigned sp = 0; while (__hip_atomic_load(gflag, __ATOMIC_RELAXED, __HIP_MEMORY_SCOPE_AGENT) < 64u) { __builtin_amdgcn_s_sleep(8); if (++sp > (1u << 22)) break; }
                __builtin_amdgcn_fence(__ATOMIC_ACQUIRE, "agent"); asm volatile("s_waitcnt vmcnt(0)" ::: "memory"); }
            __syncthreads();
            for (int wi = ab * 8 + F.wave; wi < 4160; wi += nab * 8) gla_post_witem(F, a, l, wi);
            __syncthreads(); moe_convert_pool(F, a, l); } }
}
__device__ __forceinline__ void phase_post(Frame& F, ArgsP a, int l) {
    const int nwi = (F.G >= 160) ? 4160 : 8320;
    for (int wi = F.bid * 8 + F.wave; wi < nwi; wi += F.G * 8) { if (wi < 4160) dn_post_witem(F, a, l, wi); else gla_post_witem(F, a, l, wi - 4160); }
}

template <int KQ> __device__ __forceinline__ void ctx_tile_acc(const bf16* Arow0, const bf16* Wt, int K, int k0, int r0, int c0, int fr, int fq, f32x4 (&acc)[2]) {
    const bf16* ap = Arow0 + (unsigned)((r0 + fr) * K + k0 + 8 * fq); const bf16* b0 = Wt + (unsigned)((c0 + fr) * K + k0 + 8 * fq); const bf16* b1 = b0 + 16 * K;
    bf16x8 av[KQ / 32], w0[KQ / 32], w1[KQ / 32];
#pragma unroll
    for (int ks = 0; ks < KQ / 32; ++ks) { av[ks] = *(const bf16x8*)(ap + 32 * ks); w0[ks] = *(const bf16x8*)(b0 + 32 * ks); w1[ks] = *(const bf16x8*)(b1 + 32 * ks); }
#pragma unroll
    for (int ks = 0; ks < KQ / 32; ++ks) { acc[0] = __builtin_amdgcn_mfma_f32_16x16x32_bf16(w0[ks], av[ks], acc[0], 0, 0, 0); acc[1] = __builtin_amdgcn_mfma_f32_16x16x32_bf16(w1[ks], av[ks], acc[1], 0, 0, 0); }
}
__device__ __forceinline__ void ctx_branch_rows(Frame& F, int l) {
    const bf16* P = (const bf16*)(F.ws + WS_P); bf16* MG = (bf16*)(F.ws + WS_MG); const int fr = F.lane & 15, fq = F.lane >> 4;
    LAS f32x4* red = (LAS f32x4*)F.lds;
    for (int base = F.bid * 8; base < 2048; base += F.G * 8) { const int wi = base + F.wave, it = wi >> 2, kq = wi & 3, r0 = (it >> 5) * 16, c0 = (it & 31) * 32;
        f32x4 sum[2] = {(f32x4){0.f, 0.f, 0.f, 0.f}, (f32x4){0.f, 0.f, 0.f, 0.f}};
#pragma unroll
        for (int z = 0; z < 3; ++z) { f32x4 acc[2] = {(f32x4){0.f, 0.f, 0.f, 0.f}, (f32x4){0.f, 0.f, 0.f, 0.f}};
            ctx_tile_acc<128>((const bf16*)(F.ws + WS_YABC + z * YSTRIDE), (const bf16*)(F.ws + WS_WBR) + (size_t)(l * 3 + z) * 1024 * 512, 512, 128 * kq, r0, c0, fr, fq, acc);
#pragma unroll
            for (int t = 0; t < 2; ++t) { const v2u gw = *(const v2u*)(P + (unsigned)((r0 + fr) * NIN + PC_GL + z * 1024 + c0 + 16 * t + 4 * fq));
                sum[t][0] += acc[t][0] * bf_lo(gw.x); sum[t][1] += acc[t][1] * bf_hi(gw.x); sum[t][2] += acc[t][2] * bf_lo(gw.y); sum[t][3] += acc[t][3] * bf_hi(gw.y); } }
        __syncthreads();
        red[(F.wave * 2 + 0) * 64 + F.lane] = sum[0]; red[(F.wave * 2 + 1) * 64 + F.lane] = sum[1];
        __syncthreads();
        if (kq == 0) {
#pragma unroll
            for (int t = 0; t < 2; ++t) { f32x4 s = sum[t];
#pragma unroll
                for (int q = 1; q < 4; ++q) s += red[((F.wave + q) * 2 + t) * 64 + F.lane];
                v2u o; o.x = cvt_pk_bf16(s[0], s[1]); o.y = cvt_pk_bf16(s[2], s[3]); *(v2u*)(MG + (unsigned)((r0 + fr) * 1024 + c0 + 16 * t + 4 * fq)) = o; } } }
}
__device__ __forceinline__ void ctx_wo_rows(Frame& F, int l) {
    float* XS = (float*)(F.ws + WS_XS); const float* modc = (const float*)(F.ws + WS_MOD) + (size_t)l * 2 * 6144 + 6144 + 2 * 1024; const int fr = F.lane & 15, fq = F.lane >> 4;
    LAS f32x4* red = (LAS f32x4*)F.lds;
    for (int base = F.bid * 8; base < 2048; base += F.G * 8) { const int wi = base + F.wave, it = wi >> 2, kq = wi & 3, r0 = (it >> 5) * 16, c0 = (it & 31) * 32;
        f32x4 acc[2] = {(f32x4){0.f, 0.f, 0.f, 0.f}, (f32x4){0.f, 0.f, 0.f, 0.f}};
        ctx_tile_acc<256>((const bf16*)(F.ws + WS_MG), (const bf16*)(F.ws + WS_WO) + (size_t)l * 1024 * 1024, 1024, 256 * kq, r0, c0, fr, fq, acc);
        __syncthreads();
        red[(F.wave * 2 + 0) * 64 + F.lane] = acc[0]; red[(F.wave * 2 + 1) * 64 + F.lane] = acc[1];
        __syncthreads();
        if (kq == 0) {
#pragma unroll
            for (int t = 0; t < 2; ++t) { f32x4 s = acc[t];
#pragma unroll
                for (int q = 1; q < 4; ++q) s += red[((F.wave + q) * 2 + t) * 64 + F.lane];
                float* xp = XS + (unsigned)((r0 + fr) * 1024 + c0 + 16 * t + 4 * fq); *(f32x4*)xp = *(const f32x4*)xp + *(const f32x4*)(modc + c0 + 16 * t + 4 * fq) * s; } } }
}
__device__ __forceinline__ void phase_route(Frame& F, ArgsP a, int l, bool commit = true) {
    const float* XS = (const float*)(F.ws + WS_XS); bf16* H = (bf16*)(F.ws + WS_H); bf16* HLO = (bf16*)(F.ws + WS_HLO); const float* MOD = (const float*)(F.ws + WS_MOD) + (size_t)l * 2 * 6144;
    int* RT = (int*)(F.ws + WS_RT); unsigned* cnt = F.ctl + CW_CNT + 32 * l;
    const bf16* WH = (const bf16*)(F.ws + WS_WRT) + (size_t)l * 65536; const bf16* WL = WH + 32768;
    const int lane = F.lane, fr = lane & 15, fq = lane >> 4;
    const float rb0 = inp(a, 24)[l * 32 + fr], rb1 = inp(a, 24)[l * 32 + 16 + fr];
    LAS unsigned* lcnt = (LAS unsigned*)F.lds;
    __syncthreads();
    if (F.tid < 32) lcnt[F.tid] = 0u;
    __syncthreads();
    for (int it = F.bid * 8 + F.wave; it < T / 16; it += F.G * 8) {
        f32x4 gsv[4], shv[4]; { const float* mv = MOD + (size_t)((16 * it < CTX) ? 1 : 0) * 6144; load_mod(inp(a, 7) + l * 1024, mv + 3 * 1024, mv + 4 * 1024, lane, gsv, shv); }
        for (int r4 = 0; r4 < 16; r4 += 4) { f32x4 xr[4][4];
#pragma unroll
          for (int rr = 0; rr < 4; ++rr)
#pragma unroll
            for (int j = 0; j < 4; ++j) xr[rr][j] = *(const f32x4*)(XS + (size_t)(16 * it + r4 + rr) * 1024 + 4 * lane + 256 * j);
          __builtin_amdgcn_sched_barrier(0);
#pragma unroll
          for (int rr = 0; rr < 4; ++rr) { const int t = 16 * it + r4 + rr; f32x4 x[4], h[4];
#pragma unroll
            for (int j = 0; j < 4; ++j) x[j] = xr[rr][j];
            norm_mod_store2(x, gsv, shv, H + (size_t)t * 1024, lane, h);
#pragma unroll
            for (int j = 0; j < 4; ++j) { const unsigned h01 = cvt_pk_bf16(h[j][0], h[j][1]), h23 = cvt_pk_bf16(h[j][2], h[j][3]);
                v2u o; o.x = cvt_pk_bf16(h[j][0] - bf_lo(h01), h[j][1] - bf_hi(h01)); o.y = cvt_pk_bf16(h[j][2] - bf_lo(h23), h[j][3] - bf_hi(h23)); *(v2u*)(HLO + (size_t)t * 1024 + 4 * lane + 256 * j) = o; } } }
        asm volatile("s_waitcnt vmcnt(0)" ::: "memory");
        f32x4 acc0 = (f32x4){0.f, 0.f, 0.f, 0.f}, acc1 = acc0;
        const bf16* ah = H + (size_t)(16 * it + fr) * 1024 + 8 * fq; const bf16* al = HLO + (size_t)(16 * it + fr) * 1024 + 8 * fq;
        const bf16* b0h = WH + (size_t)fr * 1024 + 8 * fq; const bf16* b1h = b0h + 16 * 1024; const bf16* b0l = WL + (size_t)fr * 1024 + 8 * fq; const bf16* b1l = b0l + 16 * 1024;
#pragma unroll 4
        for (int ks = 0; ks < 32; ++ks) { const bf16x8 xh = *(const bf16x8*)(ah + 32 * ks), xl = *(const bf16x8*)(al + 32 * ks), w0h = *(const bf16x8*)(b0h + 32 * ks), w1h = *(const bf16x8*)(b1h + 32 * ks), w0l = *(const bf16x8*)(b0l + 32 * ks), w1l = *(const bf16x8*)(b1l + 32 * ks);
            acc0 = __builtin_amdgcn_mfma_f32_16x16x32_bf16(xh, w0l, acc0, 0, 0, 0); acc1 = __builtin_amdgcn_mfma_f32_16x16x32_bf16(xh, w1l, acc1, 0, 0, 0);
            acc0 = __builtin_amdgcn_mfma_f32_16x16x32_bf16(xl, w0h, acc0, 0, 0, 0); acc1 = __builtin_amdgcn_mfma_f32_16x16x32_bf16(xl, w1h, acc1, 0, 0, 0);
            acc0 = __builtin_amdgcn_mfma_f32_16x16x32_bf16(xh, w0h, acc0, 0, 0, 0); acc1 = __builtin_amdgcn_mfma_f32_16x16x32_bf16(xh, w1h, acc1, 0, 0, 0); }
#pragma unroll
        for (int i = 0; i < 4; ++i) { float v0 = acc0[i] + rb0, v1 = acc1[i] + rb1; float tv[4]; int te[4];
#pragma unroll
            for (int k = 0; k < 4; ++k) { const float m = row_max16(fmaxf(v0, v1));
                const int sel = row_min16((v0 == m) ? fr : ((v1 == m) ? 16 + fr : 64));
                tv[k] = m; te[k] = sel; if (sel == fr) v0 = -INFINITY; if (sel == 16 + fr) v1 = -INFINITY; }
            const float e1 = fexp(tv[1] - tv[0]), e2 = fexp(tv[2] - tv[0]), e3 = fexp(tv[3] - tv[0]), inv = 1.0f / (1.0f + e1 + e2 + e3);
            if (fr < 4 && commit) { const int t = 16 * it + 4 * fq + i; const int ek = (fr == 0) ? te[0] : (fr == 1) ? te[1] : (fr == 2) ? te[2] : te[3]; const float gk = ((fr == 0) ? 1.0f : (fr == 1) ? e1 : (fr == 2) ? e2 : e3) * inv;
                const unsigned pos = __hip_atomic_fetch_add(lcnt + ek, 1u, __ATOMIC_RELAXED, __HIP_MEMORY_SCOPE_WORKGROUP);
                RT[(size_t)t * 4 + fr] = ek; RT[(size_t)T * 4 + (size_t)t * 4 + fr] = (int)pos; ((float*)RT)[(size_t)2 * T * 4 + (size_t)t * 4 + fr] = gk; } }
    }
    __syncthreads();
    if (F.tid < 32 && commit) ((unsigned*)(F.ws + WS_RT + 1536 * 1024))[F.bid * 32 + F.tid] = atomicAdd(cnt + F.tid, lcnt[F.tid]);
}
__device__ __forceinline__ int moe_tables(Frame& F, int l) {
    LAS int* off = (LAS int*)(F.lds + MISC_OFF + 64); LAS unsigned char* tile_e = (LAS unsigned char*)(F.lds + MISC_OFF + 256);
    __syncthreads();
    if (F.tid < 64) { const unsigned* cnt = F.ctl + CW_CNT + 32 * l; const int e = F.lane & 31;
        const int c = (int)__hip_atomic_load(cnt + e, __ATOMIC_RELAXED, __HIP_MEMORY_SCOPE_AGENT); const int nt = (F.lane < 32) ? ((c + 255) >> 8) : 0;
        int incl = nt;
#pragma unroll
        for (int o = 1; o < 32; o <<= 1) { const int up = __shfl_up(incl, o); if ((F.lane & 31) >= o) incl += up; }
        const int rt0 = incl - nt;
        if (F.lane < 32) { off[e] = rt0 * 256; if (e == 31) off[NE] = incl;
#pragma nounroll
            for (int i = 0; i < nt; ++i) tile_e[rt0 + i] = (unsigned char)e; } }
    __syncthreads();
    return __builtin_amdgcn_readfirstlane(off[NE]);
}
__device__ __forceinline__ void phase_gather(Frame& F, int l) {
    moe_tables(F, l);
    const LAS int* off = (const LAS int*)(F.lds + MISC_OFF + 64);
    int* RT = (int*)(F.ws + WS_RT); int* SRC = (int*)(F.ws + WS_XG) + (size_t)l * (MAXRT * 256);
    for (int i = F.bid * 512 + F.tid; i < T * 4; i += F.G * 512) { const int t = i >> 2;
        const int ek = RT[i], pos = RT[(size_t)T * 4 + i]; const int slot = off[ek] + (int)((const unsigned*)(F.ws + WS_RT + 1536 * 1024))[((t >> 7) % F.G) * 32 + ek] + pos;
        RT[(size_t)3 * T * 4 + i] = slot; SRC[slot] = t; }
}
template <class Sched> __device__ __forceinline__ void moe_gather_table(Frame& F, const Sched& S, int l, LAS int* gidx) {
    const int* SRC = (const int*)(F.ws + WS_XG) + (size_t)l * (MAXRT * 256);
    int nu = 0; { Unit u; while (nu < 24 && S.next(nu, u)) ++nu; }
    for (int idx = F.tid; idx < nu * 256; idx += 512) { Unit u; S.next(idx >> 8, u); gidx[idx] = SRC[u.pm * 256 + (idx & 255)]; }
    __syncthreads();
}
__device__ __forceinline__ void phase_combine(Frame& F, ArgsP a, int l, bool commit = true) {
    float* XS = (float*)(F.ws + WS_XS); bf16* H = (bf16*)(F.ws + WS_H); const bf16* Y = (const bf16*)(F.ws + WS_Y); const int* RT = (const int*)(F.ws + WS_RT);
    const float* MOD = (const float*)(F.ws + WS_MOD) + (size_t)l * 2 * 6144; const int lane = F.lane;
    for (int t0 = F.bid * 8 + F.wave; t0 < T; t0 += 2 * F.G * 8) {
        int tt[2]; tt[0] = t0; tt[1] = (t0 + F.G * 8 < T) ? t0 + F.G * 8 : t0;
        int slot[2][4]; float gk[2][4];
#pragma unroll
        for (int q = 0; q < 2; ++q)
#pragma unroll
            for (int k = 0; k < 4; ++k) { slot[q][k] = RT[(size_t)3 * T * 4 + (size_t)tt[q] * 4 + k]; gk[q][k] = ((const float*)RT)[(size_t)2 * T * 4 + (size_t)tt[q] * 4 + k]; }
        v2u yv[2][4][4]; f32x4 xv[2][4];
#pragma unroll
        for (int q = 0; q < 2; ++q) {
#pragma unroll
            for (int k = 0; k < 4; ++k)
#pragma unroll
                for (int j = 0; j < 4; ++j) yv[q][k][j] = *(const v2u*)(Y + (size_t)slot[q][k] * 1024 + 4 * lane + 256 * j);
#pragma unroll
            for (int j = 0; j < 4; ++j) xv[q][j] = *(const f32x4*)(XS + (size_t)tt[q] * 1024 + 4 * lane + 256 * j); }
        __builtin_amdgcn_sched_barrier(0);
#pragma unroll
        for (int q = 0; q < 2; ++q) { const int t = tt[q]; if (q == 1 && t == t0) break;
            const float* mv = MOD + (size_t)((t < CTX) ? 1 : 0) * 6144 + 5 * 1024;
            f32x4 x[4], h[4];
#pragma unroll
            for (int j = 0; j < 4; ++j) { f32x4 acc = (f32x4){0.f, 0.f, 0.f, 0.f};
#pragma unroll
                for (int k = 0; k < 4; ++k) acc += (f32x4){bf_lo(yv[q][k][j].x), bf_hi(yv[q][k][j].x), bf_lo(yv[q][k][j].y), bf_hi(yv[q][k][j].y)} * gk[q][k];
                x[j] = xv[q][j] + *(const f32x4*)(mv + 4 * lane + 256 * j) * acc; }
            if (!commit) { if (x[0][0] == 1.2345e30f) XS[0] = 0.f; }
            else if (l + 1 < NL) {
#pragma unroll
                for (int j = 0; j < 4; ++j) *(f32x4*)(XS + (size_t)t * 1024 + 4 * lane + 256 * j) = x[j];
                const float* mn = MOD + (size_t)2 * 6144 + (size_t)((t < CTX) ? 1 : 0) * 6144;
                norm_mod_store(x, inp(a, 6) + (l + 1) * 1024, mn, mn + 1024, H + (size_t)t * 1024, lane, h);
            } else if (t >= CTX) {
#pragma unroll
                for (int j = 0; j < 4; ++j) *(f32x4*)(outp(a) + (size_t)(t - CTX) * 1024 + 4 * lane + 256 * j) = x[j];
            } }
    }
}

__device__ __forceinline__ int opq_s(int v) { asm volatile("" : "+s"(v)); return __builtin_amdgcn_readfirstlane(v); }
__device__ __forceinline__ unsigned long long opq_u64(unsigned long long p) { unsigned lo_ = (unsigned)p, hi_ = (unsigned)(p >> 32); asm volatile("" : "+s"(lo_), "+s"(hi_));
    return ((unsigned long long)(unsigned)__builtin_amdgcn_readfirstlane((int)hi_) << 32) | (unsigned)__builtin_amdgcn_readfirstlane((int)lo_); }
#define TID_NOW() (opq_s(wave0) * 64 + (int)__builtin_amdgcn_mbcnt_hi(~0u, __builtin_amdgcn_mbcnt_lo(~0u, 0u)))
#define PHASE_BEGIN(LV) Frame F; ArgsP A; int l; { int t_ = TID_NOW(); asm volatile("" : "+v"(t_)); \
    F.ws = (unsigned char*)(GAS unsigned char*)opq_u64((unsigned long long)args.ws); F.ctl = (unsigned*)(F.ws + WS_CTL); F.lds = (LAS unsigned char*)lds_raw + opq_s(0); F.tid = t_; F.lane = t_ & 63; F.wave = __builtin_amdgcn_readfirstlane(t_ >> 6); \
    F.G = opq_s((int)gridDim.x); F.bid = opq_s((int)blockIdx.x); A = (ArgsP)opq_u64((unsigned long long)__builtin_amdgcn_kernarg_segment_ptr()); l = opq_s(LV); } \
    unsigned char* const ws = F.ws; (void)ws; (void)A; (void)l
__global__ void __launch_bounds__(512, 2) mk_fwd(Args args) {
    extern __shared__ __attribute__((aligned(16))) unsigned char lds_raw[];
    const int lo = args.ph_lo, hi = args.ph_hi;
    const int wave0 = __builtin_amdgcn_readfirstlane((int)(threadIdx.x >> 6));
    if (threadIdx.x < 4) ((LAS unsigned*)((LAS unsigned char*)lds_raw + MISC_OFF))[threadIdx.x] = 0u;
    __syncthreads();
    XcdBarrier bar; bar.lead = false; bar.bar = (unsigned*)(args.ws + WS_CTL) + CW_BAR; bar.x = 0; bar.st = (volatile LAS unsigned*)((LAS unsigned char*)lds_raw + MISC_OFF);
    if (hi - lo > 1) bar = xcd_barrier_post((unsigned*)(args.ws + WS_CTL) + CW_BAR, (volatile LAS unsigned*)((LAS unsigned char*)lds_raw + MISC_OFF), threadIdx.x == 0);
#define IN(k) (lo <= (k) && (k) < hi)
#define SEAM(k) do { if (IN(k) && IN((k) + 1)) { XcdBarrier b2_; b2_.lead = (TID_NOW() == 0); b2_.bar = (unsigned*)(GAS unsigned*)opq_u64((unsigned long long)bar.bar); b2_.x = (unsigned)opq_s((int)bar.x); b2_.st = (volatile LAS unsigned*)((LAS unsigned char*)lds_raw + opq_s(MISC_OFF)); xcd_barrier(b2_); } } while (0)
#define GRIDBAR() do { XcdBarrier b2_; b2_.lead = (TID_NOW() == 0); b2_.bar = (unsigned*)(GAS unsigned*)opq_u64((unsigned long long)bar.bar); b2_.x = (unsigned)opq_s((int)bar.x); b2_.st = (volatile LAS unsigned*)((LAS unsigned char*)lds_raw + opq_s(MISC_OFF)); xcd_barrier(b2_); } while (0)
#define PH_OUTER(k) (((k) == 5 || (k) == 6 || (k) == 10) ? 1 : PROBE_REPS(k))
#define PH(k, ...) for (int rep_ = 0; rep_ < PH_OUTER(k); ++rep_) { if (IN(pb + (k))) { __VA_ARGS__ } } SEAM(pb + (k));
    for (int rep_ = 0; rep_ < PROBE_REPS(100); ++rep_) { if (IN(0)) { PHASE_BEGIN(0); phase_prologue(F, A); } if (rep_ + 1 < PROBE_REPS(100)) { if (hi - lo > 1) GRIDBAR(); } } SEAM(0);
    if (IN(1)) { PHASE_BEGIN(0); phase_norm0(F, A); } SEAM(1);
#define LAYER_BODY(LIDX) { const int layer = (LIDX); \
        const int pb = NPH_PRO + layer * NPH_LAYER; \
        PH(0,  \
            PHASE_BEGIN(layer); \
            TileOrder S; S.init(T / 256, NIN / 256, F.G, F.bid, ws + WS_H, ws + WS_WIN + (size_t)l * NIN * 1024 * 2, 1024); \
            EpiIn E{(bf16*)(ws + WS_P), (float*)(ws + WS_SM)}; \
            for (int r_ = 0; r_ < PROBE_REPS(1000); ++r_) pg8::gemm_phase<EpiIn, TileOrder, true, true>(F.lds, F.tid, 1024, S, E); \
        ) \
        PH(1,  PHASE_BEGIN(layer); for (int r_ = 0; r_ < PROBE_REPS(11); ++r_) phase_prep(F, A, l); for (int r_ = 0; r_ < PROBE_REPS(12); ++r_) { for (int item = F.bid; item < 1040; item += F.G) dn_prep_item(F, A, l, item); \
              \
            if (F.G == 256) { for (int j = (F.bid < 16) ? 4 : 0; ; ++j) { const int item = (j < 4) ? j * 240 + (F.bid - 16) : 960 + (j - 4) * 256 + F.bid; if (item >= 2080) break; gla_prep_item(F, A, l, item); } } \
            else { for (int item = F.bid; item < 2080; item += F.G) gla_prep_item(F, A, l, item); } } ) \
        PH(2,  PHASE_BEGIN(layer); phase_mixers(F, A, l); ) \
        PH(3,  PHASE_BEGIN(layer); phase_post(F, A, l); ) \
        PH(4,  \
            PHASE_BEGIN(layer); \
            BranchOrder S; S.init(T / 256 - 1, 4, F.G, F.bid, ws + WS_YABC, ws + WS_WBR + (size_t)l * 3 * 1024 * 512 * 2, 512, 1); S.zA = YSTRIDE; S.zB = (size_t)1024 * 512 * 2; \
            EpiBranch E{(const bf16*)(ws + WS_P), (bf16*)(ws + WS_MG)}; \
            for (int r_ = 0; r_ < PROBE_REPS(41); ++r_) pg8::gemm_phase<EpiBranch, BranchOrder, true, true>(F.lds, F.tid, 512, S, E); for (int r_ = 0; r_ < PROBE_REPS(42); ++r_) ctx_branch_rows(F, l); \
        ) \
        PH(5,  \
            PHASE_BEGIN(layer); \
            const float* MOD = (const float*)(ws + WS_MOD) + (size_t)l * 2 * 6144; \
            TileOrder S; S.init(T / 256 - 1, 4, F.G, F.bid, ws + WS_MG, ws + WS_WO + (size_t)l * 1024 * 1024 * 2, 1024, 1); \
            EpiWo E{(float*)(ws + WS_XS), MOD + 2 * 1024, MOD + 6144 + 2 * 1024, true}; \
            for (int r_ = 0; r_ < PROBE_REPS(5); ++r_) { E.commit = opq_s(r_ + 1 == PROBE_REPS(5)) != 0; pg8::gemm_phase<EpiWo, TileOrder, true, true>(F.lds, F.tid, 1024, S, E); } ctx_wo_rows(F, l); \
        ) \
        PH(6,  PHASE_BEGIN(layer); for (int r_ = 0; r_ < PROBE_REPS(6); ++r_) phase_route(F, A, l, opq_s(r_ + 1 == PROBE_REPS(6)) != 0); ) \
        PH(7,  PHASE_BEGIN(layer); phase_gather(F, l); ) \
        PH(8,  \
            PHASE_BEGIN(layer); \
            const int rt = moe_tables(F, l); \
            MoeGatherOrder S; S.rt = rt; S.nN = 8; S.G = F.G; S.c = F.bid; S.tile_e = (const LAS unsigned char*)(F.lds + MISC_OFF + 256); S.gidx = (const LAS int*)(F.lds + MISC_OFF + 2560); S.rowbytes = 2048u; \
            S.A = (const char*)(ws + WS_H); S.B = (const char*)(ws + WS_WGU + (size_t)l * NE * 2048 * 1024 * 2); S.tstepA = S.tstepB = (size_t)256 * 1024 * 2; S.zB = (size_t)2048 * 1024 * 2; \
            EpiMoe1 E{(bf16*)(ws + WS_ACT), inp(A, 26) + (size_t)l * NE * 2048}; \
            moe_gather_table(F, S, l, (LAS int*)(F.lds + MISC_OFF + 2560)); for (int r_ = 0; r_ < PROBE_REPS(81); ++r_) pg8::gemm_phase<EpiMoe1, MoeGatherOrder, true, true>(F.lds, F.tid, 1024, S, E); \
        ) \
        PH(9,  \
            PHASE_BEGIN(layer); \
            const int rt = moe_tables(F, l); \
            MoeOrder S; S.rt = rt; S.nN = 4; S.G = F.G; S.c = F.bid; S.tile_e = (const LAS unsigned char*)(F.lds + MISC_OFF + 256); \
            S.A = (const char*)(ws + WS_ACT); S.B = (const char*)(ws + WS_WDN + (size_t)l * NE * 1024 * 1024 * 2); S.tstepA = S.tstepB = (size_t)256 * 1024 * 2; S.zB = (size_t)1024 * 1024 * 2; \
            EpiMoe2 E{(bf16*)(ws + WS_Y), inp(A, 28) + (size_t)l * NE * 1024}; \
            for (int r_ = 0; r_ < PROBE_REPS(91); ++r_) pg8::gemm_phase<EpiMoe2, MoeOrder, true, true>(F.lds, F.tid, 1024, S, E); \
        ) \
        PH(10,  PHASE_BEGIN(layer); for (int r_ = 0; r_ < PROBE_REPS(10); ++r_) phase_combine(F, A, l, opq_s(r_ + 1 == PROBE_REPS(10)) != 0); ) \
    }
    LAYER_BODY(0) LAYER_BODY(1) LAYER_BODY(2) LAYER_BODY(3)
#undef LAYER_BODY
#undef IN
#undef SEAM
}

extern "C" void kernel_launch(void* const* d_in, const int* in_sizes, int n_in, void* d_out, int out_size, void* d_ws, size_t ws_size, hipStream_t stream) {
    static int grid = 0;
    if (grid == 0) {
        if (n_in != 29 || out_size != SEQ * D || ws_size < WS_END) { fprintf(stderr, "kernel_launch: unexpected shapes (n_in %d, out %d, ws %zu); nothing launched\n", n_in, out_size, ws_size); grid = -1; return; }
        int dev = 0, cus = 0;
        if (hipGetDevice(&dev) != hipSuccess || hipDeviceGetAttribute(&cus, hipDeviceAttributeMultiprocessorCount, dev) != hipSuccess) { grid = -1; return; }
        if (hipFuncSetAttribute((const void*)mk_fwd, hipFuncAttributeMaxDynamicSharedMemorySize, LDS_BYTES) != hipSuccess) { fprintf(stderr, "kernel_launch: hipFuncSetAttribute failed\n"); grid = -1; return; }
        int per_cu = 0;
        if (hipOccupancyMaxActiveBlocksPerMultiprocessor(&per_cu, (const void*)mk_fwd, 512, LDS_BYTES) != hipSuccess || per_cu < 1) fprintf(stderr, "kernel_launch: occupancy query reports %d\n", per_cu);
        (void)hipGetLastError();
        grid = cus;
    }
    if (grid < 0) return;
    if (hipMemsetAsync((char*)d_ws + WS_CTL, 0, CTL_ZERO_BYTES, stream) != hipSuccess) return;
    if (hipMemsetAsync((char*)d_ws + WS_XG, 0, (size_t)NL * MAXRT * 256 * 4, stream) != hipSuccess) return;
    Args a{};
    for (int i = 0; i < 29; ++i) a.in[i] = (const float*)d_in[i];
    a.out = (float*)d_out; a.ws = (unsigned char*)d_ws;
#if MK_MULTI
    for (int ph = 0; ph < NPH; ++ph) { a.ph_lo = ph; a.ph_hi = ph + 1; hipLaunchKernelGGL(mk_fwd, dim3(grid), dim3(512), LDS_BYTES, stream, a); }
#else
    a.ph_lo = 0; a.ph_hi = NPH; hipLaunchKernelGGL(mk_fwd, dim3(grid), dim3(512), LDS_BYTES, stream, a);
#endif
}
```
